# Optimizing an MI355X kernel written in HIP

```python
import math
import jax
import jax.numpy as jnp
from jax import lax
import numpy as np

D_MODEL = 1024
BATCH = 16
SEQ = 2048
DEPTH = 2

GRID_W = 64
CTX_LEN = 256
N_EVEN = (DEPTH + 1) // 2
N_ODD = DEPTH // 2
EPS = 1e-6

GLA_HEADS = 4
GLA_KEY_W = D_MODEL // 2
GLA_VAL_W = D_MODEL
GLA_KEY_DIM = GLA_KEY_W // GLA_HEADS
GLA_VAL_DIM = GLA_VAL_W // GLA_HEADS
GLA_GATE_RANK = 16
GLA_GATE_NORM = 16.0
HG_DIM = 128
HG_W = D_MODEL
HG_HEADS = HG_W // HG_DIM
LIN_CHUNK = 32
ATT_HEAD_DIM = 64
ATT_Q_HEADS = D_MODEL // ATT_HEAD_DIM
ATT_KV_HEADS = ATT_Q_HEADS // 4
ATT_GROUP = ATT_Q_HEADS // ATT_KV_HEADS
ATT_Q_W = ATT_Q_HEADS * ATT_HEAD_DIM
ATT_KV_W = ATT_KV_HEADS * ATT_HEAD_DIM
WINDOW = 128
ATT_BLOCK = 128
ROPE_BASE = 10000.0
NEG_INF = -1e30
S5_W = D_MODEL
S5_GROUP_CH = 16
S5_GROUPS = S5_W // S5_GROUP_CH
S5_STATE = 64

EV_SPLITS = (GLA_KEY_W, GLA_KEY_W, GLA_VAL_W, 2 * GLA_GATE_RANK, GLA_VAL_W, HG_W, 2 * HG_W, HG_W, HG_W)
EV_IN_W = sum(EV_SPLITS)
EV_OUT_W = GLA_VAL_W + HG_W
OD_SPLITS = (ATT_Q_W, ATT_KV_W, ATT_KV_W, ATT_Q_W, S5_W, S5_W)
OD_IN_W = sum(OD_SPLITS)
OD_OUT_W = ATT_Q_W + S5_W

kernel_name = 'hybrid_prefix_dit_block'


def rmsnorm(x, g):
    xf = x.astype(jnp.float32)
    return xf * lax.rsqrt(jnp.mean(xf * xf, axis=-1, keepdims=True) + EPS) * g.astype(jnp.float32)


def split_cols(p, sizes):
    return jnp.split(p, [int(i) for i in np.cumsum(sizes)[:-1]], axis=-1)


def to_heads(a, nh):
    bsz, length, width = a.shape
    return a.reshape(bsz, length, nh, width // nh).transpose(0, 2, 1, 3)


def from_heads(a):
    bsz, nh, length, d = a.shape
    return a.transpose(0, 2, 1, 3).reshape(bsz, length, nh * d)


def chunk_recurrence(q, k, v, g, s0):
    bsz, nh, length, dk = q.shape
    dv = v.shape[-1]
    n = length // LIN_CHUNK
    q, k, v, g = (a.astype(jnp.float32).reshape(bsz, nh, n, LIN_CHUNK, a.shape[-1]) for a in (q, k, v, g))
    bcum = jnp.cumsum(g, axis=3)
    blast = bcum[:, :, :, -1:, :]
    q_dec = q * jnp.exp(bcum)
    k_inv = k * jnp.exp(-bcum)
    k_tail = k * jnp.exp(blast - bcum)
    lower = jnp.tril(jnp.ones((LIN_CHUNK, LIN_CHUNK), dtype=bool))
    att = jnp.where(lower, jnp.einsum('bhncd,bhnsd->bhncs', q_dec, k_inv), 0.0)
    o_intra = jnp.einsum('bhncs,bhnsv->bhncv', att, v)

    def step(state, inp):
        q_n, k_n, v_n, dec_n = inp
        o_n = jnp.einsum('bhcd,bhdv->bhcv', q_n, state)
        state = dec_n[..., None] * state + jnp.einsum('bhcd,bhcv->bhdv', k_n, v_n)
        return state, o_n

    xs = (jnp.moveaxis(q_dec, 2, 0), jnp.moveaxis(k_tail, 2, 0), jnp.moveaxis(v, 2, 0),
          jnp.moveaxis(jnp.exp(blast[:, :, :, 0, :]), 2, 0))
    s_final, o_inter = lax.scan(step, s0.astype(jnp.float32), xs)
    o = o_intra + jnp.moveaxis(o_inter, 0, 2)
    return o.reshape(bsz, nh, length, dv), s_final


def bidirectional_scan(c_feats, l_feats, need_ctx):
    q_c, k_c, v_c, g_c = c_feats
    q_l, k_l, v_l, g_l = l_feats
    bsz, nh, _, dk = q_l.shape
    dv = v_l.shape[-1]
    zero = jnp.zeros((bsz, nh, dk, dv), jnp.float32)

    def rev(a):
        return jnp.flip(a, axis=2)

    o_cf, s_f = chunk_recurrence(q_c, k_c[0], v_c, g_c[0], zero)
    o_lf, _ = chunk_recurrence(q_l, k_l[0], v_l, g_l[0], s_f)
    o_cb, s_b = chunk_recurrence(rev(q_c), rev(k_c[1]), rev(v_c), rev(g_c[1]), zero)
    o_lb, _ = chunk_recurrence(rev(q_l), rev(k_l[1]), rev(v_l), rev(g_l[1]), s_b)
    o_c = o_cf + rev(o_cb) if need_ctx else None
    return o_c, o_lf + rev(o_lb)


def even_features(h, w_in, gk_w, gk_b, lb):
    aq, ak, av, alr, agate, bq, bf, bi, bgate = split_cols(h @ w_in, EV_SPLITS)
    lr_pair = jnp.split(alr, 2, axis=-1)
    g_gla = tuple(to_heads(jax.nn.log_sigmoid((lr_pair[d] @ gk_w[d] + gk_b[d]).astype(jnp.float32)) / GLA_GATE_NORM,
                           GLA_HEADS) for d in range(2))
    f_pair = jnp.split(bf, 2, axis=-1)
    forget = tuple(lb[d] + (1.0 - lb[d]) * jax.nn.sigmoid(f_pair[d].astype(jnp.float32)) for d in range(2))
    ak_h = to_heads(ak, GLA_HEADS)
    return {
        'gla': (to_heads(aq, GLA_HEADS) * GLA_KEY_DIM ** -0.5, (ak_h, ak_h), to_heads(av, GLA_HEADS), g_gla),
        'hgrn': (to_heads(bq, HG_HEADS), tuple(to_heads(1.0 - f, HG_HEADS) for f in forget),
                 to_heads(bi, HG_HEADS), tuple(to_heads(jnp.log(f), HG_HEADS) for f in forget)),
        'gla_gate': agate,
        'hgrn_gate': bgate,
    }


def even_out(o_gla, gate_a, o_hg, gate_b, gla_g, hg_g, w_out):
    a = from_heads(rmsnorm(o_gla, gla_g)) * jax.nn.silu(gate_a)
    b = from_heads(rmsnorm(o_hg, hg_g)) * jax.nn.silu(gate_b)
    return jnp.concatenate([a, b], axis=-1) @ w_out


def even_mixer(h_c, h_l, w_in, w_out, gk_w, gk_b, gla_g, lb, hg_g, need_ctx):
    f_c = even_features(h_c, w_in, gk_w, gk_b, lb)
    f_l = even_features(h_l, w_in, gk_w, gk_b, lb)
    gla_c, gla_l = bidirectional_scan(f_c['gla'], f_l['gla'], need_ctx)
    hg_c, hg_l = bidirectional_scan(f_c['hgrn'], f_l['hgrn'], need_ctx)
    y_l = even_out(gla_l, f_l['gla_gate'], hg_l, f_l['hgrn_gate'], gla_g, hg_g, w_out)
    y_c = even_out(gla_c, f_c['gla_gate'], hg_c, f_c['hgrn_gate'], gla_g, hg_g, w_out) if need_ctx else None
    return y_c, y_l


def axial_rope(x, row, col):
    half = ATT_HEAD_DIM // 2
    quarter = half // 2
    freqs = ROPE_BASE ** (-jnp.arange(quarter, dtype=jnp.float32) / quarter)

    def rot(xa, pos):
        ang = pos.astype(jnp.float32)[:, None] * freqs
        cos, sin = jnp.cos(ang), jnp.sin(ang)
        x1, x2 = xa[..., :quarter], xa[..., quarter:]
        return jnp.concatenate([x1 * cos - x2 * sin, x2 * cos + x1 * sin], axis=-1)

    return jnp.concatenate([rot(x[..., :half], row), rot(x[..., half:], col)], axis=-1)


def window_attention(q_c, k_c, v_c, q_l, k_l, v_l, sink, need_ctx):
    bsz, hkv, grp, length, d = q_l.shape
    lc = k_c.shape[2]
    nb = length // ATT_BLOCK
    sink = sink.astype(jnp.float32).reshape(hkv, grp)
    pad = ((0, 0), (0, 0), (ATT_BLOCK, ATT_BLOCK), (0, 0))
    kpad, vpad = jnp.pad(k_l, pad), jnp.pad(v_l, pad)

    def band(a):
        return jnp.concatenate([a[:, :, s * ATT_BLOCK: s * ATT_BLOCK + length].reshape(bsz, hkv, nb, ATT_BLOCK, d)
                                for s in range(3)], axis=3)

    kb, vb = band(kpad), band(vpad)
    qb = q_l.reshape(bsz, hkv, grp, nb, ATT_BLOCK, d)
    blk = jnp.arange(nb)[:, None, None]
    qpos = blk * ATT_BLOCK + jnp.arange(ATT_BLOCK)[None, :, None]
    kpos = (blk - 1) * ATT_BLOCK + jnp.arange(3 * ATT_BLOCK)[None, None, :]
    valid = (jnp.abs(qpos - kpos) <= WINDOW) & (kpos >= 0) & (kpos < length)
    s_band = jnp.where(valid, jnp.einsum('bhgnqd,bhnkd->bhgnqk', qb, kb).astype(jnp.float32), NEG_INF)
    s_ctx = jnp.einsum('bhgnqd,bhkd->bhgnqk', qb, k_c).astype(jnp.float32)
    s_sink = jnp.broadcast_to(sink[None, :, :, None, None, None], s_ctx.shape[:-1] + (1,))
    p = jax.nn.softmax(jnp.concatenate([s_ctx, s_band, s_sink], axis=-1), axis=-1)
    o_l = (jnp.einsum('bhgnqk,bhkd->bhgnqd', p[..., :lc], v_c)
           + jnp.einsum('bhgnqk,bhnkd->bhgnqd', p[..., lc:lc + 3 * ATT_BLOCK], vb))
    o_l = o_l.reshape(bsz, hkv, grp, length, d).transpose(0, 3, 1, 2, 4).reshape(bsz, length, ATT_Q_W)
    o_c = None
    if need_ctx:
        s_c = jnp.einsum('bhgqd,bhkd->bhgqk', q_c, k_c).astype(jnp.float32)
        sink_c = jnp.broadcast_to(sink[None, :, :, None, None], s_c.shape[:-1] + (1,))
        p_c = jax.nn.softmax(jnp.concatenate([s_c, sink_c], axis=-1), axis=-1)
        o_c = jnp.einsum('bhgqk,bhkd->bhgqd', p_c[..., :lc], v_c)
        o_c = o_c.transpose(0, 3, 1, 2, 4).reshape(bsz, lc, ATT_Q_W)
    return o_c, o_l


def _combine(e1, e2):
    a1, b1 = e1
    a2, b2 = e2
    return a1 * a2, a2 * b1 + b2


def diag_scan(abar, drive, s0):
    if s0 is not None:
        drive = drive.at[0].add(abar * s0)
    a = jnp.broadcast_to(abar, (drive.shape[0], 1) + abar.shape)
    _, states = lax.associative_scan(_combine, (a, drive), axis=0)
    return states


def s5_bidirectional(u_c, u_l, lam_re, lam_im, log_dt, b_re, b_im, c_re, c_im, d_skip, need_ctx):
    f32 = jnp.float32
    bmat = lax.complex(b_re.astype(f32), b_im.astype(f32))
    cmat = lax.complex(c_re.astype(f32), c_im.astype(f32))
    uc_cx, ul_cx = u_c.astype(jnp.complex64), u_l.astype(jnp.complex64)

    def read(states):
        return jnp.real(jnp.einsum('lbgp,ghp->blgh', states, cmat))

    y_c = d_skip.astype(f32) * u_c.astype(f32) if need_ctx else None
    y_l = d_skip.astype(f32) * u_l.astype(f32)
    for direction in range(2):
        lam = lax.complex(lam_re[direction].astype(f32), lam_im[direction].astype(f32))
        dt = jnp.exp(log_dt[direction].astype(f32))[:, None]
        abar = jnp.exp(lam * dt)
        bbar = ((abar - 1.0) / lam)[:, :, None] * bmat
        order = (lambda a: jnp.flip(a, axis=0)) if direction == 1 else (lambda a: a)
        st_c = diag_scan(abar, order(jnp.einsum('blgh,gph->lbgp', uc_cx, bbar)), None)
        st_l = order(diag_scan(abar, order(jnp.einsum('blgh,gph->lbgp', ul_cx, bbar)), st_c[-1]))
        y_l = y_l + read(st_l)
        if need_ctx:
            y_c = y_c + read(order(st_c))
    return y_c, y_l


def odd_features(h, w_in):
    q, k, v, g_att, u, g_s5 = split_cols(h @ w_in, OD_SPLITS)
    bsz, length, _ = h.shape
    q = q.reshape(bsz, length, ATT_KV_HEADS, ATT_GROUP, ATT_HEAD_DIM).transpose(0, 2, 3, 1, 4) * ATT_HEAD_DIM ** -0.5
    u = u.reshape(bsz, length, S5_GROUPS, S5_GROUP_CH)
    return q, to_heads(k, ATT_KV_HEADS), to_heads(v, ATT_KV_HEADS), g_att, u, g_s5


def odd_out(o_att, g_att, y_s5, g_s5, glu_w, w_out):
    z = jax.nn.gelu(y_s5.reshape(y_s5.shape[0], y_s5.shape[1], S5_W))
    a, b = jnp.split(z @ glu_w, 2, axis=-1)
    s5 = a * jax.nn.sigmoid(b)
    return jnp.concatenate([o_att * jax.nn.silu(g_att), s5 * jax.nn.silu(g_s5)], axis=-1) @ w_out


def odd_mixer(h_c, h_l, w_in, w_out, sink, lam_re, lam_im, log_dt, b_re, b_im, c_re, c_im, d_skip, glu_w,
              row, col, need_ctx):
    q_l, k_l, v_l, ga_l, u_l, gs_l = odd_features(h_l, w_in)
    q_c, k_c, v_c, ga_c, u_c, gs_c = odd_features(h_c, w_in)
    q_l, k_l = axial_rope(q_l, row, col), axial_rope(k_l, row, col)
    att_c, att_l = window_attention(q_c, k_c, v_c, q_l, k_l, v_l, sink, need_ctx)
    ssm_c, ssm_l = s5_bidirectional(u_c, u_l, lam_re, lam_im, log_dt, b_re, b_im, c_re, c_im, d_skip, need_ctx)
    y_l = odd_out(att_l, ga_l, ssm_l, gs_l, glu_w, w_out)
    y_c = odd_out(att_c, ga_c, ssm_c, gs_c, glu_w, w_out) if need_ctx else None
    return y_c, y_l


def setup_inputs(seed: int = 0) -> dict:
    key = jax.random.key(seed)
    ks = jax.random.split(key, 27)
    f32 = jnp.float32

    def nrm(k, shape, scale):
        return jax.random.normal(k, shape, f32) * scale

    d = D_MODEL
    g5, p5, h5 = S5_GROUPS, S5_STATE, S5_GROUP_CH
    return {
        'x': nrm(ks[0], (BATCH, SEQ, d), 1.0),
        'c': nrm(ks[1], (BATCH, d), 1.0),
        'ctx': nrm(ks[2], (BATCH, CTX_LEN, d), 1.0),
        'c_ctx': nrm(ks[3], (d,), 1.0),
        'ada_w': nrm(ks[4], (DEPTH, d, 3 * d), 0.5 * d ** -0.5),
        'ada_b': nrm(ks[5], (DEPTH, 3 * d), 0.02),
        'norm_g': 1.0 + nrm(ks[6], (DEPTH, d), 0.05),
        'final_norm_g': 1.0 + nrm(ks[7], (d,), 0.05),
        'ev_w_in': nrm(ks[8], (N_EVEN, d, EV_IN_W), d ** -0.5),
        'ev_w_out': nrm(ks[9], (N_EVEN, EV_OUT_W, d), EV_OUT_W ** -0.5),
        'gla_gk_w': nrm(ks[10], (N_EVEN, 2, GLA_GATE_RANK, GLA_KEY_W), GLA_GATE_RANK ** -0.5),
        'gla_gk_b': nrm(ks[11], (N_EVEN, 2, GLA_KEY_W), 0.1),
        'gla_norm_g': 1.0 + nrm(ks[12], (N_EVEN, GLA_VAL_DIM), 0.05),
        'hgrn_lb_raw': nrm(ks[13], (2, N_EVEN + 1, HG_W), 0.5),
        'hgrn_norm_g': 1.0 + nrm(ks[14], (N_EVEN, HG_DIM), 0.05),
        'od_w_in': nrm(ks[15], (N_ODD, d, OD_IN_W), d ** -0.5),
        'od_w_out': nrm(ks[16], (N_ODD, OD_OUT_W, d), OD_OUT_W ** -0.5),
        'attn_sink': nrm(ks[17], (N_ODD, ATT_Q_HEADS), 0.5),
        's5_lambda_re': -0.5 + nrm(ks[18], (N_ODD, 2, g5, p5), 0.01),
        's5_lambda_im': math.pi * jnp.arange(p5, dtype=f32) + nrm(ks[19], (N_ODD, 2, g5, p5), 0.01),
        's5_log_dt': jax.random.uniform(ks[20], (N_ODD, 2, g5), f32, math.log(1e-3), math.log(1e-1)),
        's5_b_re': nrm(ks[21], (N_ODD, g5, p5, h5), (2 * h5) ** -0.5),
        's5_b_im': nrm(ks[22], (N_ODD, g5, p5, h5), (2 * h5) ** -0.5),
        's5_c_re': nrm(ks[23], (N_ODD, g5, h5, p5), p5 ** -0.5),
        's5_c_im': nrm(ks[24], (N_ODD, g5, h5, p5), p5 ** -0.5),
        's5_d': nrm(ks[25], (N_ODD, g5, h5), 1.0),
        's5_glu_w': nrm(ks[26], (N_ODD, S5_W, 2 * S5_W), S5_W ** -0.5),
    }


def reference(x, c, ctx, c_ctx, ada_w, ada_b, norm_g, final_norm_g,
              ev_w_in, ev_w_out, gla_gk_w, gla_gk_b, gla_norm_g, hgrn_lb_raw, hgrn_norm_g,
              od_w_in, od_w_out, attn_sink, s5_lambda_re, s5_lambda_im, s5_log_dt,
              s5_b_re, s5_b_im, s5_c_re, s5_c_im, s5_d, s5_glu_w):
    length = x.shape[1]
    rows = length // GRID_W
    row = jnp.repeat(jnp.arange(rows), GRID_W)
    col = jnp.tile(jnp.arange(GRID_W), rows)
    lb_all = jnp.cumsum(jax.nn.softmax(hgrn_lb_raw.astype(jnp.float32), axis=1), axis=1)
    xl, xc = x, ctx
    for layer in range(DEPTH):
        need_ctx = layer < DEPTH - 1
        w_ada, b_ada = ada_w[layer], ada_b[layer]
        shift_l, scale_l, gate_l = jnp.split(jax.nn.silu(c) @ w_ada + b_ada, 3, axis=-1)
        shift_c, scale_c, gate_c = jnp.split(jax.nn.silu(c_ctx) @ w_ada + b_ada, 3, axis=-1)
        h_l = rmsnorm(xl, norm_g[layer]) * (1.0 + scale_l[:, None, :]) + shift_l[:, None, :]
        h_c = rmsnorm(xc, norm_g[layer]) * (1.0 + scale_c) + shift_c
        idx = layer // 2
        if layer % 2 == 0:
            y_c, y_l = even_mixer(h_c, h_l, ev_w_in[idx], ev_w_out[idx], gla_gk_w[idx], gla_gk_b[idx],
                                  gla_norm_g[idx], lb_all[:, idx], hgrn_norm_g[idx], need_ctx)
        else:
            y_c, y_l = odd_mixer(h_c, h_l, od_w_in[idx], od_w_out[idx], attn_sink[idx],
                                 s5_lambda_re[idx], s5_lambda_im[idx], s5_log_dt[idx],
                                 s5_b_re[idx], s5_b_im[idx], s5_c_re[idx], s5_c_im[idx], s5_d[idx],
                                 s5_glu_w[idx], row, col, need_ctx)
        xl = xl + gate_l[:, None, :] * y_l
        if need_ctx:
            xc = xc + gate_c * y_c
    return rmsnorm(xl, final_norm_g)
```

```cpp
#include <hip/hip_runtime.h>
#include <hip/hip_cooperative_groups.h>
#include <cstdio>
#include <cstdint>
namespace cg = cooperative_groups;

typedef unsigned short bf16_t;
typedef short bf16x8 __attribute__((ext_vector_type(8)));
typedef float f32x4 __attribute__((ext_vector_type(4)));

#define MFMA(a, b, c) __builtin_amdgcn_mfma_f32_16x16x32_bf16(a, b, c, 0, 0, 0)
#define DEV __device__ __forceinline__

constexpr int NTOK = 36864;
constexpr int GROWS = 4608;
constexpr int HALF_LDS = 73728;
constexpr int LDS_BYTES = 2 * HALF_LDS + 64;
constexpr int NTHR = 512;
constexpr float EPSN = 1e-6f;
constexpr int KOFF = 0, VOFF = 256, UOFF = 512, GATT = 1536, QOFF = 2560, GS5 = 3584, F2LD = 4608, F2CLD = 1536;

constexpr size_t WS_WIN1 = 0;
constexpr size_t WS_WGLU = WS_WIN1 + 9437184;
constexpr size_t WS_WOUT1 = WS_WGLU + 4194304;
constexpr size_t WS_XC = WS_WOUT1 + 4194304;
constexpr size_t WS_MOD = WS_XC + 16777216;
constexpr size_t WS_LB = WS_MOD + 417792;
constexpr size_t WS_ROPE = WS_LB + 8192;
constexpr size_t WS_A32 = WS_ROPE + 8192;
constexpr size_t WS_PW = WS_A32 + 65536;
constexpr size_t WS_BB = WS_PW + 2162688;
constexpr size_t WS_R1 = WS_BB + 1048576;
constexpr size_t WS_WIN0 = WS_R1;
constexpr size_t WS_WOUT0 = WS_WIN0 + 18874368;
constexpr size_t WS_WX = WS_R1;
constexpr size_t WS_KT2 = WS_WX + 16777216;
constexpr size_t WS_VT = WS_KT2 + 2064384;
constexpr size_t WS_H = WS_R1 + 35618816;
constexpr size_t WS_S = WS_H + 75497472;
constexpr size_t WS_R3 = WS_S + 37748736;
constexpr size_t WS_FEATB = WS_R3;
constexpr size_t WS_FEATF = WS_FEATB + 56623104;
constexpr size_t WS_QD = WS_FEATF + 56623104;
constexpr size_t WS_KTT = WS_QD + 28311552;
constexpr size_t WS_ATT = WS_KTT + 28311552;
constexpr size_t WS_DEC = WS_ATT + 7077888;
constexpr size_t WS_VTT = WS_DEC + 1769472;
constexpr size_t WS_GATES = WS_VTT + 18874368;
constexpr size_t WS_OF = WS_GATES + 37748736;
constexpr size_t WS_OB = WS_OF + 37748736;
constexpr size_t WS_VTT1 = WS_FEATF + 28311552;
constexpr size_t OBUF = 18874368;
static_assert(WS_OB + 37748736 <= WS_R3 + 314572800, "layer-0 buffers overflow region 3");
constexpr size_t WS_F2L = WS_R3;
constexpr size_t WS_F2C = WS_F2L + 301989888;
constexpr size_t WS_END = WS_F2C + 12582912;
constexpr size_t WS_BAR = WS_END;
constexpr size_t WS_TOTAL = WS_BAR + 16384;
constexpr size_t F2C_DELTA = (WS_F2C - WS_F2L) / 2;

struct P {
    const float *x, *c, *ctx, *c_ctx, *ada_w, *ada_b, *norm_g, *final_g, *ev_w_in, *ev_w_out, *gk_w, *gk_b, *gla_g, *lb_raw, *hg_g,
        *od_w_in, *od_w_out, *sink, *lam_re, *lam_im, *log_dt, *b_re, *b_im, *c_re, *c_im, *s5_d, *glu_w;
    float* out;
    unsigned char* ws;
};

DEV int tid_l() { int t = threadIdx.x; asm volatile("" : "+v"(t)); return t; }
typedef __bf16 bf16v2_t __attribute__((ext_vector_type(2)));
typedef float f32v2_t __attribute__((ext_vector_type(2)));
DEV unsigned pk(float a, float b) { const f32v2_t v = {a, b}; return __builtin_bit_cast(unsigned, __builtin_convertvector(v, bf16v2_t)); }
DEV bf16_t f2bf(float f) { return __builtin_bit_cast(bf16_t, (__bf16)f); }
typedef _Float16 h16v2_t __attribute__((ext_vector_type(2)));
typedef _Float16 h16v8_t __attribute__((ext_vector_type(8)));
DEV unsigned pkh(float a, float b) { const h16v2_t v = {(_Float16)a, (_Float16)b}; return __builtin_bit_cast(unsigned, v); }
DEV void unpackh8(uint4 v, float* f) { const h16v8_t h = __builtin_bit_cast(h16v8_t, v); _Pragma("unroll") for (int e = 0; e < 8; ++e) f[e] = (float)h[e]; }
DEV float bflo(unsigned w) { return __uint_as_float(w << 16); }
DEV float bfhi(unsigned w) { return __uint_as_float(w & 0xffff0000u); }
DEV float bf2f(bf16_t b) { return __uint_as_float((unsigned)b << 16); }
DEV bf16x8 as8(uint4 v) { return __builtin_bit_cast(bf16x8, v); }
DEV float rcpf_(float x) { return __builtin_amdgcn_rcpf(x); }
DEV float sigmoidf_(float x) { return rcpf_(1.f + __expf(-x)); }
DEV float siluf_(float x) { return x * rcpf_(1.f + __expf(-x)); }
DEV float geluf_(float x) { float u = 0.7978845608028654f * (x + 0.044715f * x * x * x); float t = 1.f - 2.f * rcpf_(1.f + __expf(2.f * u)); return 0.5f * x * (1.f + t); }
DEV void unpack8(uint4 v, float* f) { f[0] = bflo(v.x); f[1] = bfhi(v.x); f[2] = bflo(v.y); f[3] = bfhi(v.y); f[4] = bflo(v.z); f[5] = bfhi(v.z); f[6] = bflo(v.w); f[7] = bfhi(v.w); }

namespace pg8 {
#define PG8_LAS __attribute__((address_space(3)))
typedef unsigned short bf16_t;
typedef short bf16x8 __attribute__((ext_vector_type(8)));
typedef float f32x4 __attribute__((ext_vector_type(4)));
typedef unsigned u32x4 __attribute__((ext_vector_type(4)));
constexpr int BM = 256, BK = 64, HALF = 128, HTB = HALF * BK * 2  , STAGE_BYTES = 8 * HTB, NXCD = 8, WGM = 8;

__host__ __device__ __forceinline__ int lds_byte(int r, int c) { const int st = (r >> 4) * 2 + (c >> 5), rr = r & 15, cc = c & 31, ob = rr * 64 + cc * 2; return st * 1024 + (ob ^ (((ob >> 9) & 1) << 5)); }
__host__ __device__ __forceinline__ void stage_rc(int b, int& R, int& C) { const int st = b / 1024, sb = b % 1024, swz = sb ^ (((sb >> 9) & 1) << 5); R = (st >> 1) * 16 + swz / 64; C = (st & 1) * 32 + (swz % 64) / 2; }
__host__ __device__ __forceinline__ int perm32(int rho) { const int n = rho >> 4, i = rho & 15; return 8 * (i >> 2) + 4 * n + (i & 3); }

struct Unit { int pm, pn; };
struct Gemm { const bf16_t* A; const bf16_t* Bt; int M, N, K, lda; };

struct StaticOrder {
    int nM, nN, nwg, G, c;
    __host__ __device__ void init(int M, int N, int G_, int c_) { nM = M / BM; nN = N / BM; nwg = nM * nN; G = G_; c = c_; }
    __host__ __device__ bool next(int i, Unit& u) const {
        const long L = (long)i * G + c; if (L >= nwg) return false;
        int wgid = (int)L; { const int q = nwg / NXCD, r = nwg % NXCD, xcd = wgid % NXCD, off = wgid / NXCD; wgid = (xcd < r ? xcd * (q + 1) : r * (q + 1) + (xcd - r) * q) + off; }
        const int nig = WGM * nN, gid = wgid / nig, fm = gid * WGM, gsz = (nM - fm) < WGM ? (nM - fm) : WGM;
        u.pm = fm + ((wgid % nig) % gsz); u.pn = (wgid % nig) / gsz; return true;
    }
    __device__ __forceinline__ void a_ready(const Unit&) const {}
    __device__ __forceinline__ void done(const Unit&) const {}
};
template <class Epi, class Sched, bool ALIGN_EPI = false, bool SP2 = false>
__device__ __forceinline__ void gemm_phase(PG8_LAS unsigned char* lds, const Gemm g, const Sched& S, const Epi& E) {
    const int tid = tid_l(), wid = __builtin_amdgcn_readfirstlane(tid >> 6), lane = tid & 63, wr = wid >> 2, wc = wid & 3, fr = lane & 15, fq = lane >> 4;
    const int K = g.K, nt = K / BK;
    unsigned voffA[2], voffB[2];
#pragma unroll
    for (int i = 0; i < 2; ++i) { int R, C; stage_rc(tid * 16 + i * 8192, R, C); const int Rb = Epi::PERM ? ((R & ~31) + perm32(R & 31)) : R;
        voffA[i] = (unsigned)(R * g.lda + C) * 2u; voffB[i] = (unsigned)(Rb * K + C) * 2u; }
    const size_t kstep = (size_t)(BK * 2);
    const size_t hstep = (size_t)HALF * K * 2, hstepA = (size_t)HALF * g.lda * 2, tstepA = 2 * hstepA;
    const size_t tstep = 2 * hstep;
    const unsigned ldsw = (unsigned)wid * 1024u;
    const int aoff = lds_byte(wr * 64 + fr, fq * 8), boff = lds_byte(wc * 32 + fr, fq * 8);
#define PG8_SA(b, h) (((b) * 2 + (h)) * HTB)
#define PG8_SB(b, h) ((4 + (b) * 2 + (h)) * HTB)
#define PG8_STAGE(bufoff, gbase, voff) do { _Pragma("unroll") for (int _i = 0; _i < 2; ++_i) \
        __builtin_amdgcn_global_load_lds((const unsigned*)((const char*)(gbase) + (voff)[_i]), (PG8_LAS unsigned*)(lds + (bufoff) + ldsw + _i * 8192), 16, 0, 0); } while (0)
#define PG8_LDA(dst, b, h) do { _Pragma("unroll") for (int m = 0; m < 4; ++m) _Pragma("unroll") for (int k = 0; k < 2; ++k) dst[m][k] = *(const PG8_LAS bf16x8*)(lds + PG8_SA(b, h) + aoff + m * 2048 + k * 1024); } while (0)
#define PG8_LDB(dst, b, h) do { _Pragma("unroll") for (int n = 0; n < 2; ++n) _Pragma("unroll") for (int k = 0; k < 2; ++k) dst[n][k] = *(const PG8_LAS bf16x8*)(lds + PG8_SB(b, h) + boff + n * 2048 + k * 1024); } while (0)
#define PG8_MMA(ai, bj, At, Bt) do { __builtin_amdgcn_s_setprio(1); _Pragma("unroll") for (int m = 0; m < 4; ++m) _Pragma("unroll") for (int n = 0; n < 2; ++n) _Pragma("unroll") for (int k = 0; k < 2; ++k) \
        acc[ai][bj][m][n] = __builtin_amdgcn_mfma_f32_16x16x32_bf16(Bt[n][k], At[m][k], acc[ai][bj][m][n], 0, 0, 0); __builtin_amdgcn_s_setprio(0); } while (0)
#define PG8_WAIT_V(n) asm volatile("s_waitcnt vmcnt(" #n ")" ::: "memory")
#define PG8_WAIT_L(n) asm volatile("s_waitcnt lgkmcnt(" #n ")" ::: "memory")
#define PG8_BAR __builtin_amdgcn_s_barrier()
#define PG8_SCHED __builtin_amdgcn_sched_barrier(0)
    Unit cur, nxt; int ui = 0;
    if (!S.next(0, cur)) return;
    f32x4 acc[2][2][4][2];
#pragma unroll
    for (int a = 0; a < 2; ++a)
#pragma unroll
        for (int b = 0; b < 2; ++b)
#pragma unroll
            for (int m = 0; m < 4; ++m)
#pragma unroll
                for (int n = 0; n < 2; ++n) acc[a][b][m][n] = (f32x4){0.f, 0.f, 0.f, 0.f};
    bf16x8 At[4][2], B0[2][2], B1[2][2];
    const char* cA = (const char*)g.A + (size_t)cur.pm * tstepA; const char* cB = (const char*)g.Bt + (size_t)cur.pn * tstep;
    S.a_ready(cur);
    if constexpr (SP2) {
        PG8_STAGE(PG8_SB(0, 0), cB, voffB); PG8_STAGE(PG8_SB(0, 1), cB + hstep, voffB); PG8_STAGE(PG8_SA(0, 0), cA, voffA); PG8_STAGE(PG8_SA(0, 1), cA + hstepA, voffA);
        if (wr == 1) PG8_BAR;
        PG8_WAIT_V(2); PG8_BAR;
        PG8_STAGE(PG8_SB(1, 0), cB + kstep, voffB); PG8_STAGE(PG8_SA(1, 0), cA + kstep, voffA); PG8_STAGE(PG8_SB(1, 1), cB + hstep + kstep, voffB);
        PG8_WAIT_V(6); PG8_BAR;
    } else {
        PG8_STAGE(PG8_SB(0, 0), cB, voffB); PG8_STAGE(PG8_SA(0, 0), cA, voffA); PG8_STAGE(PG8_SB(0, 1), cB + hstep, voffB); PG8_STAGE(PG8_SA(0, 1), cA + hstepA, voffA);
        if (wr == 1) PG8_BAR;
        PG8_WAIT_V(4); PG8_BAR;
        PG8_STAGE(PG8_SB(1, 0), cB + kstep, voffB); PG8_STAGE(PG8_SA(1, 0), cA + kstep, voffA); PG8_STAGE(PG8_SB(1, 1), cB + hstep + kstep, voffB);
        PG8_WAIT_V(6); PG8_BAR;
    }
    for (;;) {
        const bool has_next = S.next(ui + 1, nxt);
        const char* nA = has_next ? (const char*)g.A + (size_t)nxt.pm * tstepA : cA; const char* nB = has_next ? (const char*)g.Bt + (size_t)nxt.pn * tstep : cB;
        for (int t = 0; t < nt; t += 2) {
            const bool last = (t == nt - 2);
            const char* a1 = cA + (size_t)(t + 1) * kstep;
            const char* a2 = last ? nA : cA + (size_t)(t + 2) * kstep; const char* b2 = last ? nB : cB + (size_t)(t + 2) * kstep;
            const char* a3 = a2 + kstep; const char* b3 = b2 + kstep;
            if (last && has_next) S.a_ready(nxt);
            if constexpr (SP2) {
            PG8_LDB(B0, 0, 0); PG8_LDB(B1, 0, 1); PG8_SCHED; PG8_LDA(At, 0, 0); PG8_STAGE(PG8_SA(1, 1), a1 + hstepA, voffA);
            PG8_WAIT_V(8); PG8_WAIT_L(0); PG8_BAR; PG8_MMA(0, 0, At, B0); PG8_MMA(0, 1, At, B1); PG8_BAR; PG8_SCHED;
            PG8_LDA(At, 0, 1); PG8_STAGE(PG8_SB(0, 0), b2, voffB); PG8_STAGE(PG8_SB(0, 1), b2 + hstep, voffB); PG8_STAGE(PG8_SA(0, 0), a2, voffA);
            PG8_WAIT_V(8); PG8_WAIT_L(0); PG8_BAR; PG8_MMA(1, 0, At, B0); PG8_MMA(1, 1, At, B1); PG8_BAR; PG8_SCHED;
            PG8_LDB(B0, 1, 0); PG8_LDB(B1, 1, 1); PG8_SCHED; PG8_LDA(At, 1, 0); PG8_STAGE(PG8_SA(0, 1), a2 + hstepA, voffA);
            PG8_WAIT_V(8); PG8_WAIT_L(0); PG8_BAR; PG8_MMA(0, 0, At, B0); PG8_MMA(0, 1, At, B1); PG8_BAR; PG8_SCHED;
            PG8_LDA(At, 1, 1); PG8_STAGE(PG8_SB(1, 0), b3, voffB); PG8_STAGE(PG8_SB(1, 1), b3 + hstep, voffB); PG8_STAGE(PG8_SA(1, 0), a3, voffA);
            PG8_WAIT_V(8); PG8_WAIT_L(0); PG8_BAR; PG8_MMA(1, 0, At, B0); PG8_MMA(1, 1, At, B1); PG8_BAR; PG8_SCHED;
            } else {
            PG8_LDB(B0, 0, 0); PG8_SCHED; PG8_LDA(At, 0, 0); PG8_STAGE(PG8_SA(1, 1), a1 + hstepA, voffA);
            PG8_WAIT_L(8); PG8_BAR; PG8_WAIT_L(0); PG8_MMA(0, 0, At, B0); PG8_BAR; PG8_SCHED;
            PG8_LDB(B1, 0, 1); PG8_STAGE(PG8_SB(0, 0), b2, voffB);
            PG8_BAR; PG8_WAIT_L(0); PG8_MMA(0, 1, At, B1); PG8_BAR;
            PG8_LDA(At, 0, 1); PG8_STAGE(PG8_SA(0, 0), a2, voffA);
            PG8_BAR; PG8_WAIT_L(0); PG8_MMA(1, 0, At, B0); PG8_BAR; PG8_SCHED;
            PG8_STAGE(PG8_SB(0, 1), b2 + hstep, voffB);
            PG8_WAIT_V(6); PG8_BAR; PG8_MMA(1, 1, At, B1); PG8_BAR;
            PG8_LDB(B0, 1, 0); PG8_SCHED; PG8_LDA(At, 1, 0); PG8_STAGE(PG8_SA(0, 1), a2 + hstepA, voffA);
            PG8_WAIT_L(8); PG8_BAR; PG8_WAIT_L(0); PG8_MMA(0, 0, At, B0); PG8_BAR; PG8_SCHED;
            PG8_LDB(B1, 1, 1); PG8_STAGE(PG8_SB(1, 0), b3, voffB);
            PG8_BAR; PG8_WAIT_L(0); PG8_MMA(0, 1, At, B1); PG8_BAR;
            PG8_LDA(At, 1, 1); PG8_STAGE(PG8_SA(1, 0), a3, voffA);
            PG8_BAR; PG8_WAIT_L(0); PG8_MMA(1, 0, At, B0); PG8_BAR; PG8_SCHED;
            PG8_STAGE(PG8_SB(1, 1), b3 + hstep, voffB);
            PG8_WAIT_V(6); PG8_BAR; PG8_MMA(1, 1, At, B1); PG8_BAR;
            }
        }
        if constexpr (ALIGN_EPI) { if (wr == 0) PG8_BAR; }
        if constexpr (!Epi::AFTER_DRAIN) { E(acc, cur, wr, wc, fr, fq); S.done(cur); }
        if (!has_next) break;
#pragma unroll
        for (int a = 0; a < 2; ++a)
#pragma unroll
            for (int b = 0; b < 2; ++b)
#pragma unroll
                for (int m = 0; m < 4; ++m)
#pragma unroll
                    for (int n = 0; n < 2; ++n) acc[a][b][m][n] = (f32x4){0.f, 0.f, 0.f, 0.f};
        cur = nxt; cA = nA; cB = nB; ++ui;
        if constexpr (ALIGN_EPI) { if (wr == 1) PG8_BAR; }
    }
    PG8_WAIT_V(0);
    if constexpr (!ALIGN_EPI) { if (wr == 0) PG8_BAR; }
    PG8_BAR;
    if constexpr (Epi::AFTER_DRAIN) { E.fused(acc, cur, wr, wc, fr, fq, lds, wid, lane); S.done(cur); }
#undef PG8_SA
#undef PG8_SB
#undef PG8_STAGE
#undef PG8_LDA
#undef PG8_LDB
#undef PG8_MMA
#undef PG8_WAIT_V
#undef PG8_WAIT_L
#undef PG8_BAR
#undef PG8_SCHED
}
}

template <class AL, class BL, class EP>
__device__ __forceinline__ void gemm_tile(const AL& al, const BL& bl, const EP& ep, int m0, int n0, int K, unsigned char* lds) {
    const int tid = tid_l() & 255, lane = tid & 63, w = tid >> 6, wm = w >> 1, wn = w & 1;
    bf16_t* sA = (bf16_t*)lds;
    bf16_t* sB = sA + 2 * 128 * 72;
    const int lr = tid >> 3, lk = (tid & 7) * 8;
    f32x4 acc[4][4];
#pragma unroll
    for (int i = 0; i < 4; ++i)
#pragma unroll
        for (int j = 0; j < 4; ++j) acc[i][j] = (f32x4){0.f, 0.f, 0.f, 0.f};
    uint4 ra0[4], rb0[4], ra1[4], rb1[4];
#define GLOAD(RA, RB, KT) { const int k_ = (KT) * 64 + lk; _Pragma("unroll") for (int x = 0; x < 4; ++x) { RA[x] = al.load(m0 + lr + 32 * x, k_); RB[x] = bl.load(n0 + lr + 32 * x, k_); } }
#define LSTORE(RA, RB, BUF) { bf16_t* a_ = sA + (BUF) * 128 * 72; bf16_t* b_ = sB + (BUF) * 128 * 72; _Pragma("unroll") for (int x = 0; x < 4; ++x) { *(uint4*)(a_ + (lr + 32 * x) * 72 + lk) = RA[x]; *(uint4*)(b_ + (lr + 32 * x) * 72 + lk) = RB[x]; } }
#define COMPUTE(BUF) { const bf16_t* a_ = sA + (BUF) * 128 * 72; const bf16_t* b_ = sB + (BUF) * 128 * 72; \
        _Pragma("unroll") for (int kh = 0; kh < 2; ++kh) { bf16x8 fw[4], ft[4]; \
            _Pragma("unroll") for (int i = 0; i < 4; ++i) fw[i] = as8(*(const uint4*)(b_ + (wn * 64 + i * 16 + (lane & 15)) * 72 + kh * 32 + (lane >> 4) * 8)); \
            _Pragma("unroll") for (int j = 0; j < 4; ++j) ft[j] = as8(*(const uint4*)(a_ + (wm * 64 + j * 16 + (lane & 15)) * 72 + kh * 32 + (lane >> 4) * 8)); \
            _Pragma("unroll") for (int i = 0; i < 4; ++i) _Pragma("unroll") for (int j = 0; j < 4; ++j) acc[i][j] = MFMA(fw[i], ft[j], acc[i][j]); } }
    const int nk = K >> 6;
    __syncthreads();
    GLOAD(ra0, rb0, 0); GLOAD(ra1, rb1, 1);
    LSTORE(ra0, rb0, 0);
    __syncthreads();
    for (int kt = 0; kt < nk; kt += 2) {
        GLOAD(ra0, rb0, (kt + 2 < nk ? kt + 2 : nk - 1));
        COMPUTE(0);
        LSTORE(ra1, rb1, 1);
        __syncthreads();
        GLOAD(ra1, rb1, (kt + 3 < nk ? kt + 3 : nk - 1));
        COMPUTE(1);
        if (kt + 2 < nk) LSTORE(ra0, rb0, 0);
        __syncthreads();
    }
#undef GLOAD
#undef LSTORE
#undef COMPUTE
    ep(acc, m0 + wm * 64, n0 + wn * 64, lane);
}
DEV void tile_map8(int it, int NT, int& tm, int& tn) { const int x = it & 7, q = it >> 3, c = NT >> 3; tn = x + 8 * (q % c); tm = q / c; }

struct LdPlain { const bf16_t* base; int ld; DEV uint4 load(int row, int k) const { return *(const uint4*)(base + (size_t)row * ld + k); } };
struct LdH1L { const bf16_t* H; DEV uint4 load(int m, int k) const { const int b = m >> 11, t = m & 2047; return *(const uint4*)(H + (size_t)(b * 2304 + 256 + t) * 1024 + k); } };
struct LdH1C { const bf16_t* H; DEV uint4 load(int m, int k) const { const int b = m >> 8, j = m & 255; return *(const uint4*)(H + (size_t)(b * 2304 + j) * 1024 + k); } };
struct LdD { const bf16_t* F; DEV uint4 load(int m, int k) const { const int kk = k < 1024 ? QOFF + k : GS5 + k - 1024; return *(const uint4*)(F + (size_t)m * F2LD + kk); } };
struct LdS5X { const bf16_t* FL; int g;
    DEV uint4 load(int n, int k) const { const int b = n / 72, c = n - b * 72, i = k >> 4, h = k & 15;
        const size_t off = c < 8 ? F2C_DELTA + (size_t)(b * 256 + c * 32 + i) * F2CLD : (size_t)(b * 2048 + (c - 8) * 32 + i) * F2LD;
        return *(const uint4*)(FL + off + UOFF + g * 16 + h); } };
struct LdS5YA { const bf16_t* FL; const bf16_t* S; int g;
    DEV uint4 load(int n, int k) const { const int b = n >> 6, cl = n & 63;
        const bf16_t* p = k < 512 ? FL + (size_t)(b * 2048 + cl * 32 + (k >> 4)) * F2LD + UOFF + g * 16 + (k & 15) : S + ((size_t)(b * 72 + cl + 8) * 64 + g) * 256 + (k - 512);
        return *(const uint4*)p; } };
struct LdS5YB { const bf16_t* KT2; const bf16_t* VT; int g;
    DEV uint4 load(int col, int k) const { const int t = col >> 4, h = col & 15;
        const bf16_t* p = k < 512 ? KT2 + ((size_t)(g * 63 + (t - (k >> 4) + 31)) * 16 + h) * 16 + (k & 15) : VT + ((size_t)g * 512 + col) * 256 + (k - 512);
        return *(const uint4*)p; } };

#define PG_ROWS_COLS(...) \
    _Pragma("unroll") for (int ai = 0; ai < 2; ++ai) _Pragma("unroll") for (int m = 0; m < 4; ++m) { const int row = u.pm * 256 + ai * 128 + wr * 64 + m * 16 + fr; \
        _Pragma("unroll") for (int bj = 0; bj < 2; ++bj) _Pragma("unroll") for (int n = 0; n < 2; ++n) { const int col = u.pn * 256 + bj * 128 + wc * 32 + n * 16 + fq * 4; const f32x4 v = acc[ai][bj][m][n]; __VA_ARGS__ } }
struct PgA {
    static constexpr bool PERM = false, AFTER_DRAIN = false;
    unsigned char* ws; const float* gkb; int par;
    DEV void operator()(const f32x4 (&acc)[2][2][4][2], const pg8::Unit& u, int wr, int wc, int fr, int fq) const {
        bf16_t* featb = (bf16_t*)(ws + WS_FEATB); unsigned short* featf = (unsigned short*)(ws + WS_FEATF);   bf16_t* gates = (bf16_t*)(ws + WS_GATES + (size_t)par * OBUF);
        PG_ROWS_COLS(
            if ((col >= 2048 && col < 3072) || (col >= 7168 && col < 8192)) {
                const int oc = col < 3072 ? col - 2048 : col - 6144;
                uint2 o; o.x = pk(v[0], v[1]); o.y = pk(v[2], v[3]); *(uint2*)(gates + (size_t)row * 2048 + oc) = o;
            } else if ((col >= 1024 && col < 2048) || (col >= 6144 && col < 7168)) {
                const int vc = col < 2048 ? col - 1024 : col - 5120; const int bl_ = row / 2304, j_ = row - bl_ * 2304;
                bf16_t* vt = (bf16_t*)(ws + (par ? WS_VTT1 : WS_VTT)) + (((size_t)(bl_ * 72 + (j_ >> 5)) * 2048 + vc) * 32 + (j_ & 31));
                const unsigned p01 = pk(v[0], v[1]), p23 = pk(v[2], v[3]);
                vt[0] = (bf16_t)(p01 & 0xffffu); vt[32] = (bf16_t)(p01 >> 16); vt[64] = (bf16_t)(p23 & 0xffffu); vt[96] = (bf16_t)(p23 >> 16);
            } else if (col < 4096 || (col >= 6144 && col < 8192)) {
                const float s = col < 512 ? 0.08838834764831845f : 1.f; const int oc = col < 4096 ? col : col - 2048;
                uint2 o; o.x = pk(v[0] * s, v[1] * s); o.y = pk(v[2] * s, v[3] * s); *(uint2*)(featb + (size_t)row * 6144 + oc) = o;
            } else if (col < 6144) {
                const int cc = col - 4096;
                *(uint2*)(featf + (size_t)row * 3072 + cc) = make_uint2(pkh(v[0], v[1]), pkh(v[2], v[3]));
            } else {
                const int cc = col - 8192; const f32x4 bb = *(const f32x4*)(gkb + cc);
                *(uint2*)(featf + (size_t)row * 3072 + 2048 + cc) = make_uint2(pkh(v[0] + bb[0], v[1] + bb[1]), pkh(v[2] + bb[2], v[3] + bb[3]));
            })
    }
};
struct PgC {
    static constexpr bool PERM = false, AFTER_DRAIN = false;
    const float* x; const float* ctx; float* out; float* xc; const float* mod; int grp;
    DEV void operator()(const f32x4 (&acc)[2][2][4][2], const pg8::Unit& u, int wr, int wc, int fr, int fq) const {
        PG_ROWS_COLS(
            const int R = grp * GROWS + row; const int b = R / 2304, jj = R - b * 2304; const bool isc = jj < 256;
            const size_t ro = isc ? (size_t)(b * 256 + jj) * 1024 : (size_t)(b * 2048 + jj - 256) * 1024;
            const f32x4 s = *(const f32x4*)((isc ? ctx : x) + ro + col); const f32x4 gt = *(const f32x4*)(mod + (size_t)(isc ? 16 : b) * 3072 + 2048 + col);
            *(f32x4*)((isc ? xc : out) + ro + col) = s + gt * v; )
    }
};
struct PgB {
    static constexpr bool PERM = false, AFTER_DRAIN = false;
    bf16_t* F; int ld; const float2* rope; int latent;
    DEV void operator()(const f32x4 (&acc)[2][2][4][2], const pg8::Unit& u, int wr, int wc, int fr, int fq) const {
#pragma unroll
        for (int ai = 0; ai < 2; ++ai)
#pragma unroll
            for (int m = 0; m < 4; ++m) { const int row = u.pm * 256 + ai * 128 + wr * 64 + m * 16 + fr; const int t = row & 2047;
#pragma unroll
                for (int bj = 0; bj < 2; ++bj) { const int cb = u.pn * 256 + bj * 128 + wc * 32; f32x4 v0 = acc[ai][bj][m][0], v1 = acc[ai][bj][m][1];
                    const bool isq = cb >= QOFF && cb < QOFF + 1024;
                    if (latent && (cb < VOFF || isq)) { const float sc = isq ? 0.125f : 1.f; const int pos = (cb & 32) ? (t & 63) : (t >> 6); f32x4 o0, o1;
#pragma unroll
                        for (int r = 0; r < 4; ++r) { const float2 cs = rope[pos * 16 + fq * 4 + r]; o0[r] = (v0[r] * cs.x - v1[r] * cs.y) * sc; o1[r] = (v1[r] * cs.x + v0[r] * cs.y) * sc; }
                        v0 = o0; v1 = o1; }
                    uint2 o; o.x = pk(v0[0], v0[1]); o.y = pk(v0[2], v0[3]); *(uint2*)(F + (size_t)row * ld + cb + fq * 4) = o;
                    o.x = pk(v1[0], v1[1]); o.y = pk(v1[2], v1[3]); *(uint2*)(F + (size_t)row * ld + cb + 16 + fq * 4) = o; } }
    }
};
struct PgGLU {
    static constexpr bool PERM = false, AFTER_DRAIN = false;
    bf16_t* F;
    DEV void operator()(const f32x4 (&acc)[2][2][4][2], const pg8::Unit& u, int wr, int wc, int fr, int fq) const {
#pragma unroll
        for (int ai = 0; ai < 2; ++ai)
#pragma unroll
            for (int m = 0; m < 4; ++m) { const int row = u.pm * 256 + ai * 128 + wr * 64 + m * 16 + fr;
#pragma unroll
                for (int n = 0; n < 2; ++n) { const int oc = u.pn * 128 + wc * 32 + n * 16 + fq * 4; const f32x4 a = acc[ai][0][m][n], b = acc[ai][1][m][n];
                    bf16_t* pp = F + (size_t)row * F2LD + GS5 + oc; const uint2 gg = *(const uint2*)pp;
                    const float g0 = bflo(gg.x), g1 = bfhi(gg.x), g2 = bflo(gg.y), g3 = bfhi(gg.y);
                    uint2 o; o.x = pk(a[0] * sigmoidf_(b[0]) * siluf_(g0), a[1] * sigmoidf_(b[1]) * siluf_(g1)); o.y = pk(a[2] * sigmoidf_(b[2]) * siluf_(g2), a[3] * sigmoidf_(b[3]) * siluf_(g3));
                    *(uint2*)pp = o; } }
    }
};
struct PgD {
    static constexpr bool PERM = false, AFTER_DRAIN = false;
    float* out; const float* mod;
    DEV void operator()(const f32x4 (&acc)[2][2][4][2], const pg8::Unit& u, int wr, int wc, int fr, int fq) const {
        PG_ROWS_COLS(
            float* dst = out + (size_t)row * 1024 + col; const f32x4 gt = *(const f32x4*)(mod + (size_t)(row >> 11) * 3072 + 2048 + col);
            *(f32x4*)dst = *(const f32x4*)dst + gt * v; )
    }
};
struct EpiS5X { bf16_t* S; int g, dir;
    DEV void operator()(f32x4 (&acc)[4][4], int mrow0, int ncol0, int lane) const {
#pragma unroll
        for (int j = 0; j < 4; ++j) { const int n = mrow0 + j * 16 + (lane & 15);
#pragma unroll
            for (int i = 0; i < 4; ++i) { const int col = ncol0 + i * 16 + (lane >> 4) * 4; const f32x4 v = acc[i][j];
                uint2 o; o.x = pk(v[0], v[1]); o.y = pk(v[2], v[3]); *(uint2*)(S + (((size_t)n * 64 + g) * 2 + dir) * 128 + col) = o; } }
    }
};
struct EpiS5Y { const bf16_t* FL; bf16_t* Z; const float* dsk; int g;
    DEV void operator()(f32x4 (&acc)[4][4], int mrow0, int ncol0, int lane) const {
#pragma unroll
        for (int j = 0; j < 4; ++j) { const int n = mrow0 + j * 16 + (lane & 15); const int b = n >> 6, cl = n & 63;
#pragma unroll
            for (int i = 0; i < 4; ++i) { const int t = (ncol0 >> 4) + i, h = (lane >> 4) * 4; const f32x4 v = acc[i][j];
                const size_t m = (size_t)b * 2048 + cl * 32 + t; const uint2 uu = *(const uint2*)(FL + m * F2LD + UOFF + g * 16 + h);
                const float4 dd = *(const float4*)(dsk + g * 16 + h);
                uint2 o; o.x = pk(geluf_(v[0] + dd.x * bflo(uu.x)), geluf_(v[1] + dd.y * bfhi(uu.x))); o.y = pk(geluf_(v[2] + dd.z * bflo(uu.y)), geluf_(v[3] + dd.w * bfhi(uu.y)));
                *(uint2*)(Z + m * 1024 + g * 16 + h) = o; } }
    }
};

template <class MAP>
__device__ __forceinline__ void transpose_tile(const float* src, int ldsrc, bf16_t* dst, int K, int n0, int k0, const MAP& map, unsigned char* lds) {
    float* tile = (float*)lds;
    const int tid = tid_l() & 255;
    __syncthreads();
#pragma unroll
    for (int e = 0; e < 16; ++e) { const int idx = tid + e * 256; const int kk = idx >> 6, nn = idx & 63; tile[kk * 65 + nn] = src[(size_t)(k0 + kk) * ldsrc + map(n0 + nn)]; }
    __syncthreads();
    const int nn = tid >> 2, kq = (tid & 3) * 16;
    unsigned o[8];
#pragma unroll
    for (int e = 0; e < 8; ++e) o[e] = pk(tile[(kq + 2 * e) * 65 + nn], tile[(kq + 2 * e + 1) * 65 + nn]);
    uint4* d = (uint4*)(dst + (size_t)(n0 + nn) * K + k0 + kq);
    d[0] = make_uint4(o[0], o[1], o[2], o[3]); d[1] = make_uint4(o[4], o[5], o[6], o[7]);
}
struct MapIn0 { DEV int operator()(int n) const { return n < 2048 ? n : n + 32; } };
struct MapId { DEV int operator()(int n) const { return n; } };
struct MapIn1 { DEV int operator()(int n) const { return n < 512 ? n + 1024 : n < 1536 ? n + 2048 : n < 2560 ? n : n < 3584 ? n - 2560 : n; } };
struct MapGlu { DEV int operator()(int n) const { return ((n >> 7) & 1) * 1024 + (n >> 8) * 128 + (n & 127); } };

__device__ __forceinline__ void prep_phase(const P& p, unsigned char* lds) {
    unsigned char* ws = p.ws;
    const int tid5 = tid_l(), half = tid5 >> 8, tid = tid5 & 255, nb = gridDim.x, bid = blockIdx.x;
    lds += half * HALF_LDS;
    constexpr int N_IN0 = 128 * 16, N_G = 16 * 16, N_OUT0 = 16 * 32, N_IN1 = 72 * 16, N_GLU = 32 * 16, N_OUT1 = 16 * 32, N_ADA = 96;
    constexpr int E0 = N_IN0, E1 = E0 + N_G, E2 = E1 + N_OUT0, E3 = E2 + N_IN1, E4 = E3 + N_GLU, E5 = E4 + N_OUT1, E6 = E5 + N_ADA;
    for (int it = bid * 2 + half; it < E6; it += nb * 2) {
        if (it < E0) { transpose_tile(p.ev_w_in, 8224, (bf16_t*)(ws + WS_WIN0), 1024, (it >> 4) * 64, (it & 15) * 64, MapIn0(), lds); }
        else if (it < E1) {
            const int i2 = it - E0; const int n0 = (i2 >> 4) * 64, k0 = (i2 & 15) * 64; const int nn = tid >> 2, kq = (tid & 3) * 16;
            const int n = n0 + nn, dd = n >> 9, cc = n & 511; float gw[16];
#pragma unroll
            for (int r = 0; r < 16; ++r) gw[r] = p.gk_w[(size_t)(dd * 16 + r) * 512 + cc];
            unsigned o[8];
#pragma unroll
            for (int e = 0; e < 8; ++e) { float v2[2];
#pragma unroll
                for (int q = 0; q < 2; ++q) { const float* wr = p.ev_w_in + (size_t)(k0 + kq + 2 * e + q) * 8224 + 2048 + dd * 16; float a = 0.f;
#pragma unroll
                    for (int r = 0; r < 16; ++r) a += wr[r] * gw[r];
                    v2[q] = a; }
                o[e] = pk(v2[0], v2[1]); }
            uint4* d = (uint4*)((bf16_t*)(ws + WS_WIN0) + (size_t)(8192 + n) * 1024 + k0 + kq);
            d[0] = make_uint4(o[0], o[1], o[2], o[3]); d[1] = make_uint4(o[4], o[5], o[6], o[7]);
        }
        else if (it < E2) { const int i2 = it - E1; transpose_tile(p.ev_w_out, 1024, (bf16_t*)(ws + WS_WOUT0), 2048, (i2 >> 5) * 64, (i2 & 31) * 64, MapId(), lds); }
        else if (it < E3) { const int i2 = it - E2; transpose_tile(p.od_w_in, 4608, (bf16_t*)(ws + WS_WIN1), 1024, (i2 >> 4) * 64, (i2 & 15) * 64, MapIn1(), lds); }
        else if (it < E4) { const int i2 = it - E3; transpose_tile(p.glu_w, 2048, (bf16_t*)(ws + WS_WGLU), 1024, (i2 >> 4) * 64, (i2 & 15) * 64, MapGlu(), lds); }
        else if (it < E5) { const int i2 = it - E4; transpose_tile(p.od_w_out, 1024, (bf16_t*)(ws + WS_WOUT1), 2048, (i2 >> 5) * 64, (i2 & 31) * 64, MapId(), lds); }
        else {
            const int i2 = it - E5; const int layer = i2 / 48, col0 = (i2 % 48) * 64;
            float* sc = (float*)lds;
            __syncthreads();
            for (int idx = tid; idx < 17 * 1024; idx += 256) { const int r = idx >> 10, k = idx & 1023; const float v = r < 16 ? p.c[r * 1024 + k] : p.c_ctx[k]; sc[idx] = v / (1.f + expf(-v)); }
            __syncthreads();
            const int cl = tid & 63, kq = tid >> 6; float a[17];
#pragma unroll
            for (int r = 0; r < 17; ++r) a[r] = 0.f;
            const float* wp = p.ada_w + (size_t)layer * 1024 * 3072 + col0 + cl;
            for (int k = kq * 256; k < kq * 256 + 256; k += 8) { float wv[8];
#pragma unroll
                for (int j = 0; j < 8; ++j) wv[j] = wp[(size_t)(k + j) * 3072];
#pragma unroll
                for (int j = 0; j < 8; ++j)
#pragma unroll
                    for (int r = 0; r < 17; ++r) a[r] += sc[r * 1024 + k + j] * wv[j]; }
            __syncthreads();
#pragma unroll
            for (int r = 0; r < 17; ++r) sc[(kq * 17 + r) * 64 + cl] = a[r];
            __syncthreads();
            for (int idx = tid; idx < 17 * 64; idx += 256) { const int r = idx >> 6, c2 = idx & 63;
                const float v = sc[(0 * 17 + r) * 64 + c2] + sc[(1 * 17 + r) * 64 + c2] + sc[(2 * 17 + r) * 64 + c2] + sc[(3 * 17 + r) * 64 + c2];
                ((float*)(ws + WS_MOD))[((size_t)layer * 17 + r) * 3072 + col0 + c2] = v + p.ada_b[layer * 3072 + col0 + c2]; }
        }
    }
    const int gt = bid * NTHR + tid5, gs = nb * NTHR;
    for (int idx = gt; idx < 2048; idx += gs) { const int d = idx >> 10, col = idx & 1023; const float r0 = p.lb_raw[d * 2048 + col], r1 = p.lb_raw[d * 2048 + 1024 + col]; ((float*)(ws + WS_LB))[idx] = 1.f / (1.f + expf(r1 - r0)); }
    for (int idx = gt; idx < 1024; idx += gs) { const int pos = idx >> 4, i = idx & 15; const float fr = powf(10000.f, -(float)i / 16.f); float s, c; sincosf((float)pos * fr, &s, &c); ((float2*)(ws + WS_ROPE))[idx] = make_float2(c, s); }
    for (int idx = gt; idx < 128 * 33 * 64; idx += gs) { const int pp = idx & 63, m = (idx >> 6) % 33, gd = idx / (64 * 33), g = gd >> 1, dir = gd & 1;
        const float lre = p.lam_re[dir * 4096 + g * 64 + pp], lim = p.lam_im[dir * 4096 + g * 64 + pp], dt = expf(p.log_dt[dir * 64 + g]);
        const float mag = expf(lre * dt * (float)m); float s, c; sincosf(lim * dt * (float)m, &s, &c); ((float2*)(ws + WS_PW))[idx] = make_float2(mag * c, mag * s); }
    for (int idx = gt; idx < 128 * 64 * 16; idx += gs) { const int h = idx & 15, pp = (idx >> 4) & 63, gd = idx >> 10, g = gd >> 1, dir = gd & 1;
        const float lre = p.lam_re[dir * 4096 + g * 64 + pp], lim = p.lam_im[dir * 4096 + g * 64 + pp], dt = expf(p.log_dt[dir * 64 + g]);
        const float mag = expf(lre * dt); float s, c; sincosf(lim * dt, &s, &c); const float xr = mag * c - 1.f, xi = mag * s, den = lre * lre + lim * lim;
        const float qr = (xr * lre + xi * lim) / den, qi = (xi * lre - xr * lim) / den; const float br = p.b_re[(g * 64 + pp) * 16 + h], bi = p.b_im[(g * 64 + pp) * 16 + h];
        ((float2*)(ws + WS_BB))[idx] = make_float2(qr * br - qi * bi, qr * bi + qi * br); }
}

__device__ __forceinline__ void normmod_phase(const P& p, int layer, int tok_lo, int tok_hi, int blk0, int nblk) {
    const int tid = tid_l(); const int lane = tid & 63, w = tid >> 6;
    const float* xc = (const float*)(p.ws + WS_XC); const float* mod = (const float*)(p.ws + WS_MOD) + (size_t)layer * 17 * 3072;
    bf16_t* H = (bf16_t*)(p.ws + WS_H); const float* ng = p.norm_g + layer * 1024;
    for (int tok = tok_lo + (blockIdx.x - blk0) * 8 + w; tok < tok_hi; tok += nblk * 8) {
        const int b = tok / 2304, j = tok - b * 2304; const bool isc = j < 256;
        const float* src = isc ? (layer == 0 ? p.ctx : xc) + (size_t)(b * 256 + j) * 1024 : (layer == 0 ? p.x : p.out) + (size_t)(b * 2048 + j - 256) * 1024;
        const float* md = mod + (size_t)(isc ? 16 : b) * 3072;
        const int hrow = layer == 0 ? tok : (isc ? 32768 + b * 256 + j : b * 2048 + j - 256);
        float4 v[4]; float ss = 0.f;
#pragma unroll
        for (int m = 0; m < 4; ++m) { v[m] = *(const float4*)(src + m * 256 + lane * 4); ss += v[m].x * v[m].x + v[m].y * v[m].y + v[m].z * v[m].z + v[m].w * v[m].w; }
#pragma unroll
        for (int o = 32; o >= 1; o >>= 1) ss += __shfl_xor(ss, o);
        const float rs = rsqrtf(ss * (1.f / 1024.f) + EPSN);
#pragma unroll
        for (int m = 0; m < 4; ++m) { const int col = m * 256 + lane * 4; const float4 g = *(const float4*)(ng + col), sh = *(const float4*)(md + col), sc = *(const float4*)(md + 1024 + col);
            uint2 o; o.x = pk(v[m].x * rs * g.x * (1.f + sc.x) + sh.x, v[m].y * rs * g.y * (1.f + sc.y) + sh.y); o.y = pk(v[m].z * rs * g.z * (1.f + sc.z) + sh.z, v[m].w * rs * g.w * (1.f + sc.w) + sh.w);
            *(uint2*)(H + (size_t)hrow * 1024 + col) = o; }
    }
}

__device__ __forceinline__ void pre_phase(const P& p, int par, int half, unsigned char* lds) {
    const int tid = tid_l() & 255, lane = tid & 63, w = tid >> 6;
    float* sG = (float*)lds;
    bf16_t* sQ = (bf16_t*)(lds + 33792);
    bf16_t* sK = sQ + 32 * 136;
    bf16_t* sT = sK + 32 * 136;
    bf16_t* sAtt = sT + 128 * 40;
    const bf16_t* FB = (const bf16_t*)(p.ws + WS_FEATB); const unsigned short* FF = (const unsigned short*)(p.ws + WS_FEATF);
    const int li = tid >> 3, seg = tid & 7, stride = gridDim.x * 2;
    uint4 nq0, nq1, nk0, nk1, ng00, ng01, ng10, ng11;
#define PRE_DEC(IT) const int chunk = (IT) % 72, t2 = (IT) / 72, head12 = t2 % 12, bl = t2 / 12; const int hgrn = head12 >= 4, head = hgrn ? head12 - 4 : head12; \
        const size_t row = (size_t)bl * 2304 + chunk * 32 + li;
#define PRE_LOAD(IT) { PRE_DEC(IT) const bf16_t* fb_ = FB + row * 6144; const int qo_ = hgrn ? 3072 + head * 128 : head * 128, ko_ = hgrn ? qo_ : 512 + head * 128; \
        nq0 = *(const uint4*)(fb_ + qo_ + seg * 16); nq1 = *(const uint4*)(fb_ + qo_ + seg * 16 + 8); nk0 = *(const uint4*)(fb_ + ko_ + seg * 16); nk1 = *(const uint4*)(fb_ + ko_ + seg * 16 + 8); \
        const unsigned short* f0_ = FF + row * 3072 + (hgrn ? head * 128 : 2048 + head * 128) + seg * 16; const unsigned short* f1_ = f0_ + (hgrn ? 1024 : 512); \
        ng00 = *(const uint4*)(f0_); ng01 = *(const uint4*)(f0_ + 8); ng10 = *(const uint4*)(f1_); ng11 = *(const uint4*)(f1_ + 8); }
    int it = blockIdx.x * 2 + half;
    if (it < 1728) PRE_LOAD(it)
    for (; it < 1728; it += stride) {
        PRE_DEC(it)
        const bf16_t* fb = FB + row * 6144;
        float q[16], kk_[16], g0[16], g1[16];
        unpack8(nq0, q); unpack8(nq1, q + 8); unpack8(nk0, kk_); unpack8(nk1, kk_ + 8);
        unpackh8(ng00, g0); unpackh8(ng01, g0 + 8); unpackh8(ng10, g1); unpackh8(ng11, g1 + 8);
        float kh0[16], kh1[16];
#pragma unroll
        for (int e = 0; e < 16; ++e) { kh0[e] = 0.f; kh1[e] = 0.f; }
        if (hgrn) {
            const float* lbp = (const float*)(p.ws + WS_LB) + head * 128 + seg * 16;
#pragma unroll
            for (int e4 = 0; e4 < 4; ++e4) { const float4 l0 = *(const float4*)(lbp + e4 * 4), l1 = *(const float4*)(lbp + 1024 + e4 * 4); const float la[4] = {l0.x, l0.y, l0.z, l0.w}, lc[4] = {l1.x, l1.y, l1.z, l1.w};
#pragma unroll
                for (int r = 0; r < 4; ++r) { const int e = e4 * 4 + r; const float f0 = la[r] + (1.f - la[r]) * rcpf_(1.f + __expf(-g0[e])), f1 = lc[r] + (1.f - lc[r]) * rcpf_(1.f + __expf(-g1[e]));
                    kh0[e] = 1.f - f0; kh1[e] = 1.f - f1; g0[e] = __logf(f0); g1[e] = __logf(f1); } }
        } else {
#pragma unroll
            for (int e = 0; e < 16; ++e) { g0[e] = (fminf(g0[e], 0.f) - __logf(1.f + __expf(-fabsf(g0[e])))) * 0.0625f; g1[e] = (fminf(g1[e], 0.f) - __logf(1.f + __expf(-fabsf(g1[e])))) * 0.0625f; }
        }
        { const int nx = it + stride < 1728 ? it + stride : it; PRE_LOAD(nx) }
#pragma unroll
        for (int e = 0; e < 4; ++e) { *(float4*)(sG + li * 132 + seg * 16 + e * 4) = make_float4(g0[4 * e], g0[4 * e + 1], g0[4 * e + 2], g0[4 * e + 3]);
            *(float4*)(sG + 32 * 132 + li * 132 + seg * 16 + e * 4) = make_float4(g1[4 * e], g1[4 * e + 1], g1[4 * e + 2], g1[4 * e + 3]); }
        __syncthreads();
        { float* pl = sG + (tid >> 7) * 32 * 132 + (tid & 127); float a = 0.f;
#pragma unroll
            for (int i = 0; i < 32; ++i) { a += pl[i * 132]; pl[i * 132] = a; } }
        __syncthreads();
#pragma unroll
        for (int dir = 0; dir < 2; ++dir) {
            const int hd = hgrn ? 8 + head * 2 + dir : head * 2 + dir;
            const size_t hb = ((size_t)(bl * 24 + hd) * 72 + chunk);
            float g[16];
#pragma unroll
            for (int e = 0; e < 16; ++e) g[e] = dir ? g1[e] : g0[e];
            {
                unsigned oq[8], ok[8];
                float Pv[16], PLv[16];
                const float* sGd = sG + dir * 32 * 132;
#pragma unroll
                for (int e4 = 0; e4 < 4; ++e4) { const float4 a4 = *(const float4*)(sGd + li * 132 + seg * 16 + e4 * 4), b4 = *(const float4*)(sGd + 31 * 132 + seg * 16 + e4 * 4);
                    Pv[4 * e4] = a4.x; Pv[4 * e4 + 1] = a4.y; Pv[4 * e4 + 2] = a4.z; Pv[4 * e4 + 3] = a4.w; PLv[4 * e4] = b4.x; PLv[4 * e4 + 1] = b4.y; PLv[4 * e4 + 2] = b4.z; PLv[4 * e4 + 3] = b4.w; }
                bf16_t* qd_g = (bf16_t*)(p.ws + WS_QD) + hb * 4096 + li * 128 + (seg >> 1) * 32 + (seg & 1) * 4;
#pragma unroll
                for (int e = 0; e < 16; e += 2) {
                    float qd[2], ki[2];
#pragma unroll
                    for (int u = 0; u < 2; ++u) { const float Pi = Pv[e + u], PL = PLv[e + u];
                        const float bc = dir ? PL - Pi + g[e + u] : Pi; const float kv = hgrn ? (dir ? kh1[e + u] : kh0[e + u]) : kk_[e + u];
                        qd[u] = q[e + u] * __expf(bc); ki[u] = kv * __expf(fminf(-bc, 87.f)); const float ktl = kv * __expf(PL - bc);
                        sT[((e + u) * 8 + seg) * 40 + li] = f2bf(ktl);
                        if (li == 31) ((float*)(p.ws + WS_DEC))[hb * 128 + seg * 16 + e + u] = __expf(PL); }
                    oq[e >> 1] = pk(qd[0], qd[1]); ok[e >> 1] = pk(ki[0], ki[1]);
                }
                *(uint4*)(sQ + li * 136 + seg * 16) = make_uint4(oq[0], oq[1], oq[2], oq[3]); *(uint4*)(sQ + li * 136 + seg * 16 + 8) = make_uint4(oq[4], oq[5], oq[6], oq[7]);
                *(uint4*)(sK + li * 136 + seg * 16) = make_uint4(ok[0], ok[1], ok[2], ok[3]); *(uint4*)(sK + li * 136 + seg * 16 + 8) = make_uint4(ok[4], ok[5], ok[6], ok[7]);
#pragma unroll
                for (int qg = 0; qg < 4; ++qg) *(uint2*)(qd_g + qg * 8) = make_uint2(oq[qg * 2], oq[qg * 2 + 1]);
            }
            __syncthreads();
            {
                const int ti = w >> 1, tj = w & 1; f32x4 a = (f32x4){0.f, 0.f, 0.f, 0.f};
                if (dir ? !(ti == 1 && tj == 0) : !(ti == 0 && tj == 1)) {
#pragma unroll
                    for (int kk = 0; kk < 4; ++kk) { const bf16x8 A = as8(*(const uint4*)(sQ + (ti * 16 + (lane & 15)) * 136 + kk * 32 + (lane >> 4) * 8)); const bf16x8 B = as8(*(const uint4*)(sK + (tj * 16 + (lane & 15)) * 136 + kk * 32 + (lane >> 4) * 8)); a = MFMA(A, B, a); }
                }
#pragma unroll
                for (int r = 0; r < 4; ++r) { const int c = ti * 16 + (lane >> 4) * 4 + r, s2 = tj * 16 + (lane & 15); const bool keep = dir ? (s2 >= c) : (s2 <= c); sAtt[c * 40 + s2] = f2bf(keep ? a[r] : 0.f); }
            }
            __syncthreads();
            {
                const int d = tid >> 1, part = tid & 1; bf16_t* kt_g = (bf16_t*)(p.ws + WS_KTT) + hb * 4096 + d * 32 + part * 16;
                const int dr = (d & 15) * 8 + (d >> 4);
                *(uint4*)kt_g = *(const uint4*)(sT + dr * 40 + part * 16); *(uint4*)(kt_g + 8) = *(const uint4*)(sT + dr * 40 + part * 16 + 8);
                if (tid < 128) { const int r = tid >> 2, pt = tid & 3; *(uint4*)((bf16_t*)(p.ws + WS_ATT) + hb * 1024 + r * 32 + pt * 8) = *(const uint4*)(sAtt + r * 40 + pt * 8); }
            }
            if (dir == 0) __syncthreads();
        }
    }
#undef PRE_DEC
#undef PRE_LOAD
}

__device__ __forceinline__ void seq_block(const P& p, int par, int blk, unsigned char* lds) {
    const int tid = tid_l(), lane = tid & 63, w = tid >> 6, fr = lane & 15, fq = lane >> 4;
    int bl, hd, vcol0;
    if (blk < 32) { bl = blk >> 4; hd = (blk >> 1) & 7; vcol0 = (hd >> 1) * 256 + (blk & 1) * 128; } else { const int b2 = blk - 32; bl = b2 >> 4; hd = 8 + (b2 & 15); vcol0 = 1024 + ((hd - 8) >> 1) * 128; }
    const int dir = hd & 1, vcol = vcol0 + w * 16;
    bf16_t* O = (bf16_t*)(p.ws + (dir ? WS_OB : WS_OF) + (size_t)par * OBUF);
    const size_t hb = (size_t)(bl * 24 + hd) * 72;
    const size_t QDo = WS_QD + hb * 8192, KTo = WS_KTT + hb * 8192, ATo = WS_ATT + hb * 2048, DCo = WS_DEC + hb * 512, VTo = (par ? WS_VTT1 : WS_VTT) + (size_t)bl * 72 * 131072;
    const char* wsb = (const char*)p.ws;
    const size_t o0 = QDo + ((((w >> 2) * 16 + fr) * 128 + (w & 3) * 32 + fq * 8) * 2);
    const size_t o1 = w < 2 ? ATo + (((w * 16 + fr) * 32 + fq * 8) * 2) : KTo + ((((w - 2) * 16 + fr) * 32 + fq * 8) * 2);
    const size_t o2 = w < 2 ? KTo + ((((w + 6) * 16 + fr) * 32 + fq * 8) * 2) : DCo + (lane & 31) * 16;
    const size_t o3 = VTo + (((vcol + fr) * 32 + fq * 8) * 2);
    const char* b0 = wsb + o0; const char* b1 = wsb + o1; const char* b2 = wsb + o2; const char* b3 = wsb + o3;
    const unsigned s0 = 8192, s1 = w < 2 ? 2048u : 8192u, s2 = w < 2 ? 8192u : 512u, s3 = 131072;
    const int id0 = w, id1 = w + 8, id2 = w < 3 ? w + 16 : 18, id3 = 19 + w;
    f32x4 S[8];
#pragma unroll
    for (int d = 0; d < 8; ++d) S[d] = (f32x4){0.f, 0.f, 0.f, 0.f};
    uint4 stA0, stA1, stA2, stA3, stB0, stB1, stB2, stB3, stC0, stC1, stC2, stC3, stD0, stD1, stD2, stD3;
#define SQ_CH(CC) (dir ? ((CC) < 8 ? 7 - (CC) : 79 - (CC)) : (CC))
#define SQ_LOAD(ST, CC) { const size_t c_ = (size_t)SQ_CH((CC) < 72 ? (CC) : 71); ST##0 = *(const uint4*)(b0 + c_ * s0); ST##1 = *(const uint4*)(b1 + c_ * s1); ST##2 = *(const uint4*)(b2 + c_ * s2); ST##3 = *(const uint4*)(b3 + c_ * s3); }
#define SQ_STEP(ST, CC) { unsigned char* sl = lds + ((CC) & 1) * 27648; \
        *(uint4*)(sl + id0 * 1024 + lane * 16) = ST##0; *(uint4*)(sl + id1 * 1024 + lane * 16) = ST##1; if (w < 3) *(uint4*)(sl + id2 * 1024 + lane * 16) = ST##2; *(uint4*)(sl + id3 * 1024 + lane * 16) = ST##3; \
        SQ_LOAD(ST, (CC) + 4); \
        __syncthreads(); \
        const int c = SQ_CH(CC); \
        const bf16x8 Bv = as8(*(const uint4*)(sl + id3 * 1024 + lane * 16)); \
        bf16x8 SB[4]; \
        _Pragma("unroll") for (int kk = 0; kk < 4; ++kk) SB[kk] = as8(make_uint4(pk(S[2 * kk][0], S[2 * kk][1]), pk(S[2 * kk][2], S[2 * kk][3]), pk(S[2 * kk + 1][0], S[2 * kk + 1][1]), pk(S[2 * kk + 1][2], S[2 * kk + 1][3]))); \
        _Pragma("unroll") for (int ci = 0; ci < 2; ++ci) { f32x4 o = (f32x4){0.f, 0.f, 0.f, 0.f}; \
            o = MFMA(Bv, as8(*(const uint4*)(sl + (8 + ci) * 1024 + lane * 16)), o); \
            _Pragma("unroll") for (int kk = 0; kk < 4; ++kk) o = MFMA(SB[kk], as8(*(const uint4*)(sl + (ci * 4 + kk) * 1024 + lane * 16)), o); \
            uint2 ov; ov.x = pk(o[0], o[1]); ov.y = pk(o[2], o[3]); \
            *(uint2*)(O + ((size_t)bl * 2304 + c * 32 + ci * 16 + fr) * 2048 + vcol + fq * 4) = ov; } \
        _Pragma("unroll") for (int dt = 0; dt < 8; ++dt) { const f32x4 dcv = *(const f32x4*)(sl + 18 * 1024 + (dt * 4 + fq) * 16); \
            S[dt] = S[dt] * dcv; S[dt] = MFMA(as8(*(const uint4*)(sl + (10 + dt) * 1024 + lane * 16)), Bv, S[dt]); } }
    SQ_LOAD(stA, 0); SQ_LOAD(stB, 1); SQ_LOAD(stC, 2); SQ_LOAD(stD, 3);
    __syncthreads();
    for (int cc = 0; cc < 72; cc += 4) { SQ_STEP(stA, cc); SQ_STEP(stB, cc + 1); SQ_STEP(stC, cc + 2); SQ_STEP(stD, cc + 3); }
    __syncthreads();
#undef SQ_CH
#undef SQ_LOAD
#undef SQ_STEP
}

__device__ __forceinline__ void gatenorm_phase(const P& p, int par) {
    const int tid = tid_l(); const int lane = tid & 63, w = tid >> 6;
    bf16_t* OF = (bf16_t*)(p.ws + WS_OF + (size_t)par * OBUF); const bf16_t* OB = (const bf16_t*)(p.ws + WS_OB + (size_t)par * OBUF); const bf16_t* GT = (const bf16_t*)(p.ws + WS_GATES + (size_t)par * OBUF);
    for (int r = blockIdx.x * 8 + w; r < GROWS; r += gridDim.x * 8) {
#pragma unroll
        for (int m = 0; m < 4; ++m) { const int col = m * 512 + lane * 8;
            float a[8], b[8], gt[8]; unpack8(*(const uint4*)(OF + (size_t)r * 2048 + col), a); unpack8(*(const uint4*)(OB + (size_t)r * 2048 + col), b);
            unpack8(*(const uint4*)(GT + (size_t)r * 2048 + col), gt);
            float ss = 0.f;
#pragma unroll
            for (int e = 0; e < 8; ++e) { a[e] += b[e]; ss += a[e] * a[e]; }
            ss += __shfl_xor(ss, 1); ss += __shfl_xor(ss, 2); ss += __shfl_xor(ss, 4); ss += __shfl_xor(ss, 8);
            float rs; const float* gw;
            if (m < 2) { ss += __shfl_xor(ss, 16); rs = rsqrtf(ss * (1.f / 256.f) + EPSN); gw = p.gla_g + (col & 255); } else { rs = rsqrtf(ss * (1.f / 128.f) + EPSN); gw = p.hg_g + (col & 127); }
            unsigned o[4];
#pragma unroll
            for (int e = 0; e < 8; e += 2) o[e >> 1] = pk(a[e] * rs * gw[e] * siluf_(gt[e]), a[e + 1] * rs * gw[e + 1] * siluf_(gt[e + 1]));
            *(uint4*)(OF + (size_t)r * 2048 + col) = make_uint4(o[0], o[1], o[2], o[3]); }
    }
}

#define DPPF(V, CTRL) __builtin_bit_cast(float, __builtin_amdgcn_update_dpp(0, __builtin_bit_cast(int, (V)), (CTRL), 0xF, 0xF, false))
DEV float rowmax16(float v) { v = fmaxf(v, DPPF(v, 0xB1)); v = fmaxf(v, DPPF(v, 0x4E)); v = fmaxf(v, DPPF(v, 0x124)); v = fmaxf(v, DPPF(v, 0x128)); return v; }
DEV float rowsum16(float v) { v += DPPF(v, 0xB1); v += DPPF(v, 0x4E); v += DPPF(v, 0x124); v += DPPF(v, 0x128); return v; }
__device__ __forceinline__ void attn_item(const P& p, int item, unsigned char* lds) {
    const int tid = tid_l() & 255, lane = tid & 63, w = tid >> 6, fr = lane & 15, fq = lane >> 4;
    bf16_t* sKb = (bf16_t*)lds;
    bf16_t* sVb = sKb + 2 * 64 * 72;
    bf16_t* FL = (bf16_t*)(p.ws + WS_F2L);
    const int nb = (item >> 1) & 15, hq = ((item >> 5) & 7) * 2 + (item & 1), b = item >> 8, kv = hq >> 2;
    const float sinkv = p.sink[hq];
    const size_t qrow0 = (size_t)b * 2048 + nb * 128 + w * 32;
    bf16x8 qf[2][2];
#pragma unroll
    for (int rt = 0; rt < 2; ++rt)
#pragma unroll
        for (int kk = 0; kk < 2; ++kk) qf[rt][kk] = as8(*(const uint4*)(FL + (qrow0 + rt * 16 + fr) * F2LD + QOFF + hq * 64 + kk * 32 + fq * 8));
    float mrow[2], lrow[2]; f32x4 o[2][4];
#pragma unroll
    for (int rt = 0; rt < 2; ++rt) { mrow[rt] = sinkv; lrow[rt] = fq == 0 ? 1.f : 0.f;
#pragma unroll
        for (int dt = 0; dt < 4; ++dt) o[rt][dt] = (f32x4){0.f, 0.f, 0.f, 0.f}; }
    const int bt_lo = nb == 0 ? 2 : 0, ntile = 4 + ((nb == 15 ? 3 : 5) - bt_lo + 1);
    uint4 rk0, rk1, rv0, rv1;
#define AT_LOAD(T) { const int t_ = (T) < ntile ? (T) : ntile - 1; const bool cx_ = t_ < 4; const int kp_ = (nb - 1) * 128 + (bt_lo + t_ - 4) * 64; \
        const size_t ro_ = cx_ ? F2C_DELTA + (size_t)(b * 256 + t_ * 64) * F2CLD : (size_t)(b * 2048 + kp_) * F2LD; const int ld_ = cx_ ? F2CLD : F2LD; \
        const bf16_t* kp0_ = FL + ro_ + kv * 64 + (size_t)(tid >> 3) * ld_ + (tid & 7) * 8; \
        rk0 = *(const uint4*)(kp0_ + KOFF); rk1 = *(const uint4*)(kp0_ + (size_t)32 * ld_ + KOFF); \
        const bf16_t* vp0_ = FL + ro_ + kv * 64 + VOFF + (size_t)(tid & 63) * ld_ + (tid >> 6) * 16;     \
        rv0 = *(const uint4*)vp0_; rv1 = *(const uint4*)(vp0_ + 8); }
#define AT_STAGE(BUF) { bf16_t* sK = sKb + (BUF) * 64 * 72; bf16_t* sVT = sVb + (BUF) * 64 * 72; const int key = tid >> 3, ds = (tid & 7) * 8; \
        *(uint4*)(sK + key * 72 + ds) = rk0; *(uint4*)(sK + (key + 32) * 72 + ds) = rk1; \
        const unsigned vw0[4] = {rv0.x, rv0.y, rv0.z, rv0.w}; const unsigned vw1[4] = {rv1.x, rv1.y, rv1.z, rv1.w}; \
        const int vk = tid & 63, vd = (tid >> 6) * 16; \
        _Pragma("unroll") for (int e2 = 0; e2 < 4; ++e2) { sVT[(vd + 2 * e2) * 72 + vk] = (bf16_t)(vw0[e2] & 0xffffu); sVT[(vd + 2 * e2 + 1) * 72 + vk] = (bf16_t)(vw0[e2] >> 16); \
            sVT[(vd + 8 + 2 * e2) * 72 + vk] = (bf16_t)(vw1[e2] & 0xffffu); sVT[(vd + 8 + 2 * e2 + 1) * 72 + vk] = (bf16_t)(vw1[e2] >> 16); } }
    __syncthreads();
    AT_LOAD(0); AT_STAGE(0); AT_LOAD(1);
    __syncthreads();
    for (int tile = 0; tile < ntile; ++tile) {
        const bool masked = tile >= 4; const int kpos0 = (nb - 1) * 128 + (bt_lo + tile - 4) * 64;
        if (tile + 1 < ntile) AT_STAGE((tile + 1) & 1);
        AT_LOAD(tile + 2);
        const bf16_t* sK = sKb + (tile & 1) * 64 * 72; const bf16_t* sVT = sVb + (tile & 1) * 64 * 72;
        f32x4 s[2][4];
        __builtin_amdgcn_s_setprio(1);
#pragma unroll
        for (int kt = 0; kt < 4; ++kt) { const bf16x8 K0 = as8(*(const uint4*)(sK + (kt * 16 + fr) * 72 + fq * 8)), K1 = as8(*(const uint4*)(sK + (kt * 16 + fr) * 72 + 32 + fq * 8));
#pragma unroll
            for (int rt = 0; rt < 2; ++rt) { f32x4 a = (f32x4){0.f, 0.f, 0.f, 0.f}; a = MFMA(K0, qf[rt][0], a); a = MFMA(K1, qf[rt][1], a); s[rt][kt] = a; } }
        __builtin_amdgcn_s_setprio(0);
        const int q0w = nb * 128 + w * 32;
        if (masked && (kpos0 < q0w + 31 - 128 || kpos0 + 63 > q0w + 128)) {
#pragma unroll
            for (int rt = 0; rt < 2; ++rt)
#pragma unroll
                for (int kt = 0; kt < 4; ++kt)
#pragma unroll
                    for (int r = 0; r < 4; ++r) { const int qpos = nb * 128 + w * 32 + rt * 16 + fr, kpos = kpos0 + kt * 16 + fq * 4 + r; const int d = qpos - kpos; if (d > 128 || d < -128) s[rt][kt][r] = -1e30f; }
        }
        bf16x8 PB[2][2];
#pragma unroll
        for (int rt = 0; rt < 2; ++rt) {
            float mx = -1e30f;
#pragma unroll
            for (int kt = 0; kt < 4; ++kt) mx = fmaxf(mx, fmaxf(fmaxf(s[rt][kt][0], s[rt][kt][1]), fmaxf(s[rt][kt][2], s[rt][kt][3])));
            mx = fmaxf(mx, __shfl_xor(mx, 16)); mx = fmaxf(mx, __shfl_xor(mx, 32));
            const float mn = fmaxf(mrow[rt], mx), alpha = __expf(mrow[rt] - mn); mrow[rt] = mn; float ps = 0.f;
            float pv[4][4];
#pragma unroll
            for (int kt = 0; kt < 4; ++kt)
#pragma unroll
                for (int r = 0; r < 4; ++r) { pv[kt][r] = __expf(s[rt][kt][r] - mn); ps += pv[kt][r]; }
            lrow[rt] = lrow[rt] * alpha + ps;
#pragma unroll
            for (int kp = 0; kp < 2; ++kp) PB[rt][kp] = as8(make_uint4(pk(pv[2 * kp][0], pv[2 * kp][1]), pk(pv[2 * kp][2], pv[2 * kp][3]), pk(pv[2 * kp + 1][0], pv[2 * kp + 1][1]), pk(pv[2 * kp + 1][2], pv[2 * kp + 1][3])));
#pragma unroll
            for (int dt = 0; dt < 4; ++dt) o[rt][dt] = o[rt][dt] * alpha;
        }
        __builtin_amdgcn_s_setprio(1);
#pragma unroll
        for (int dt = 0; dt < 4; ++dt)
#pragma unroll
            for (int kp = 0; kp < 2; ++kp) { const bf16_t* vp = sVT + (dt * 16 + fr) * 72 + kp * 32 + fq * 4; const uint2 v0 = *(const uint2*)vp, v1 = *(const uint2*)(vp + 16);
                const bf16x8 VA = as8(make_uint4(v0.x, v0.y, v1.x, v1.y));
#pragma unroll
                for (int rt = 0; rt < 2; ++rt) o[rt][dt] = MFMA(VA, PB[rt][kp], o[rt][dt]); }
        __builtin_amdgcn_s_setprio(0);
        __syncthreads();
    }
#undef AT_LOAD
#undef AT_STAGE
#pragma unroll
    for (int rt = 0; rt < 2; ++rt) { float l = lrow[rt]; l += __shfl_xor(l, 16); l += __shfl_xor(l, 32); const float inv = 1.f / l;
        bf16_t* rp = FL + (qrow0 + rt * 16 + fr) * F2LD;
#pragma unroll
        for (int dt = 0; dt < 4; ++dt) { const int d = hq * 64 + dt * 16 + fq * 4; const uint2 gg = *(const uint2*)(rp + GATT + d);
            uint2 ov; ov.x = pk(o[rt][dt][0] * inv * siluf_(bflo(gg.x)), o[rt][dt][1] * inv * siluf_(bfhi(gg.x))); ov.y = pk(o[rt][dt][2] * inv * siluf_(bflo(gg.y)), o[rt][dt][3] * inv * siluf_(bfhi(gg.y)));
            *(uint2*)(rp + QOFF + d) = ov; } }
}

__device__ __forceinline__ void s5tab_phase(const P& p) {
    unsigned char* ws = p.ws; const int gt = blockIdx.x * NTHR + tid_l(), gs = gridDim.x * NTHR;
    const float2* PW = (const float2*)(ws + WS_PW); const float2* BB = (const float2*)(ws + WS_BB);
    for (int idx = gt; idx < 128 * 64; idx += gs) ((float2*)(ws + WS_A32))[idx] = PW[((idx >> 6) * 33 + 32) * 64 + (idx & 63)];
    bf16_t* WX = (bf16_t*)(ws + WS_WX);
    for (int i8 = gt; i8 < 128 * 128 * 512 / 8; i8 += gs) { const int idx = i8 * 8;
        const int k = idx & 511, pc = (idx >> 9) & 127, gd = idx >> 16, pp = pc >> 1, ci = pc & 1, i = k >> 4, h0 = k & 15, dir = gd & 1;
        const int m = dir ? i : 31 - i; const float2 a = PW[(gd * 33 + m) * 64 + pp]; const float4* bp = (const float4*)(BB + (gd * 64 + pp) * 16 + h0);
        const float4 b0 = bp[0], b1 = bp[1], b2 = bp[2], b3 = bp[3];
#define WXV(BX, BY) (ci ? a.x * (BY) + a.y * (BX) : a.x * (BX) - a.y * (BY))
        *(uint4*)(WX + idx) = make_uint4(pk(WXV(b0.x, b0.y), WXV(b0.z, b0.w)), pk(WXV(b1.x, b1.y), WXV(b1.z, b1.w)), pk(WXV(b2.x, b2.y), WXV(b2.z, b2.w)), pk(WXV(b3.x, b3.y), WXV(b3.z, b3.w)));
#undef WXV
    }
    bf16_t* VT = (bf16_t*)(ws + WS_VT);
    for (int i8 = gt; i8 < 64 * 512 * 256 / 8; i8 += gs) { const int idx = i8 * 8;
        const int kk = idx & 255, col = (idx >> 8) & 511, g = idx >> 17, dir = kk >> 7, pp = (kk >> 1) & 63, t = col >> 4, h = col & 15;
        const int m = dir ? 32 - t : t + 1; const float4* ap = (const float4*)(PW + ((g * 2 + dir) * 33 + m) * 64 + pp); const float4 a0 = ap[0], a1 = ap[1];
        const float4 cr = *(const float4*)(p.c_re + (g * 16 + h) * 64 + pp), cm = *(const float4*)(p.c_im + (g * 16 + h) * 64 + pp);
        *(uint4*)(VT + idx) = make_uint4(pk(cr.x * a0.x - cm.x * a0.y, -(cr.x * a0.y + cm.x * a0.x)), pk(cr.y * a0.z - cm.y * a0.w, -(cr.y * a0.w + cm.y * a0.z)),
                                         pk(cr.z * a1.x - cm.z * a1.y, -(cr.z * a1.y + cm.z * a1.x)), pk(cr.w * a1.z - cm.w * a1.w, -(cr.w * a1.w + cm.w * a1.z)));
    }
    bf16_t* KT2 = (bf16_t*)(ws + WS_KT2);
    for (int i4 = gt; i4 < 64 * 63 * 256 / 4; i4 += gs) { const int idx = i4 * 4;
        const int hp = idx & 15, h = (idx >> 4) & 15, mm = (idx >> 8) % 63, g = idx / (63 * 256); float acc0 = 0.f, acc1 = 0.f, acc2 = 0.f, acc3 = 0.f;
        for (int dir = 0; dir < 2; ++dir) { const int m = dir ? 31 - mm : mm - 31; if (m < 0) continue; const int gd = g * 2 + dir;
            for (int pp = 0; pp < 64; ++pp) { const float2 a = PW[(gd * 33 + m) * 64 + pp]; const float4* bp = (const float4*)(BB + (gd * 64 + pp) * 16 + hp); const float4 b0 = bp[0], b1 = bp[1];
                const float cr = p.c_re[(g * 16 + h) * 64 + pp], cim = p.c_im[(g * 16 + h) * 64 + pp];
                const float er = cr * a.x - cim * a.y, ei = cr * a.y + cim * a.x;
                acc0 += er * b0.x - ei * b0.y; acc1 += er * b0.z - ei * b0.w; acc2 += er * b1.x - ei * b1.y; acc3 += er * b1.z - ei * b1.w; } }
        *(uint2*)(KT2 + idx) = make_uint2(pk(acc0, acc1), pk(acc2, acc3)); }
}

__device__ __forceinline__ void s5scan_phase(const P& p) {
    unsigned* S32 = (unsigned*)(p.ws + WS_S); const float2* A32 = (const float2*)(p.ws + WS_A32);
    for (int idx = blockIdx.x * NTHR + tid_l(); idx < 16 * 64 * 2 * 64; idx += gridDim.x * NTHR) {
        const int pp = idx & 63, dir = (idx >> 6) & 1, g = (idx >> 7) & 63, b = idx >> 13; const float2 a = A32[(g * 2 + dir) * 64 + pp];
        float sr = 0.f, si = 0.f;
        unsigned* base = S32 + ((size_t)(b * 72) * 64 + g) * 128 + dir * 64 + pp;
        for (int i0 = 0; i0 < 72; i0 += 8) {
            unsigned wv[8];
#pragma unroll
            for (int j = 0; j < 8; ++j) { const int i = i0 + j, c = dir ? (i < 8 ? 7 - i : 79 - i) : i; wv[j] = base[(size_t)c * 8192]; }
#pragma unroll
            for (int j = 0; j < 8; ++j) { const int i = i0 + j, c = dir ? (i < 8 ? 7 - i : 79 - i) : i; base[(size_t)c * 8192] = pk(sr, si);
                const float nr = a.x * sr - a.y * si + bflo(wv[j]), ni = a.x * si + a.y * sr + bfhi(wv[j]); sr = nr; si = ni; }
        }
    }
}

__device__ __forceinline__ void final_phase(const P& p) {
    const int tid = tid_l(); const int lane = tid & 63, w = tid >> 6;
    for (int tok = blockIdx.x * 8 + w; tok < 32768; tok += gridDim.x * 8) {
        float* row = p.out + (size_t)tok * 1024; float4 v[4]; float ss = 0.f;
#pragma unroll
        for (int m = 0; m < 4; ++m) { v[m] = *(const float4*)(row + m * 256 + lane * 4); ss += v[m].x * v[m].x + v[m].y * v[m].y + v[m].z * v[m].z + v[m].w * v[m].w; }
#pragma unroll
        for (int o = 32; o >= 1; o >>= 1) ss += __shfl_xor(ss, o);
        const float rs = rsqrtf(ss * (1.f / 1024.f) + EPSN);
#pragma unroll
        for (int m = 0; m < 4; ++m) { const int col = m * 256 + lane * 4; const float4 g = *(const float4*)(p.final_g + col);
            float4 o; o.x = v[m].x * rs * g.x; o.y = v[m].y * rs * g.y; o.z = v[m].z * rs * g.z; o.w = v[m].w * rs * g.w; *(float4*)(row + col) = o; }
    }
}

#define LAS __attribute__((address_space(3)))
#define XB_TMO      128
#define XB_XCNT(j)  (256  + 64 * (j))
#define XB_XSUB(j)  (1280 + 64 * (j))
#define XB_XGEN(j)  (2304 + 64 * (j))
#define XB_TOP      3328
#define XB_TOPGEN   3392
#define XCD_BAR_WORDS 3456
#define XB_SPIN_CAP (1u << 18)

__device__ __forceinline__ unsigned xb_ld(unsigned* p)              { return __hip_atomic_load(p, __ATOMIC_RELAXED, __HIP_MEMORY_SCOPE_AGENT); }
__device__ __forceinline__ unsigned xb_add(unsigned* p, unsigned v) { return __hip_atomic_fetch_add(p, v, __ATOMIC_RELAXED, __HIP_MEMORY_SCOPE_AGENT); }
__device__ __forceinline__ unsigned xb_xcc_id() { return (unsigned)__builtin_amdgcn_s_getreg((3 << 11) | 20) & 0xFu; }
#define XB_SPIN(cond, bar) do { unsigned _sp = 0; while (cond) { __builtin_amdgcn_s_sleep(1); \
    if ((++_sp & 255u) == 0u) { if (xb_ld(&(bar)[XB_TMO])) break; if (_sp > XB_SPIN_CAP) { atomicAdd(&(bar)[XB_TMO], 1u); break; } } } } while (0)

struct XcdBarrier {
    unsigned* bar; unsigned x;
    volatile LAS unsigned* st;
};

__device__ __forceinline__ XcdBarrier xcd_barrier_post(unsigned* bar, volatile LAS unsigned* st) {
    XcdBarrier b; b.bar = bar; b.x = xb_xcc_id(); b.st = st;
    if (threadIdx.x == 0) (void)xb_add(&bar[XB_XCNT(b.x)], 1u);
    return b;
}
__device__ __forceinline__ void xcd_barrier_complete(unsigned* bar, unsigned x, unsigned& nloc, unsigned& nx) {
    const unsigned G = gridDim.x * gridDim.y * gridDim.z;
    unsigned sum, cnt, mine, sp = 0u;
    for (;;) {
        sum = 0u; cnt = 0u; mine = 0u;
#pragma unroll
        for (unsigned j = 0; j < 16; ++j) { const unsigned c = xb_ld(&bar[XB_XCNT(j)]); sum += c; cnt += (c > 0u) ? 1u : 0u; mine = (j == x) ? c : mine; }
        if (sum == G) break;
        __builtin_amdgcn_s_sleep(1);
        if ((++sp & 255u) == 0u) { if (xb_ld(&bar[XB_TMO])) break; if (sp > XB_SPIN_CAP) { atomicAdd(&bar[XB_TMO], 1u); break; } }
    }
    nloc = mine > 0u ? mine : 1u; nx = cnt > 0u ? cnt : 1u;
}

__device__ __forceinline__ void xcd_barrier(const XcdBarrier& b) {
    asm volatile("s_waitcnt vmcnt(0)" ::: "memory");
    __syncthreads();
    if (threadIdx.x == 0) {
        unsigned* bar = b.bar;
        __builtin_amdgcn_s_waitcnt(0);
        unsigned nloc = b.st[0], nx = b.st[1];
        if (nloc == 0u) { xcd_barrier_complete(bar, b.x, nloc, nx); b.st[0] = nloc; b.st[1] = nx; }
        const unsigned old = xb_add(&bar[XB_XSUB(b.x)], 1u);
        const unsigned gen = old / nloc;
        if (old + 1u == (gen + 1u) * nloc) {
            __builtin_amdgcn_fence(__ATOMIC_RELEASE, "agent");
            asm volatile("s_waitcnt vmcnt(0)" ::: "memory");
            const unsigned og = xb_add(&bar[XB_TOP], 1u);
            const unsigned tg = og / nx;
            if (og + 1u == (tg + 1u) * nx) xb_add(&bar[XB_TOPGEN], 1u);
            else XB_SPIN(xb_ld(&bar[XB_TOPGEN]) == tg, bar);
            __builtin_amdgcn_fence(__ATOMIC_ACQUIRE, "agent");
            xb_add(&bar[XB_XGEN(b.x)], 1u);
            asm volatile("s_waitcnt vmcnt(0)" ::: "memory");
        } else {
            XB_SPIN(xb_ld(&bar[XB_XGEN(b.x)]) == gen, bar);
            __builtin_amdgcn_fence(__ATOMIC_ACQUIRE, "agent");
            asm volatile("s_waitcnt vmcnt(0)" ::: "memory");
        }
    }
    __syncthreads();
}

struct ListOrder {
    int nM, nN, nwg, base, step, cnt;
    __device__ void init(int M, int N, int base_, int step_, int cnt_) { nM = M / 256; nN = N / 256; nwg = nM * nN; base = base_; step = step_; cnt = cnt_; }
    __device__ bool next(int i, pg8::Unit& u) const {
        if (i >= cnt) return false; const int L = base + i * step; if (L >= nwg) return false;
        int wgid = L; { const int q = nwg / 8, r = nwg % 8, xcd = wgid % 8, off = wgid / 8; wgid = (xcd < r ? xcd * (q + 1) : r * (q + 1) + (xcd - r) * q) + off; }
        const int nig = 8 * nN, gid = wgid / nig, fm = gid * 8, gsz = (nM - fm) < 8 ? (nM - fm) : 8;
        u.pm = fm + ((wgid % nig) % gsz); u.pn = (wgid % nig) / gsz; return true;
    }
    __device__ __forceinline__ void a_ready(const pg8::Unit&) const {}
    __device__ __forceinline__ void done(const pg8::Unit&) const {}
};
template <class Epi>
__device__ __forceinline__ void run_gemm_list(unsigned char* lds, const bf16_t* A, int lda, const bf16_t* Bt, int M, int N, int K, int base, int step, int cnt, const Epi& ep) {
    pg8::Gemm g{A, Bt, M, N, K, lda}; ListOrder S; S.init(M, N, base, step, cnt);
    pg8::gemm_phase<Epi, ListOrder, true, true>((PG8_LAS unsigned char*)lds, g, S, ep);
}
template <class Epi>
__device__ __forceinline__ void run_gemm(unsigned char* lds, const bf16_t* A, int lda, const bf16_t* Bt, int M, int N, int K, int c, const Epi& ep) {
    pg8::Gemm g{A, Bt, M, N, K, lda}; pg8::StaticOrder S; S.init(M, N, gridDim.x, c);
    pg8::gemm_phase<Epi, pg8::StaticOrder, true, true>((PG8_LAS unsigned char*)lds, g, S, ep);
}

__global__ void __launch_bounds__(NTHR) fwd_megakernel(P p) {
    extern __shared__ __attribute__((aligned(16))) unsigned char lds[];
    cg::grid_group grid = cg::this_grid();
    unsigned char* ws = p.ws;
    const int bid = blockIdx.x, nb = gridDim.x;
#define half (tid_l() >> 8)
#define hl (lds + (tid_l() >> 8) * HALF_LDS)

    volatile LAS unsigned* xst = (volatile LAS unsigned*)((LAS unsigned char*)lds + 2 * HALF_LDS);
    if (threadIdx.x == 0) { xst[0] = 0u; xst[1] = 0u; }
    __syncthreads();
    XcdBarrier xb = xcd_barrier_post((unsigned*)(ws + WS_BAR), xst);
    prep_phase(p, lds);
    grid.sync();
    normmod_phase(p, 0, 0, NTOK, 0, nb);
    xcd_barrier(xb);
    const bf16_t* H0 = (const bf16_t*)(ws + WS_H); const bf16_t* W0 = (const bf16_t*)(ws + WS_WIN0);
    PgA epa{ws, p.gk_b, 0};
    run_gemm(lds, H0, 1024, W0, GROWS, 9216, 1024, bid, epa);
    xcd_barrier(xb);
    pre_phase(p, 0, half, hl);
    xcd_barrier(xb);
    for (int grp = 0; grp < 8; ++grp) {
        const int par = grp & 1;
        if (bid < 64) seq_block(p, par, bid, lds);
        if (grp >= 1) {
            PgC epc{p.x, p.ctx, p.out, (float*)(ws + WS_XC), (const float*)(ws + WS_MOD), grp - 1};
            run_gemm_list(lds, (const bf16_t*)(ws + WS_OF + (size_t)(par ^ 1) * OBUF), 2048, (const bf16_t*)(ws + WS_WOUT0), GROWS, 1024, 2048, bid - 64, 72, (bid >= 64 && bid < 136) ? 1 : 0, epc);
        }
        if (grp < 7) {
            int base, step, cnt;
            if (bid >= 136) { base = bid - 136; step = 120; cnt = 4; } else if (bid >= 64) { base = 480 + bid - 64; step = 72; cnt = 2; } else { base = 624 + bid; step = 64; cnt = bid < 24 ? 1 : 0; }
            epa.par = par ^ 1;
            run_gemm_list(lds, H0 + (size_t)(grp + 1) * GROWS * 1024, 1024, W0, GROWS, 9216, 1024, base, step, cnt, epa);
        }
        xcd_barrier(xb);
        if (grp < 7) pre_phase(p, par ^ 1, half, hl);
        gatenorm_phase(p, par);
        xcd_barrier(xb);
    }
    {
        PgC epc{p.x, p.ctx, p.out, (float*)(ws + WS_XC), (const float*)(ws + WS_MOD), 7};
        run_gemm(lds, (const bf16_t*)(ws + WS_OF + OBUF), 2048, (const bf16_t*)(ws + WS_WOUT0), GROWS, 1024, 2048, bid, epc);
        if (bid >= 72) normmod_phase(p, 1, 0, 7 * GROWS, 72, nb - 72);
    }
    xcd_barrier(xb);
    normmod_phase(p, 1, 7 * GROWS, NTOK, 0, nb);
    s5tab_phase(p);
    xcd_barrier(xb);
    {
        PgB epl{(bf16_t*)(ws + WS_F2L), F2LD, (const float2*)(ws + WS_ROPE), 1}; PgB epc{(bf16_t*)(ws + WS_F2C), F2CLD, (const float2*)(ws + WS_ROPE), 0};
        run_gemm(lds, (const bf16_t*)(ws + WS_H), 1024, (const bf16_t*)(ws + WS_WIN1), 32768, 4608, 1024, bid, epl);
        run_gemm(lds, (const bf16_t*)(ws + WS_H) + (size_t)32768 * 1024, 1024, (const bf16_t*)(ws + WS_WIN1), 4096, 1536, 1024, bid, epc);
    }
    xcd_barrier(xb);
    {
        constexpr int NX = 128 * 9;
        for (int it = bid * 2 + half; it < NX + 4096; it += nb * 2) {
            if (it < NX) { const int gd = it / 9, tm = it % 9; LdS5X al{(const bf16_t*)(ws + WS_F2L), gd >> 1}; LdPlain bl{(const bf16_t*)(ws + WS_WX) + (size_t)gd * 128 * 512, 512};
                EpiS5X ep{(bf16_t*)(ws + WS_S), gd >> 1, gd & 1}; gemm_tile(al, bl, ep, tm * 128, 0, 512, hl); }
            else attn_item(p, it - NX, hl);
        }
    }
    xcd_barrier(xb);
    s5scan_phase(p);
    xcd_barrier(xb);
    {
        for (int it = bid * 2 + half; it < 64 * 32; it += nb * 2) {
            const int local = ((it >> 4) & 31) * 2 + (it & 1); const int g = (nb == 256) ? (it >> 9) * 16 + ((it >> 1) & 7) * 2 + (local >> 5) : it >> 5;
            const int tile = (nb == 256) ? (local & 31) : (it & 31); const int tm = tile >> 2, tn = tile & 3;
            LdS5YA al{(const bf16_t*)(ws + WS_F2L), (const bf16_t*)(ws + WS_S), g}; LdS5YB bl{(const bf16_t*)(ws + WS_KT2), (const bf16_t*)(ws + WS_VT), g};
            EpiS5Y ep{(const bf16_t*)(ws + WS_F2L), (bf16_t*)(ws + WS_H), p.s5_d, g}; gemm_tile(al, bl, ep, tm * 128, tn * 128, 768, hl); }
    }
    xcd_barrier(xb);
    {
        PgGLU ep{(bf16_t*)(ws + WS_F2L)};
        run_gemm(lds, (const bf16_t*)(ws + WS_H), 1024, (const bf16_t*)(ws + WS_WGLU), 32768, 2048, 1024, bid, ep);
    }
    xcd_barrier(xb);
    {
        PgD ep{p.out, (const float*)(ws + WS_MOD) + 17 * 3072};
        run_gemm(lds, (const bf16_t*)(ws + WS_F2L) + QOFF, F2LD, (const bf16_t*)(ws + WS_WOUT1), 32768, 1024, 2048, bid, ep);
    }
    xcd_barrier(xb);
    final_phase(p);
#undef half
#undef hl
}

extern "C" void kernel_launch(void* const* d_in, const int* in_sizes, int n_in, void* d_out, int out_size, void* d_ws, size_t ws_size, hipStream_t stream) {
    static int grid_blocks = 0;
    if (grid_blocks == 0) {
        if (ws_size < WS_TOTAL) { fprintf(stderr, "kernel_launch: workspace too small: %zu < %zu\n", ws_size, (size_t)WS_TOTAL); grid_blocks = -1; return; }
        int dev = 0, cus = 0, per_cu = 0;
        (void)hipGetDevice(&dev);
        (void)hipDeviceGetAttribute(&cus, hipDeviceAttributeMultiprocessorCount, dev);
        (void)hipFuncSetAttribute((const void*)fwd_megakernel, hipFuncAttributeMaxDynamicSharedMemorySize, LDS_BYTES);
        (void)hipOccupancyMaxActiveBlocksPerMultiprocessor(&per_cu, (const void*)fwd_megakernel, NTHR, LDS_BYTES);
        if (per_cu < 1) { fprintf(stderr, "kernel_launch: occupancy query reports %d blocks/CU\n", per_cu); per_cu = 1; }
        grid_blocks = cus;
    }
    if (grid_blocks < 0) return;
    P p{};
    const float** pp = (const float**)&p;
    for (int i = 0; i < 27; ++i) pp[i] = (const float*)d_in[i];
    p.out = (float*)d_out; p.ws = (unsigned char*)d_ws;
    (void)hipMemsetAsync((unsigned char*)d_ws + WS_BAR, 0, 16384, stream);
    void* args[] = {&p};
    hipError_t e = hipLaunchCooperativeKernel((void*)fwd_megakernel, dim3(grid_blocks), dim3(NTHR), args, LDS_BYTES, stream);
    if (e != hipSuccess) fprintf(stderr, "cooperative launch failed: %s (grid %d)\n", hipGetErrorString(e), grid_blocks);
}
```

```cpp
#include <hip/hip_runtime.h>
#include <hip/hip_cooperative_groups.h>
#include <cstdio>
#include <cstdint>
namespace cg = cooperative_groups;

typedef unsigned short bf16_t;
typedef short bf16x8 __attribute__((ext_vector_type(8)));
typedef float f32x4 __attribute__((ext_vector_type(4)));

#define MFMA(a, b, c) __builtin_amdgcn_mfma_f32_16x16x32_bf16(a, b, c, 0, 0, 0)
#define DEV __device__ __forceinline__

constexpr int NTOK = 36864;
constexpr int GROWS = 4608;
constexpr int HALF_LDS = 73728;
constexpr int LDS_BYTES = 2 * HALF_LDS + 64;
constexpr int NTHR = 512;
constexpr float EPSN = 1e-6f;
constexpr int KOFF = 0, VOFF = 256, UOFF = 512, GATT = 1536, QOFF = 2560, GS5 = 3584, F2LD = 4608, F2CLD = 1536;

constexpr size_t WS_WIN1 = 0;
constexpr size_t WS_WGLU = WS_WIN1 + 9437184;
constexpr size_t WS_WOUT1 = WS_WGLU + 4194304;
constexpr size_t WS_XC = WS_WOUT1 + 4194304;
constexpr size_t WS_MOD = WS_XC + 16777216;
constexpr size_t WS_LB = WS_MOD + 417792;
constexpr size_t WS_ROPE = WS_LB + 8192;
constexpr size_t WS_A32 = WS_ROPE + 8192;
constexpr size_t WS_PW = WS_A32 + 65536;
constexpr size_t WS_BB = WS_PW + 2162688;
constexpr size_t WS_R1 = WS_BB + 1048576;
constexpr size_t WS_WIN0 = WS_R1;
constexpr size_t WS_WOUT0 = WS_WIN0 + 18874368;
constexpr size_t WS_WX = WS_R1;
constexpr size_t WS_KT2 = WS_WX + 16777216;
constexpr size_t WS_VT = WS_KT2 + 2064384;
constexpr size_t WS_H = WS_R1 + 35618816;
constexpr size_t WS_S = WS_H + 75497472;
constexpr size_t WS_R3 = WS_S + 37748736;
constexpr size_t WS_FEATB = WS_R3;
constexpr size_t WS_FEATF = WS_FEATB + 56623104;
constexpr size_t WS_QD = WS_FEATF + 56623104;
constexpr size_t WS_KTT = WS_QD + 28311552;
constexpr size_t WS_ATT = WS_KTT + 28311552;
constexpr size_t WS_DEC = WS_ATT + 7077888;
constexpr size_t WS_VTT = WS_DEC + 1769472;
constexpr size_t WS_GATES = WS_VTT + 18874368;
constexpr size_t WS_OF = WS_GATES + 37748736;
constexpr size_t WS_OB = WS_OF + 37748736;
constexpr size_t WS_VTT1 = WS_FEATF + 28311552;
constexpr size_t OBUF = 18874368;
static_assert(WS_OB + 37748736 <= WS_R3 + 314572800, "layer-0 buffers overflow region 3");
constexpr size_t WS_F2L = WS_R3;
constexpr size_t WS_F2C = WS_F2L + 301989888;
constexpr size_t WS_END = WS_F2C + 12582912;
constexpr size_t WS_BAR = WS_END;
constexpr size_t WS_TOTAL = WS_BAR + 16384;
constexpr size_t F2C_DELTA = (WS_F2C - WS_F2L) / 2;

struct P {
    const float *x, *c, *ctx, *c_ctx, *ada_w, *ada_b, *norm_g, *final_g, *ev_w_in, *ev_w_out, *gk_w, *gk_b, *gla_g, *lb_raw, *hg_g,
        *od_w_in, *od_w_out, *sink, *lam_re, *lam_im, *log_dt, *b_re, *b_im, *c_re, *c_im, *s5_d, *glu_w;
    float* out;
    unsigned char* ws;
};

DEV int tid_l() { int t = threadIdx.x; asm volatile("" : "+v"(t)); return t; }
typedef __bf16 bf16v2_t __attribute__((ext_vector_type(2)));
typedef float f32v2_t __attribute__((ext_vector_type(2)));
DEV unsigned pk(float a, float b) { const f32v2_t v = {a, b}; return __builtin_bit_cast(unsigned, __builtin_convertvector(v, bf16v2_t)); }
DEV bf16_t f2bf(float f) { return __builtin_bit_cast(bf16_t, (__bf16)f); }
typedef _Float16 h16v2_t __attribute__((ext_vector_type(2)));
typedef _Float16 h16v8_t __attribute__((ext_vector_type(8)));
DEV unsigned pkh(float a, float b) { const h16v2_t v = {(_Float16)a, (_Float16)b}; return __builtin_bit_cast(unsigned, v); }
DEV void unpackh8(uint4 v, float* f) { const h16v8_t h = __builtin_bit_cast(h16v8_t, v); _Pragma("unroll") for (int e = 0; e < 8; ++e) f[e] = (float)h[e]; }
DEV float bflo(unsigned w) { return __uint_as_float(w << 16); }
DEV float bfhi(unsigned w) { return __uint_as_float(w & 0xffff0000u); }
DEV float bf2f(bf16_t b) { return __uint_as_float((unsigned)b << 16); }
DEV bf16x8 as8(uint4 v) { return __builtin_bit_cast(bf16x8, v); }
DEV float rcpf_(float x) { return __builtin_amdgcn_rcpf(x); }
DEV float sigmoidf_(float x) { return rcpf_(1.f + __expf(-x)); }
DEV float siluf_(float x) { return x * rcpf_(1.f + __expf(-x)); }
DEV float geluf_(float x) { float u = 0.7978845608028654f * (x + 0.044715f * x * x * x); float t = 1.f - 2.f * rcpf_(1.f + __expf(2.f * u)); return 0.5f * x * (1.f + t); }
DEV void unpack8(uint4 v, float* f) { f[0] = bflo(v.x); f[1] = bfhi(v.x); f[2] = bflo(v.y); f[3] = bfhi(v.y); f[4] = bflo(v.z); f[5] = bfhi(v.z); f[6] = bflo(v.w); f[7] = bfhi(v.w); }

namespace pg8 {
#define PG8_LAS __attribute__((address_space(3)))
typedef unsigned short bf16_t;
typedef short bf16x8 __attribute__((ext_vector_type(8)));
typedef float f32x4 __attribute__((ext_vector_type(4)));
typedef unsigned u32x4 __attribute__((ext_vector_type(4)));
constexpr int BM = 256, BK = 64, HALF = 128, HTB = HALF * BK * 2  , STAGE_BYTES = 8 * HTB, NXCD = 8, WGM = 8;

__host__ __device__ __forceinline__ int lds_byte(int r, int c) { const int st = (r >> 4) * 2 + (c >> 5), rr = r & 15, cc = c & 31, ob = rr * 64 + cc * 2; return st * 1024 + (ob ^ (((ob >> 9) & 1) << 5)); }
__host__ __device__ __forceinline__ void stage_rc(int b, int& R, int& C) { const int st = b / 1024, sb = b % 1024, swz = sb ^ (((sb >> 9) & 1) << 5); R = (st >> 1) * 16 + swz / 64; C = (st & 1) * 32 + (swz % 64) / 2; }
__host__ __device__ __forceinline__ int perm32(int rho) { const int n = rho >> 4, i = rho & 15; return 8 * (i >> 2) + 4 * n + (i & 3); }

struct Unit { int pm, pn; };
struct Gemm { const bf16_t* A; const bf16_t* Bt; int M, N, K, lda; };

struct StaticOrder {
    int nM, nN, nwg, G, c;
    __host__ __device__ void init(int M, int N, int G_, int c_) { nM = M / BM; nN = N / BM; nwg = nM * nN; G = G_; c = c_; }
    __host__ __device__ bool next(int i, Unit& u) const {
        const long L = (long)i * G + c; if (L >= nwg) return false;
        int wgid = (int)L; { const int q = nwg / NXCD, r = nwg % NXCD, xcd = wgid % NXCD, off = wgid / NXCD; wgid = (xcd < r ? xcd * (q + 1) : r * (q + 1) + (xcd - r) * q) + off; }
        const int nig = WGM * nN, gid = wgid / nig, fm = gid * WGM, gsz = (nM - fm) < WGM ? (nM - fm) : WGM;
        u.pm = fm + ((wgid % nig) % gsz); u.pn = (wgid % nig) / gsz; return true;
    }
    __device__ __forceinline__ void a_ready(const Unit&) const {}
    __device__ __forceinline__ void done(const Unit&) const {}
};
template <class Epi, class Sched, bool ALIGN_EPI = false, bool SP2 = false>
__device__ __forceinline__ void gemm_phase(PG8_LAS unsigned char* lds, const Gemm g, const Sched& S, const Epi& E) {
    const int tid = tid_l(), wid = __builtin_amdgcn_readfirstlane(tid >> 6), lane = tid & 63, wr = wid >> 2, wc = wid & 3, fr = lane & 15, fq = lane >> 4;
    const int K = g.K, nt = K / BK;
    unsigned voffA[2], voffB[2];
#pragma unroll
    for (int i = 0; i < 2; ++i) { int R, C; stage_rc(tid * 16 + i * 8192, R, C); const int Rb = Epi::PERM ? ((R & ~31) + perm32(R & 31)) : R;
        voffA[i] = (unsigned)(R * g.lda + C) * 2u; voffB[i] = (unsigned)(Rb * K + C) * 2u; }
    const size_t kstep = (size_t)(BK * 2);
    const size_t hstep = (size_t)HALF * K * 2, hstepA = (size_t)HALF * g.lda * 2, tstepA = 2 * hstepA;
    const size_t tstep = 2 * hstep;
    const unsigned ldsw = (unsigned)wid * 1024u;
    const int aoff = lds_byte(wr * 64 + fr, fq * 8), boff = lds_byte(wc * 32 + fr, fq * 8);
#define PG8_SA(b, h) (((b) * 2 + (h)) * HTB)
#define PG8_SB(b, h) ((4 + (b) * 2 + (h)) * HTB)
#define PG8_STAGE(bufoff, gbase, voff) do { _Pragma("unroll") for (int _i = 0; _i < 2; ++_i) \
        __builtin_amdgcn_global_load_lds((const unsigned*)((const char*)(gbase) + (voff)[_i]), (PG8_LAS unsigned*)(lds + (bufoff) + ldsw + _i * 8192), 16, 0, 0); } while (0)
#define PG8_LDA(dst, b, h) do { _Pragma("unroll") for (int m = 0; m < 4; ++m) _Pragma("unroll") for (int k = 0; k < 2; ++k) dst[m][k] = *(const PG8_LAS bf16x8*)(lds + PG8_SA(b, h) + aoff + m * 2048 + k * 1024); } while (0)
#define PG8_LDB(dst, b, h) do { _Pragma("unroll") for (int n = 0; n < 2; ++n) _Pragma("unroll") for (int k = 0; k < 2; ++k) dst[n][k] = *(const PG8_LAS bf16x8*)(lds + PG8_SB(b, h) + boff + n * 2048 + k * 1024); } while (0)
#define PG8_MMA(ai, bj, At, Bt) do { __builtin_amdgcn_s_setprio(1); _Pragma("unroll") for (int m = 0; m < 4; ++m) _Pragma("unroll") for (int n = 0; n < 2; ++n) _Pragma("unroll") for (int k = 0; k < 2; ++k) \
        acc[ai][bj][m][n] = __builtin_amdgcn_mfma_f32_16x16x32_bf16(Bt[n][k], At[m][k], acc[ai][bj][m][n], 0, 0, 0); __builtin_amdgcn_s_setprio(0); } while (0)
#define PG8_WAIT_V(n) asm volatile("s_waitcnt vmcnt(" #n ")" ::: "memory")
#define PG8_WAIT_L(n) asm volatile("s_waitcnt lgkmcnt(" #n ")" ::: "memory")
#define PG8_BAR __builtin_amdgcn_s_barrier()
#define PG8_SCHED __builtin_amdgcn_sched_barrier(0)
    Unit cur, nxt; int ui = 0;
    if (!S.next(0, cur)) return;
    f32x4 acc[2][2][4][2];
#pragma unroll
    for (int a = 0; a < 2; ++a)
#pragma unroll
        for (int b = 0; b < 2; ++b)
#pragma unroll
            for (int m = 0; m < 4; ++m)
#pragma unroll
                for (int n = 0; n < 2; ++n) acc[a][b][m][n] = (f32x4){0.f, 0.f, 0.f, 0.f};
    bf16x8 At[4][2], B0[2][2], B1[2][2];
    const char* cA = (const char*)g.A + (size_t)cur.pm * tstepA; const char* cB = (const char*)g.Bt + (size_t)cur.pn * tstep;
    S.a_ready(cur);
    if constexpr (SP2) {
        PG8_STAGE(PG8_SB(0, 0), cB, voffB); PG8_STAGE(PG8_SB(0, 1), cB + hstep, voffB); PG8_STAGE(PG8_SA(0, 0), cA, voffA); PG8_STAGE(PG8_SA(0, 1), cA + hstepA, voffA);
        if (wr == 1) PG8_BAR;
        PG8_WAIT_V(2); PG8_BAR;
        PG8_STAGE(PG8_SB(1, 0), cB + kstep, voffB); PG8_STAGE(PG8_SA(1, 0), cA + kstep, voffA); PG8_STAGE(PG8_SB(1, 1), cB + hstep + kstep, voffB);
        PG8_WAIT_V(6); PG8_BAR;
    } else {
        PG8_STAGE(PG8_SB(0, 0), cB, voffB); PG8_STAGE(PG8_SA(0, 0), cA, voffA); PG8_STAGE(PG8_SB(0, 1), cB + hstep, voffB); PG8_STAGE(PG8_SA(0, 1), cA + hstepA, voffA);
        if (wr == 1) PG8_BAR;
        PG8_WAIT_V(4); PG8_BAR;
        PG8_STAGE(PG8_SB(1, 0), cB + kstep, voffB); PG8_STAGE(PG8_SA(1, 0), cA + kstep, voffA); PG8_STAGE(PG8_SB(1, 1), cB + hstep + kstep, voffB);
        PG8_WAIT_V(6); PG8_BAR;
    }
    for (;;) {
        const bool has_next = S.next(ui + 1, nxt);
        const char* nA = has_next ? (const char*)g.A + (size_t)nxt.pm * tstepA : cA; const char* nB = has_next ? (const char*)g.Bt + (size_t)nxt.pn * tstep : cB;
        for (int t = 0; t < nt; t += 2) {
            const bool last = (t == nt - 2);
            const char* a1 = cA + (size_t)(t + 1) * kstep;
            const char* a2 = last ? nA : cA + (size_t)(t + 2) * kstep; const char* b2 = last ? nB : cB + (size_t)(t + 2) * kstep;
            const char* a3 = a2 + kstep; const char* b3 = b2 + kstep;
            if (last && has_next) S.a_ready(nxt);
            if constexpr (SP2) {
            PG8_LDB(B0, 0, 0); PG8_LDB(B1, 0, 1); PG8_SCHED; PG8_LDA(At, 0, 0); PG8_STAGE(PG8_SA(1, 1), a1 + hstepA, voffA);
            PG8_WAIT_V(8); PG8_WAIT_L(0); PG8_BAR; PG8_MMA(0, 0, At, B0); PG8_MMA(0, 1, At, B1); PG8_BAR; PG8_SCHED;
            PG8_LDA(At, 0, 1); PG8_STAGE(PG8_SB(0, 0), b2, voffB); PG8_STAGE(PG8_SB(0, 1), b2 + hstep, voffB); PG8_STAGE(PG8_SA(0, 0), a2, voffA);
            PG8_WAIT_V(8); PG8_WAIT_L(0); PG8_BAR; PG8_MMA(1, 0, At, B0); PG8_MMA(1, 1, At, B1); PG8_BAR; PG8_SCHED;
            PG8_LDB(B0, 1, 0); PG8_LDB(B1, 1, 1); PG8_SCHED; PG8_LDA(At, 1, 0); PG8_STAGE(PG8_SA(0, 1), a2 + hstepA, voffA);
            PG8_WAIT_V(8); PG8_WAIT_L(0); PG8_BAR; PG8_MMA(0, 0, At, B0); PG8_MMA(0, 1, At, B1); PG8_BAR; PG8_SCHED;
            PG8_LDA(At, 1, 1); PG8_STAGE(PG8_SB(1, 0), b3, voffB); PG8_STAGE(PG8_SB(1, 1), b3 + hstep, voffB); PG8_STAGE(PG8_SA(1, 0), a3, voffA);
            PG8_WAIT_V(8); PG8_WAIT_L(0); PG8_BAR; PG8_MMA(1, 0, At, B0); PG8_MMA(1, 1, At, B1); PG8_BAR; PG8_SCHED;
            } else {
            PG8_LDB(B0, 0, 0); PG8_SCHED; PG8_LDA(At, 0, 0); PG8_STAGE(PG8_SA(1, 1), a1 + hstepA, voffA);
            PG8_WAIT_L(8); PG8_BAR; PG8_WAIT_L(0); PG8_MMA(0, 0, At, B0); PG8_BAR; PG8_SCHED;
            PG8_LDB(B1, 0, 1); PG8_STAGE(PG8_SB(0, 0), b2, voffB);
            PG8_BAR; PG8_WAIT_L(0); PG8_MMA(0, 1, At, B1); PG8_BAR;
            PG8_LDA(At, 0, 1); PG8_STAGE(PG8_SA(0, 0), a2, voffA);
            PG8_BAR; PG8_WAIT_L(0); PG8_MMA(1, 0, At, B0); PG8_BAR; PG8_SCHED;
            PG8_STAGE(PG8_SB(0, 1), b2 + hstep, voffB);
            PG8_WAIT_V(6); PG8_BAR; PG8_MMA(1, 1, At, B1); PG8_BAR;
            PG8_LDB(B0, 1, 0); PG8_SCHED; PG8_LDA(At, 1, 0); PG8_STAGE(PG8_SA(0, 1), a2 + hstepA, voffA);
            PG8_WAIT_L(8); PG8_BAR; PG8_WAIT_L(0); PG8_MMA(0, 0, At, B0); PG8_BAR; PG8_SCHED;
            PG8_LDB(B1, 1, 1); PG8_STAGE(PG8_SB(1, 0), b3, voffB);
            PG8_BAR; PG8_WAIT_L(0); PG8_MMA(0, 1, At, B1); PG8_BAR;
            PG8_LDA(At, 1, 1); PG8_STAGE(PG8_SA(1, 0), a3, voffA);
            PG8_BAR; PG8_WAIT_L(0); PG8_MMA(1, 0, At, B0); PG8_BAR; PG8_SCHED;
            PG8_STAGE(PG8_SB(1, 1), b3 + hstep, voffB);
            PG8_WAIT_V(6); PG8_BAR; PG8_MMA(1, 1, At, B1); PG8_BAR;
            }
        }
        if constexpr (ALIGN_EPI) { if (wr == 0) PG8_BAR; }
        if constexpr (!Epi::AFTER_DRAIN) { E(acc, cur, wr, wc, fr, fq); S.done(cur); }
        if (!has_next) break;
#pragma unroll
        for (int a = 0; a < 2; ++a)
#pragma unroll
            for (int b = 0; b < 2; ++b)
#pragma unroll
                for (int m = 0; m < 4; ++m)
#pragma unroll
                    for (int n = 0; n < 2; ++n) acc[a][b][m][n] = (f32x4){0.f, 0.f, 0.f, 0.f};
        cur = nxt; cA = nA; cB = nB; ++ui;
        if constexpr (ALIGN_EPI) { if (wr == 1) PG8_BAR; }
    }
    PG8_WAIT_V(0);
    if constexpr (!ALIGN_EPI) { if (wr == 0) PG8_BAR; }
    PG8_BAR;
    if constexpr (Epi::AFTER_DRAIN) { E.fused(acc, cur, wr, wc, fr, fq, lds, wid, lane); S.done(cur); }
#undef PG8_SA
#undef PG8_SB
#undef PG8_STAGE
#undef PG8_LDA
#undef PG8_LDB
#undef PG8_MMA
#undef PG8_WAIT_V
#undef PG8_WAIT_L
#undef PG8_BAR
#undef PG8_SCHED
}
}

template <class AL, class BL, class EP>
__device__ __forceinline__ void gemm_tile(const AL& al, const BL& bl, const EP& ep, int m0, int n0, int K, unsigned char* lds) {
    const int tid = tid_l() & 255, lane = tid & 63, w = tid >> 6, wm = w >> 1, wn = w & 1;
    bf16_t* sA = (bf16_t*)lds;
    bf16_t* sB = sA + 2 * 128 * 72;
    const int lr = tid >> 3, lk = (tid & 7) * 8;
    f32x4 acc[4][4];
#pragma unroll
    for (int i = 0; i < 4; ++i)
#pragma unroll
        for (int j = 0; j < 4; ++j) acc[i][j] = (f32x4){0.f, 0.f, 0.f, 0.f};
    uint4 ra0[4], rb0[4], ra1[4], rb1[4];
#define GLOAD(RA, RB, KT) { const int k_ = (KT) * 64 + lk; _Pragma("unroll") for (int x = 0; x < 4; ++x) { RA[x] = al.load(m0 + lr + 32 * x, k_); RB[x] = bl.load(n0 + lr + 32 * x, k_); } }
#define LSTORE(RA, RB, BUF) { bf16_t* a_ = sA + (BUF) * 128 * 72; bf16_t* b_ = sB + (BUF) * 128 * 72; _Pragma("unroll") for (int x = 0; x < 4; ++x) { *(uint4*)(a_ + (lr + 32 * x) * 72 + lk) = RA[x]; *(uint4*)(b_ + (lr + 32 * x) * 72 + lk) = RB[x]; } }
#define COMPUTE(BUF) { const bf16_t* a_ = sA + (BUF) * 128 * 72; const bf16_t* b_ = sB + (BUF) * 128 * 72; \
        _Pragma("unroll") for (int kh = 0; kh < 2; ++kh) { bf16x8 fw[4], ft[4]; \
            _Pragma("unroll") for (int i = 0; i < 4; ++i) fw[i] = as8(*(const uint4*)(b_ + (wn * 64 + i * 16 + (lane & 15)) * 72 + kh * 32 + (lane >> 4) * 8)); \
            _Pragma("unroll") for (int j = 0; j < 4; ++j) ft[j] = as8(*(const uint4*)(a_ + (wm * 64 + j * 16 + (lane & 15)) * 72 + kh * 32 + (lane >> 4) * 8)); \
            _Pragma("unroll") for (int i = 0; i < 4; ++i) _Pragma("unroll") for (int j = 0; j < 4; ++j) acc[i][j] = MFMA(fw[i], ft[j], acc[i][j]); } }
    const int nk = K >> 6;
    __syncthreads();
    GLOAD(ra0, rb0, 0); GLOAD(ra1, rb1, 1);
    LSTORE(ra0, rb0, 0);
    __syncthreads();
    for (int kt = 0; kt < nk; kt += 2) {
        GLOAD(ra0, rb0, (kt + 2 < nk ? kt + 2 : nk - 1));
        COMPUTE(0);
        LSTORE(ra1, rb1, 1);
        __syncthreads();
        GLOAD(ra1, rb1, (kt + 3 < nk ? kt + 3 : nk - 1));
        COMPUTE(1);
        if (kt + 2 < nk) LSTORE(ra0, rb0, 0);
        __syncthreads();
    }
#undef GLOAD
#undef LSTORE
#undef COMPUTE
    ep(acc, m0 + wm * 64, n0 + wn * 64, lane);
}
DEV void tile_map8(int it, int NT, int& tm, int& tn) { const int x = it & 7, q = it >> 3, c = NT >> 3; tn = x + 8 * (q % c); tm = q / c; }

struct LdPlain { const bf16_t* base; int ld; DEV uint4 load(int row, int k) const { return *(const uint4*)(base + (size_t)row * ld + k); } };
struct LdH1L { const bf16_t* H; DEV uint4 load(int m, int k) const { const int b = m >> 11, t = m & 2047; return *(const uint4*)(H + (size_t)(b * 2304 + 256 + t) * 1024 + k); } };
struct LdH1C { const bf16_t* H; DEV uint4 load(int m, int k) const { const int b = m >> 8, j = m & 255; return *(const uint4*)(H + (size_t)(b * 2304 + j) * 1024 + k); } };
struct LdD { const bf16_t* F; DEV uint4 load(int m, int k) const { const int kk = k < 1024 ? QOFF + k : GS5 + k - 1024; return *(const uint4*)(F + (size_t)m * F2LD + kk); } };
struct LdS5X { const bf16_t* FL; int g;
    DEV uint4 load(int n, int k) const { const int b = n / 72, c = n - b * 72, i = k >> 4, h = k & 15;
        const size_t off = c < 8 ? F2C_DELTA + (size_t)(b * 256 + c * 32 + i) * F2CLD : (size_t)(b * 2048 + (c - 8) * 32 + i) * F2LD;
        return *(const uint4*)(FL + off + UOFF + g * 16 + h); } };
struct LdS5YA { const bf16_t* FL; const bf16_t* S; int g;
    DEV uint4 load(int n, int k) const { const int b = n >> 6, cl = n & 63;
        const bf16_t* p = k < 512 ? FL + (size_t)(b * 2048 + cl * 32 + (k >> 4)) * F2LD + UOFF + g * 16 + (k & 15) : S + ((size_t)(b * 72 + cl + 8) * 64 + g) * 256 + (k - 512);
        return *(const uint4*)p; } };
struct LdS5YB { const bf16_t* KT2; const bf16_t* VT; int g;
    DEV uint4 load(int col, int k) const { const int t = col >> 4, h = col & 15;
        const bf16_t* p = k < 512 ? KT2 + ((size_t)(g * 63 + (t - (k >> 4) + 31)) * 16 + h) * 16 + (k & 15) : VT + ((size_t)g * 512 + col) * 256 + (k - 512);
        return *(const uint4*)p; } };

#define PG_ROWS_COLS(...) \
    _Pragma("unroll") for (int ai = 0; ai < 2; ++ai) _Pragma("unroll") for (int m = 0; m < 4; ++m) { const int row = u.pm * 256 + ai * 128 + wr * 64 + m * 16 + fr; \
        _Pragma("unroll") for (int bj = 0; bj < 2; ++bj) _Pragma("unroll") for (int n = 0; n < 2; ++n) { const int col = u.pn * 256 + bj * 128 + wc * 32 + n * 16 + fq * 4; const f32x4 v = acc[ai][bj][m][n]; __VA_ARGS__ } }
struct PgA {
    static constexpr bool PERM = false, AFTER_DRAIN = false;
    unsigned char* ws; const float* gkb; int par;
    DEV void operator()(const f32x4 (&acc)[2][2][4][2], const pg8::Unit& u, int wr, int wc, int fr, int fq) const {
        bf16_t* featb = (bf16_t*)(ws + WS_FEATB); unsigned short* featf = (unsigned short*)(ws + WS_FEATF);   bf16_t* gates = (bf16_t*)(ws + WS_GATES + (size_t)par * OBUF);
        PG_ROWS_COLS(
            if ((col >= 2048 && col < 3072) || (col >= 7168 && col < 8192)) {
                const int oc = col < 3072 ? col - 2048 : col - 6144;
                uint2 o; o.x = pk(v[0], v[1]); o.y = pk(v[2], v[3]); *(uint2*)(gates + (size_t)row * 2048 + oc) = o;
            } else if ((col >= 1024 && col < 2048) || (col >= 6144 && col < 7168)) {
                const int vc = col < 2048 ? col - 1024 : col - 5120; const int bl_ = row / 2304, j_ = row - bl_ * 2304;
                bf16_t* vt = (bf16_t*)(ws + (par ? WS_VTT1 : WS_VTT)) + (((size_t)(bl_ * 72 + (j_ >> 5)) * 2048 + vc) * 32 + (j_ & 31));
                const unsigned p01 = pk(v[0], v[1]), p23 = pk(v[2], v[3]);
                vt[0] = (bf16_t)(p01 & 0xffffu); vt[32] = (bf16_t)(p01 >> 16); vt[64] = (bf16_t)(p23 & 0xffffu); vt[96] = (bf16_t)(p23 >> 16);
            } else if (col < 4096 || (col >= 6144 && col < 8192)) {
                const float s = col < 512 ? 0.08838834764831845f : 1.f; const int oc = col < 4096 ? col : col - 2048;
                uint2 o; o.x = pk(v[0] * s, v[1] * s); o.y = pk(v[2] * s, v[3] * s); *(uint2*)(featb + (size_t)row * 6144 + oc) = o;
            } else if (col < 6144) {
                const int cc = col - 4096;
                *(uint2*)(featf + (size_t)row * 3072 + cc) = make_uint2(pkh(v[0], v[1]), pkh(v[2], v[3]));
            } else {
                const int cc = col - 8192; const f32x4 bb = *(const f32x4*)(gkb + cc);
                *(uint2*)(featf + (size_t)row * 3072 + 2048 + cc) = make_uint2(pkh(v[0] + bb[0], v[1] + bb[1]), pkh(v[2] + bb[2], v[3] + bb[3]));
            })
    }
};
struct PgC {
    static constexpr bool PERM = false, AFTER_DRAIN = false;
    const float* x; const float* ctx; float* out; float* xc; const float* mod; int grp;
    DEV void operator()(const f32x4 (&acc)[2][2][4][2], const pg8::Unit& u, int wr, int wc, int fr, int fq) const {
        PG_ROWS_COLS(
            const int R = grp * GROWS + row; const int b = R / 2304, jj = R - b * 2304; const bool isc = jj < 256;
            const size_t ro = isc ? (size_t)(b * 256 + jj) * 1024 : (size_t)(b * 2048 + jj - 256) * 1024;
            const f32x4 s = *(const f32x4*)((isc ? ctx : x) + ro + col); const f32x4 gt = *(const f32x4*)(mod + (size_t)(isc ? 16 : b) * 3072 + 2048 + col);
            *(f32x4*)((isc ? xc : out) + ro + col) = s + gt * v; )
    }
};
struct PgB {
    static constexpr bool PERM = false, AFTER_DRAIN = false;
    bf16_t* F; int ld; const float2* rope; int latent;
    DEV void operator()(const f32x4 (&acc)[2][2][4][2], const pg8::Unit& u, int wr, int wc, int fr, int fq) const {
#pragma unroll
        for (int ai = 0; ai < 2; ++ai)
#pragma unroll
            for (int m = 0; m < 4; ++m) { const int row = u.pm * 256 + ai * 128 + wr * 64 + m * 16 + fr; const int t = row & 2047;
#pragma unroll
                for (int bj = 0; bj < 2; ++bj) { const int cb = u.pn * 256 + bj * 128 + wc * 32; f32x4 v0 = acc[ai][bj][m][0], v1 = acc[ai][bj][m][1];
                    const bool isq = cb >= QOFF && cb < QOFF + 1024;
                    if (latent && (cb < VOFF || isq)) { const float sc = isq ? 0.125f : 1.f; const int pos = (cb & 32) ? (t & 63) : (t >> 6); f32x4 o0, o1;
#pragma unroll
                        for (int r = 0; r < 4; ++r) { const float2 cs = rope[pos * 16 + fq * 4 + r]; o0[r] = (v0[r] * cs.x - v1[r] * cs.y) * sc; o1[r] = (v1[r] * cs.x + v0[r] * cs.y) * sc; }
                        v0 = o0; v1 = o1; }
                    uint2 o; o.x = pk(v0[0], v0[1]); o.y = pk(v0[2], v0[3]); *(uint2*)(F + (size_t)row * ld + cb + fq * 4) = o;
                    o.x = pk(v1[0], v1[1]); o.y = pk(v1[2], v1[3]); *(uint2*)(F + (size_t)row * ld + cb + 16 + fq * 4) = o; } }
    }
};
struct PgGLU {
    static constexpr bool PERM = false, AFTER_DRAIN = false;
    bf16_t* F;
    DEV void operator()(const f32x4 (&acc)[2][2][4][2], const pg8::Unit& u, int wr, int wc, int fr, int fq) const {
#pragma unroll
        for (int ai = 0; ai < 2; ++ai)
#pragma unroll
            for (int m = 0; m < 4; ++m) { const int row = u.pm * 256 + ai * 128 + wr * 64 + m * 16 + fr;
#pragma unroll
                for (int n = 0; n < 2; ++n) { const int oc = u.pn * 128 + wc * 32 + n * 16 + fq * 4; const f32x4 a = acc[ai][0][m][n], b = acc[ai][1][m][n];
                    bf16_t* pp = F + (size_t)row * F2LD + GS5 + oc; const uint2 gg = *(const uint2*)pp;
                    const float g0 = bflo(gg.x), g1 = bfhi(gg.x), g2 = bflo(gg.y), g3 = bfhi(gg.y);
                    uint2 o; o.x = pk(a[0] * sigmoidf_(b[0]) * siluf_(g0), a[1] * sigmoidf_(b[1]) * siluf_(g1)); o.y = pk(a[2] * sigmoidf_(b[2]) * siluf_(g2), a[3] * sigmoidf_(b[3]) * siluf_(g3));
                    *(uint2*)pp = o; } }
    }
};
struct PgD {
    static constexpr bool PERM = false, AFTER_DRAIN = false;
    float* out; const float* mod;
    DEV void operator()(const f32x4 (&acc)[2][2][4][2], const pg8::Unit& u, int wr, int wc, int fr, int fq) const {
        PG_ROWS_COLS(
            float* dst = out + (size_t)row * 1024 + col; const f32x4 gt = *(const f32x4*)(mod + (size_t)(row >> 11) * 3072 + 2048 + col);
            *(f32x4*)dst = *(const f32x4*)dst + gt * v; )
    }
};
struct EpiS5X { bf16_t* S; int g, dir;
    DEV void operator()(f32x4 (&acc)[4][4], int mrow0, int ncol0, int lane) const {
#pragma unroll
        for (int j = 0; j < 4; ++j) { const int n = mrow0 + j * 16 + (lane & 15);
#pragma unroll
            for (int i = 0; i < 4; ++i) { const int col = ncol0 + i * 16 + (lane >> 4) * 4; const f32x4 v = acc[i][j];
                uint2 o; o.x = pk(v[0], v[1]); o.y = pk(v[2], v[3]); *(uint2*)(S + (((size_t)n * 64 + g) * 2 + dir) * 128 + col) = o; } }
    }
};
struct EpiS5Y { const bf16_t* FL; bf16_t* Z; const float* dsk; int g;
    DEV void operator()(f32x4 (&acc)[4][4], int mrow0, int ncol0, int lane) const {
#pragma unroll
        for (int j = 0; j < 4; ++j) { const int n = mrow0 + j * 16 + (lane & 15); const int b = n >> 6, cl = n & 63;
#pragma unroll
            for (int i = 0; i < 4; ++i) { const int t = (ncol0 >> 4) + i, h = (lane >> 4) * 4; const f32x4 v = acc[i][j];
                const size_t m = (size_t)b * 2048 + cl * 32 + t; const uint2 uu = *(const uint2*)(FL + m * F2LD + UOFF + g * 16 + h);
                const float4 dd = *(const float4*)(dsk + g * 16 + h);
                uint2 o; o.x = pk(geluf_(v[0] + dd.x * bflo(uu.x)), geluf_(v[1] + dd.y * bfhi(uu.x))); o.y = pk(geluf_(v[2] + dd.z * bflo(uu.y)), geluf_(v[3] + dd.w * bfhi(uu.y)));
                *(uint2*)(Z + m * 1024 + g * 16 + h) = o; } }
    }
};

template <class MAP>
__device__ __forceinline__ void transpose_tile(const float* src, int ldsrc, bf16_t* dst, int K, int n0, int k0, const MAP& map, unsigned char* lds) {
    float* tile = (float*)lds;
    const int tid = tid_l() & 255;
    __syncthreads();
#pragma unroll
    for (int e = 0; e < 16; ++e) { const int idx = tid + e * 256; const int kk = idx >> 6, nn = idx & 63; tile[kk * 65 + nn] = src[(size_t)(k0 + kk) * ldsrc + map(n0 + nn)]; }
    __syncthreads();
    const int nn = tid >> 2, kq = (tid & 3) * 16;
    unsigned o[8];
#pragma unroll
    for (int e = 0; e < 8; ++e) o[e] = pk(tile[(kq + 2 * e) * 65 + nn], tile[(kq + 2 * e + 1) * 65 + nn]);
    uint4* d = (uint4*)(dst + (size_t)(n0 + nn) * K + k0 + kq);
    d[0] = make_uint4(o[0], o[1], o[2], o[3]); d[1] = make_uint4(o[4], o[5], o[6], o[7]);
}
struct MapIn0 { DEV int operator()(int n) const { return n < 2048 ? n : n + 32; } };
struct MapId { DEV int operator()(int n) const { return n; } };
struct MapIn1 { DEV int operator()(int n) const { return n < 512 ? n + 1024 : n < 1536 ? n + 2048 : n < 2560 ? n : n < 3584 ? n - 2560 : n; } };
struct MapGlu { DEV int operator()(int n) const { return ((n >> 7) & 1) * 1024 + (n >> 8) * 128 + (n & 127); } };

__device__ __forceinline__ void prep_phase(const P& p, unsigned char* lds) {
    unsigned char* ws = p.ws;
    const int tid5 = tid_l(), half = tid5 >> 8, tid = tid5 & 255, nb = gridDim.x, bid = blockIdx.x;
    lds += half * HALF_LDS;
    constexpr int N_IN0 = 128 * 16, N_G = 16 * 16, N_OUT0 = 16 * 32, N_IN1 = 72 * 16, N_GLU = 32 * 16, N_OUT1 = 16 * 32, N_ADA = 96;
    constexpr int E0 = N_IN0, E1 = E0 + N_G, E2 = E1 + N_OUT0, E3 = E2 + N_IN1, E4 = E3 + N_GLU, E5 = E4 + N_OUT1, E6 = E5 + N_ADA;
    for (int it = bid * 2 + half; it < E6; it += nb * 2) {
        if (it < E0) { transpose_tile(p.ev_w_in, 8224, (bf16_t*)(ws + WS_WIN0), 1024, (it >> 4) * 64, (it & 15) * 64, MapIn0(), lds); }
        else if (it < E1) {
            const int i2 = it - E0; const int n0 = (i2 >> 4) * 64, k0 = (i2 & 15) * 64; const int nn = tid >> 2, kq = (tid & 3) * 16;
            const int n = n0 + nn, dd = n >> 9, cc = n & 511; float gw[16];
#pragma unroll
            for (int r = 0; r < 16; ++r) gw[r] = p.gk_w[(size_t)(dd * 16 + r) * 512 + cc];
            unsigned o[8];
#pragma unroll
            for (int e = 0; e < 8; ++e) { float v2[2];
#pragma unroll
                for (int q = 0; q < 2; ++q) { const float* wr = p.ev_w_in + (size_t)(k0 + kq + 2 * e + q) * 8224 + 2048 + dd * 16; float a = 0.f;
#pragma unroll
                    for (int r = 0; r < 16; ++r) a += wr[r] * gw[r];
                    v2[q] = a; }
                o[e] = pk(v2[0], v2[1]); }
            uint4* d = (uint4*)((bf16_t*)(ws + WS_WIN0) + (size_t)(8192 + n) * 1024 + k0 + kq);
            d[0] = make_uint4(o[0], o[1], o[2], o[3]); d[1] = make_uint4(o[4], o[5], o[6], o[7]);
        }
        else if (it < E2) { const int i2 = it - E1; transpose_tile(p.ev_w_out, 1024, (bf16_t*)(ws + WS_WOUT0), 2048, (i2 >> 5) * 64, (i2 & 31) * 64, MapId(), lds); }
        else if (it < E3) { const int i2 = it - E2; transpose_tile(p.od_w_in, 4608, (bf16_t*)(ws + WS_WIN1), 1024, (i2 >> 4) * 64, (i2 & 15) * 64, MapIn1(), lds); }
        else if (it < E4) { const int i2 = it - E3; transpose_tile(p.glu_w, 2048, (bf16_t*)(ws + WS_WGLU), 1024, (i2 >> 4) * 64, (i2 & 15) * 64, MapGlu(), lds); }
        else if (it < E5) { const int i2 = it - E4; transpose_tile(p.od_w_out, 1024, (bf16_t*)(ws + WS_WOUT1), 2048, (i2 >> 5) * 64, (i2 & 31) * 64, MapId(), lds); }
        else {
            const int i2 = it - E5; const int layer = i2 / 48, col0 = (i2 % 48) * 64;
            float* sc = (float*)lds;
            __syncthreads();
            for (int idx = tid; idx < 17 * 1024; idx += 256) { const int r = idx >> 10, k = idx & 1023; const float v = r < 16 ? p.c[r * 1024 + k] : p.c_ctx[k]; sc[idx] = v / (1.f + expf(-v)); }
            __syncthreads();
            const int cl = tid & 63, kq = tid >> 6; float a[17];
#pragma unroll
            for (int r = 0; r < 17; ++r) a[r] = 0.f;
            const float* wp = p.ada_w + (size_t)layer * 1024 * 3072 + col0 + cl;
            for (int k = kq * 256; k < kq * 256 + 256; k += 8) { float wv[8];
#pragma unroll
                for (int j = 0; j < 8; ++j) wv[j] = wp[(size_t)(k + j) * 3072];
#pragma unroll
                for (int j = 0; j < 8; ++j)
#pragma unroll
                    for (int r = 0; r < 17; ++r) a[r] += sc[r * 1024 + k + j] * wv[j]; }
            __syncthreads();
#pragma unroll
            for (int r = 0; r < 17; ++r) sc[(kq * 17 + r) * 64 + cl] = a[r];
            __syncthreads();
            for (int idx = tid; idx < 17 * 64; idx += 256) { const int r = idx >> 6, c2 = idx & 63;
                const float v = sc[(0 * 17 + r) * 64 + c2] + sc[(1 * 17 + r) * 64 + c2] + sc[(2 * 17 + r) * 64 + c2] + sc[(3 * 17 + r) * 64 + c2];
                ((float*)(ws + WS_MOD))[((size_t)layer * 17 + r) * 3072 + col0 + c2] = v + p.ada_b[layer * 3072 + col0 + c2]; }
        }
    }
    const int gt = bid * NTHR + tid5, gs = nb * NTHR;
    for (int idx = gt; idx < 2048; idx += gs) { const int d = idx >> 10, col = idx & 1023; const float r0 = p.lb_raw[d * 2048 + col], r1 = p.lb_raw[d * 2048 + 1024 + col]; ((float*)(ws + WS_LB))[idx] = 1.f / (1.f + expf(r1 - r0)); }
    for (int idx = gt; idx < 1024; idx += gs) { const int pos = idx >> 4, i = idx & 15; const float fr = powf(10000.f, -(float)i / 16.f); float s, c; sincosf((float)pos * fr, &s, &c); ((float2*)(ws + WS_ROPE))[idx] = make_float2(c, s); }
    for (int idx = gt; idx < 128 * 33 * 64; idx += gs) { const int pp = idx & 63, m = (idx >> 6) % 33, gd = idx / (64 * 33), g = gd >> 1, dir = gd & 1;
        const float lre = p.lam_re[dir * 4096 + g * 64 + pp], lim = p.lam_im[dir * 4096 + g * 64 + pp], dt = expf(p.log_dt[dir * 64 + g]);
        const float mag = expf(lre * dt * (float)m); float s, c; sincosf(lim * dt * (float)m, &s, &c); ((float2*)(ws + WS_PW))[idx] = make_float2(mag * c, mag * s); }
    for (int idx = gt; idx < 128 * 64 * 16; idx += gs) { const int h = idx & 15, pp = (idx >> 4) & 63, gd = idx >> 10, g = gd >> 1, dir = gd & 1;
        const float lre = p.lam_re[dir * 4096 + g * 64 + pp], lim = p.lam_im[dir * 4096 + g * 64 + pp], dt = expf(p.log_dt[dir * 64 + g]);
        const float mag = expf(lre * dt); float s, c; sincosf(lim * dt, &s, &c); const float xr = mag * c - 1.f, xi = mag * s, den = lre * lre + lim * lim;
        const float qr = (xr * lre + xi * lim) / den, qi = (xi * lre - xr * lim) / den; const float br = p.b_re[(g * 64 + pp) * 16 + h], bi = p.b_im[(g * 64 + pp) * 16 + h];
        ((float2*)(ws + WS_BB))[idx] = make_float2(qr * br - qi * bi, qr * bi + qi * br); }
}

__device__ __forceinline__ void normmod_phase(const P& p, int layer, int tok_lo, int tok_hi, int blk0, int nblk) {
    const int tid = tid_l(); const int lane = tid & 63, w = tid >> 6;
    const float* xc = (const float*)(p.ws + WS_XC); const float* mod = (const float*)(p.ws + WS_MOD) + (size_t)layer * 17 * 3072;
    bf16_t* H = (bf16_t*)(p.ws + WS_H); const float* ng = p.norm_g + layer * 1024;
    for (int tok = tok_lo + (blockIdx.x - blk0) * 8 + w; tok < tok_hi; tok += nblk * 8) {
        const int b = tok / 2304, j = tok - b * 2304; const bool isc = j < 256;
        const float* src = isc ? (layer == 0 ? p.ctx : xc) + (size_t)(b * 256 + j) * 1024 : (layer == 0 ? p.x : p.out) + (size_t)(b * 2048 + j - 256) * 1024;
        const float* md = mod + (size_t)(isc ? 16 : b) * 3072;
        const int hrow = layer == 0 ? tok : (isc ? 32768 + b * 256 + j : b * 2048 + j - 256);
        float4 v[4]; float ss = 0.f;
#pragma unroll
        for (int m = 0; m < 4; ++m) { v[m] = *(const float4*)(src + m * 256 + lane * 4); ss += v[m].x * v[m].x + v[m].y * v[m].y + v[m].z * v[m].z + v[m].w * v[m].w; }
#pragma unroll
        for (int o = 32; o >= 1; o >>= 1) ss += __shfl_xor(ss, o);
        const float rs = rsqrtf(ss * (1.f / 1024.f) + EPSN);
#pragma unroll
        for (int m = 0; m < 4; ++m) { const int col = m * 256 + lane * 4; const float4 g = *(const float4*)(ng + col), sh = *(const float4*)(md + col), sc = *(const float4*)(md + 1024 + col);
            uint2 o; o.x = pk(v[m].x * rs * g.x * (1.f + sc.x) + sh.x, v[m].y * rs * g.y * (1.f + sc.y) + sh.y); o.y = pk(v[m].z * rs * g.z * (1.f + sc.z) + sh.z, v[m].w * rs * g.w * (1.f + sc.w) + sh.w);
            *(uint2*)(H + (size_t)hrow * 1024 + col) = o; }
    }
}

__device__ __forceinline__ void pre_phase(const P& p, int par, int half, unsigned char* lds) {
    const int tid = tid_l() & 255, lane = tid & 63, w = tid >> 6;
    float* sG = (float*)lds;
    bf16_t* sQ = (bf16_t*)(lds + 33792);
    bf16_t* sK = sQ + 32 * 136;
    bf16_t* sT = sK + 32 * 136;
    bf16_t* sAtt = sT + 128 * 40;
    const bf16_t* FB = (const bf16_t*)(p.ws + WS_FEATB); const unsigned short* FF = (const unsigned short*)(p.ws + WS_FEATF);
    const int li = tid >> 3, seg = tid & 7, stride = gridDim.x * 2;
    uint4 nq0, nq1, nk0, nk1, ng00, ng01, ng10, ng11;
#define PRE_DEC(IT) const int chunk = (IT) % 72, t2 = (IT) / 72, head12 = t2 % 12, bl = t2 / 12; const int hgrn = head12 >= 4, head = hgrn ? head12 - 4 : head12; \
        const size_t row = (size_t)bl * 2304 + chunk * 32 + li;
#define PRE_LOAD(IT) { PRE_DEC(IT) const bf16_t* fb_ = FB + row * 6144; const int qo_ = hgrn ? 3072 + head * 128 : head * 128, ko_ = hgrn ? qo_ : 512 + head * 128; \
        nq0 = *(const uint4*)(fb_ + qo_ + seg * 16); nq1 = *(const uint4*)(fb_ + qo_ + seg * 16 + 8); nk0 = *(const uint4*)(fb_ + ko_ + seg * 16); nk1 = *(const uint4*)(fb_ + ko_ + seg * 16 + 8); \
        const unsigned short* f0_ = FF + row * 3072 + (hgrn ? head * 128 : 2048 + head * 128) + seg * 16; const unsigned short* f1_ = f0_ + (hgrn ? 1024 : 512); \
        ng00 = *(const uint4*)(f0_); ng01 = *(const uint4*)(f0_ + 8); ng10 = *(const uint4*)(f1_); ng11 = *(const uint4*)(f1_ + 8); }
    int it = blockIdx.x * 2 + half;
    if (it < 1728) PRE_LOAD(it)
    for (; it < 1728; it += stride) {
        PRE_DEC(it)
        const bf16_t* fb = FB + row * 6144;
        float q[16], kk_[16], g0[16], g1[16];
        unpack8(nq0, q); unpack8(nq1, q + 8); unpack8(nk0, kk_); unpack8(nk1, kk_ + 8);
        unpackh8(ng00, g0); unpackh8(ng01, g0 + 8); unpackh8(ng10, g1); unpackh8(ng11, g1 + 8);
        float kh0[16], kh1[16];
#pragma unroll
        for (int e = 0; e < 16; ++e) { kh0[e] = 0.f; kh1[e] = 0.f; }
        if (hgrn) {
            const float* lbp = (const float*)(p.ws + WS_LB) + head * 128 + seg * 16;
#pragma unroll
            for (int e4 = 0; e4 < 4; ++e4) { const float4 l0 = *(const float4*)(lbp + e4 * 4), l1 = *(const float4*)(lbp + 1024 + e4 * 4); const float la[4] = {l0.x, l0.y, l0.z, l0.w}, lc[4] = {l1.x, l1.y, l1.z, l1.w};
#pragma unroll
                for (int r = 0; r < 4; ++r) { const int e = e4 * 4 + r; const float f0 = la[r] + (1.f - la[r]) * rcpf_(1.f + __expf(-g0[e])), f1 = lc[r] + (1.f - lc[r]) * rcpf_(1.f + __expf(-g1[e]));
                    kh0[e] = 1.f - f0; kh1[e] = 1.f - f1; g0[e] = __logf(f0); g1[e] = __logf(f1); } }
        } else {
#pragma unroll
            for (int e = 0; e < 16; ++e) { g0[e] = (fminf(g0[e], 0.f) - __logf(1.f + __expf(-fabsf(g0[e])))) * 0.0625f; g1[e] = (fminf(g1[e], 0.f) - __logf(1.f + __expf(-fabsf(g1[e])))) * 0.0625f; }
        }
        { const int nx = it + stride < 1728 ? it + stride : it; PRE_LOAD(nx) }
#pragma unroll
        for (int e = 0; e < 4; ++e) { *(float4*)(sG + li * 132 + seg * 16 + e * 4) = make_float4(g0[4 * e], g0[4 * e + 1], g0[4 * e + 2], g0[4 * e + 3]);
            *(float4*)(sG + 32 * 132 + li * 132 + seg * 16 + e * 4) = make_float4(g1[4 * e], g1[4 * e + 1], g1[4 * e + 2], g1[4 * e + 3]); }
        __syncthreads();
        { float* pl = sG + (tid >> 7) * 32 * 132 + (tid & 127); float a = 0.f;
#pragma unroll
            for (int i = 0; i < 32; ++i) { a += pl[i * 132]; pl[i * 132] = a; } }
        __syncthreads();
#pragma unroll
        for (int dir = 0; dir < 2; ++dir) {
            const int hd = hgrn ? 8 + head * 2 + dir : head * 2 + dir;
            const size_t hb = ((size_t)(bl * 24 + hd) * 72 + chunk);
            float g[16];
#pragma unroll
            for (int e = 0; e < 16; ++e) g[e] = dir ? g1[e] : g0[e];
            {
                unsigned oq[8], ok[8];
                float Pv[16], PLv[16];
                const float* sGd = sG + dir * 32 * 132;
#pragma unroll
                for (int e4 = 0; e4 < 4; ++e4) { const float4 a4 = *(const float4*)(sGd + li * 132 + seg * 16 + e4 * 4), b4 = *(const float4*)(sGd + 31 * 132 + seg * 16 + e4 * 4);
                    Pv[4 * e4] = a4.x; Pv[4 * e4 + 1] = a4.y; Pv[4 * e4 + 2] = a4.z; Pv[4 * e4 + 3] = a4.w; PLv[4 * e4] = b4.x; PLv[4 * e4 + 1] = b4.y; PLv[4 * e4 + 2] = b4.z; PLv[4 * e4 + 3] = b4.w; }
                bf16_t* qd_g = (bf16_t*)(p.ws + WS_QD) + hb * 4096 + li * 128 + (seg >> 1) * 32 + (seg & 1) * 4;
#pragma unroll
                for (int e = 0; e < 16; e += 2) {
                    float qd[2], ki[2];
#pragma unroll
                    for (int u = 0; u < 2; ++u) { const float Pi = Pv[e + u], PL = PLv[e + u];
                        const float bc = dir ? PL - Pi + g[e + u] : Pi; const float kv = hgrn ? (dir ? kh1[e + u] : kh0[e + u]) : kk_[e + u];
                        qd[u] = q[e + u] * __expf(bc); ki[u] = kv * __expf(fminf(-bc, 87.f)); const float ktl = kv * __expf(PL - bc);
                        sT[((e + u) * 8 + seg) * 40 + li] = f2bf(ktl);
                        if (li == 31) ((float*)(p.ws + WS_DEC))[hb * 128 + seg * 16 + e + u] = __expf(PL); }
                    oq[e >> 1] = pk(qd[0], qd[1]); ok[e >> 1] = pk(ki[0], ki[1]);
                }
                *(uint4*)(sQ + li * 136 + seg * 16) = make_uint4(oq[0], oq[1], oq[2], oq[3]); *(uint4*)(sQ + li * 136 + seg * 16 + 8) = make_uint4(oq[4], oq[5], oq[6], oq[7]);
                *(uint4*)(sK + li * 136 + seg * 16) = make_uint4(ok[0], ok[1], ok[2], ok[3]); *(uint4*)(sK + li * 136 + seg * 16 + 8) = make_uint4(ok[4], ok[5], ok[6], ok[7]);
#pragma unroll
                for (int qg = 0; qg < 4; ++qg) *(uint2*)(qd_g + qg * 8) = make_uint2(oq[qg * 2], oq[qg * 2 + 1]);
            }
            __syncthreads();
            {
                const int ti = w >> 1, tj = w & 1; f32x4 a = (f32x4){0.f, 0.f, 0.f, 0.f};
                if (dir ? !(ti == 1 && tj == 0) : !(ti == 0 && tj == 1)) {
#pragma unroll
                    for (int kk = 0; kk < 4; ++kk) { const bf16x8 A = as8(*(const uint4*)(sQ + (ti * 16 + (lane & 15)) * 136 + kk * 32 + (lane >> 4) * 8)); const bf16x8 B = as8(*(const uint4*)(sK + (tj * 16 + (lane & 15)) * 136 + kk * 32 + (lane >> 4) * 8)); a = MFMA(A, B, a); }
                }
#pragma unroll
                for (int r = 0; r < 4; ++r) { const int c = ti * 16 + (lane >> 4) * 4 + r, s2 = tj * 16 + (lane & 15); const bool keep = dir ? (s2 >= c) : (s2 <= c); sAtt[c * 40 + s2] = f2bf(keep ? a[r] : 0.f); }
            }
            __syncthreads();
            {
                const int d = tid >> 1, part = tid & 1; bf16_t* kt_g = (bf16_t*)(p.ws + WS_KTT) + hb * 4096 + d * 32 + part * 16;
                const int dr = (d & 15) * 8 + (d >> 4);
                *(uint4*)kt_g = *(const uint4*)(sT + dr * 40 + part * 16); *(uint4*)(kt_g + 8) = *(const uint4*)(sT + dr * 40 + part * 16 + 8);
                if (tid < 128) { const int r = tid >> 2, pt = tid & 3; *(uint4*)((bf16_t*)(p.ws + WS_ATT) + hb * 1024 + r * 32 + pt * 8) = *(const uint4*)(sAtt + r * 40 + pt * 8); }
            }
            if (dir == 0) __syncthreads();
        }
    }
#undef PRE_DEC
#undef PRE_LOAD
}

__device__ __forceinline__ void seq_block(const P& p, int par, int blk, unsigned char* lds) {
    const int tid = tid_l(), lane = tid & 63, w = tid >> 6, fr = lane & 15, fq = lane >> 4;
    int bl, hd, vcol0;
    if (blk < 32) { bl = blk >> 4; hd = (blk >> 1) & 7; vcol0 = (hd >> 1) * 256 + (blk & 1) * 128; } else { const int b2 = blk - 32; bl = b2 >> 4; hd = 8 + (b2 & 15); vcol0 = 1024 + ((hd - 8) >> 1) * 128; }
    const int dir = hd & 1, vcol = vcol0 + w * 16;
    bf16_t* O = (bf16_t*)(p.ws + (dir ? WS_OB : WS_OF) + (size_t)par * OBUF);
    const size_t hb = (size_t)(bl * 24 + hd) * 72;
    const size_t QDo = WS_QD + hb * 8192, KTo = WS_KTT + hb * 8192, ATo = WS_ATT + hb * 2048, DCo = WS_DEC + hb * 512, VTo = (par ? WS_VTT1 : WS_VTT) + (size_t)bl * 72 * 131072;
    const char* wsb = (const char*)p.ws;
    const size_t o0 = QDo + ((((w >> 2) * 16 + fr) * 128 + (w & 3) * 32 + fq * 8) * 2);
    const size_t o1 = w < 2 ? ATo + (((w * 16 + fr) * 32 + fq * 8) * 2) : KTo + ((((w - 2) * 16 + fr) * 32 + fq * 8) * 2);
    const size_t o2 = w < 2 ? KTo + ((((w + 6) * 16 + fr) * 32 + fq * 8) * 2) : DCo + (lane & 31) * 16;
    const size_t o3 = VTo + (((vcol + fr) * 32 + fq * 8) * 2);
    const char* b0 = wsb + o0; const char* b1 = wsb + o1; const char* b2 = wsb + o2; const char* b3 = wsb + o3;
    const unsigned s0 = 8192, s1 = w < 2 ? 2048u : 8192u, s2 = w < 2 ? 8192u : 512u, s3 = 131072;
    const int id0 = w, id1 = w + 8, id2 = w < 3 ? w + 16 : 18, id3 = 19 + w;
    f32x4 S[8];
#pragma unroll
    for (int d = 0; d < 8; ++d) S[d] = (f32x4){0.f, 0.f, 0.f, 0.f};
    uint4 stA0, stA1, stA2, stA3, stB0, stB1, stB2, stB3, stC0, stC1, stC2, stC3, stD0, stD1, stD2, stD3;
#define SQ_CH(CC) (dir ? ((CC) < 8 ? 7 - (CC) : 79 - (CC)) : (CC))
#define SQ_LOAD(ST, CC) { const size_t c_ = (size_t)SQ_CH((CC) < 72 ? (CC) : 71); ST##0 = *(const uint4*)(b0 + c_ * s0); ST##1 = *(const uint4*)(b1 + c_ * s1); ST##2 = *(const uint4*)(b2 + c_ * s2); ST##3 = *(const uint4*)(b3 + c_ * s3); }
#define SQ_STEP(ST, CC) { unsigned char* sl = lds + ((CC) & 1) * 27648; \
        *(uint4*)(sl + id0 * 1024 + lane * 16) = ST##0; *(uint4*)(sl + id1 * 1024 + lane * 16) = ST##1; if (w < 3) *(uint4*)(sl + id2 * 1024 + lane * 16) = ST##2; *(uint4*)(sl + id3 * 1024 + lane * 16) = ST##3; \
        SQ_LOAD(ST, (CC) + 4); \
        __syncthreads(); \
        const int c = SQ_CH(CC); \
        const bf16x8 Bv = as8(*(const uint4*)(sl + id3 * 1024 + lane * 16)); \
        bf16x8 SB[4]; \
        _Pragma("unroll") for (int kk = 0; kk < 4; ++kk) SB[kk] = as8(make_uint4(pk(S[2 * kk][0], S[2 * kk][1]), pk(S[2 * kk][2], S[2 * kk][3]), pk(S[2 * kk + 1][0], S[2 * kk + 1][1]), pk(S[2 * kk + 1][2], S[2 * kk + 1][3]))); \
        _Pragma("unroll") for (int ci = 0; ci < 2; ++ci) { f32x4 o = (f32x4){0.f, 0.f, 0.f, 0.f}; \
            o = MFMA(Bv, as8(*(const uint4*)(sl + (8 + ci) * 1024 + lane * 16)), o); \
            _Pragma("unroll") for (int kk = 0; kk < 4; ++kk) o = MFMA(SB[kk], as8(*(const uint4*)(sl + (ci * 4 + kk) * 1024 + lane * 16)), o); \
            uint2 ov; ov.x = pk(o[0], o[1]); ov.y = pk(o[2], o[3]); \
            *(uint2*)(O + ((size_t)bl * 2304 + c * 32 + ci * 16 + fr) * 2048 + vcol + fq * 4) = ov; } \
        _Pragma("unroll") for (int dt = 0; dt < 8; ++dt) { const f32x4 dcv = *(const f32x4*)(sl + 18 * 1024 + (dt * 4 + fq) * 16); \
            S[dt] = S[dt] * dcv; S[dt] = MFMA(as8(*(const uint4*)(sl + (10 + dt) * 1024 + lane * 16)), Bv, S[dt]); } }
    SQ_LOAD(stA, 0); SQ_LOAD(stB, 1); SQ_LOAD(stC, 2); SQ_LOAD(stD, 3);
    __syncthreads();
    for (int cc = 0; cc < 72; cc += 4) { SQ_STEP(stA, cc); SQ_STEP(stB, cc + 1); SQ_STEP(stC, cc + 2); SQ_STEP(stD, cc + 3); }
    __syncthreads();
#undef SQ_CH
#undef SQ_LOAD
#undef SQ_STEP
}

__device__ __forceinline__ void gatenorm_phase(const P& p, int par) {
    const int tid = tid_l(); const int lane = tid & 63, w = tid >> 6;
    bf16_t* OF = (bf16_t*)(p.ws + WS_OF + (size_t)par * OBUF); const bf16_t* OB = (const bf16_t*)(p.ws + WS_OB + (size_t)par * OBUF); const bf16_t* GT = (const bf16_t*)(p.ws + WS_GATES + (size_t)par * OBUF);
    for (int r = blockIdx.x * 8 + w; r < GROWS; r += gridDim.x * 8) {
#pragma unroll
        for (int m = 0; m < 4; ++m) { const int col = m * 512 + lane * 8;
            float a[8], b[8], gt[8]; unpack8(*(const uint4*)(OF + (size_t)r * 2048 + col), a); unpack8(*(const uint4*)(OB + (size_t)r * 2048 + col), b);
            unpack8(*(const uint4*)(GT + (size_t)r * 2048 + col), gt);
            float ss = 0.f;
#pragma unroll
            for (int e = 0; e < 8; ++e) { a[e] += b[e]; ss += a[e] * a[e]; }
            ss += __shfl_xor(ss, 1); ss += __shfl_xor(ss, 2); ss += __shfl_xor(ss, 4); ss += __shfl_xor(ss, 8);
            float rs; const float* gw;
            if (m < 2) { ss += __shfl_xor(ss, 16); rs = rsqrtf(ss * (1.f / 256.f) + EPSN); gw = p.gla_g + (col & 255); } else { rs = rsqrtf(ss * (1.f / 128.f) + EPSN); gw = p.hg_g + (col & 127); }
            unsigned o[4];
#pragma unroll
            for (int e = 0; e < 8; e += 2) o[e >> 1] = pk(a[e] * rs * gw[e] * siluf_(gt[e]), a[e + 1] * rs * gw[e + 1] * siluf_(gt[e + 1]));
            *(uint4*)(OF + (size_t)r * 2048 + col) = make_uint4(o[0], o[1], o[2], o[3]); }
    }
}

#define DPPF(V, CTRL) __builtin_bit_cast(float, __builtin_amdgcn_update_dpp(0, __builtin_bit_cast(int, (V)), (CTRL), 0xF, 0xF, false))
DEV float rowmax16(float v) { v = fmaxf(v, DPPF(v, 0xB1)); v = fmaxf(v, DPPF(v, 0x4E)); v = fmaxf(v, DPPF(v, 0x124)); v = fmaxf(v, DPPF(v, 0x128)); return v; }
DEV float rowsum16(float v) { v += DPPF(v, 0xB1); v += DPPF(v, 0x4E); v += DPPF(v, 0x124); v += DPPF(v, 0x128); return v; }
__device__ __forceinline__ void attn_item(const P& p, int item, unsigned char* lds) {
    const int tid = tid_l() & 255, lane = tid & 63, w = tid >> 6, fr = lane & 15, fq = lane >> 4;
    bf16_t* sKb = (bf16_t*)lds;
    bf16_t* sVb = sKb + 2 * 64 * 72;
    bf16_t* FL = (bf16_t*)(p.ws + WS_F2L);
    const int nb = (item >> 1) & 15, hq = ((item >> 5) & 7) * 2 + (item & 1), b = item >> 8, kv = hq >> 2;
    const float sinkv = p.sink[hq];
    const size_t qrow0 = (size_t)b * 2048 + nb * 128 + w * 32;
    bf16x8 qf[2][2];
#pragma unroll
    for (int rt = 0; rt < 2; ++rt)
#pragma unroll
        for (int kk = 0; kk < 2; ++kk) qf[rt][kk] = as8(*(const uint4*)(FL + (qrow0 + rt * 16 + fr) * F2LD + QOFF + hq * 64 + kk * 32 + fq * 8));
    float mrow[2], lrow[2]; f32x4 o[2][4];
#pragma unroll
    for (int rt = 0; rt < 2; ++rt) { mrow[rt] = sinkv; lrow[rt] = fq == 0 ? 1.f : 0.f;
#pragma unroll
        for (int dt = 0; dt < 4; ++dt) o[rt][dt] = (f32x4){0.f, 0.f, 0.f, 0.f}; }
    const int bt_lo = nb == 0 ? 2 : 0, ntile = 4 + ((nb == 15 ? 3 : 5) - bt_lo + 1);
    uint4 rk0, rk1, rv0, rv1;
#define AT_LOAD(T) { const int t_ = (T) < ntile ? (T) : ntile - 1; const bool cx_ = t_ < 4; const int kp_ = (nb - 1) * 128 + (bt_lo + t_ - 4) * 64; \
        const size_t ro_ = cx_ ? F2C_DELTA + (size_t)(b * 256 + t_ * 64) * F2CLD : (size_t)(b * 2048 + kp_) * F2LD; const int ld_ = cx_ ? F2CLD : F2LD; \
        const bf16_t* kp0_ = FL + ro_ + kv * 64 + (size_t)(tid >> 3) * ld_ + (tid & 7) * 8; \
        rk0 = *(const uint4*)(kp0_ + KOFF); rk1 = *(const uint4*)(kp0_ + (size_t)32 * ld_ + KOFF); \
        const bf16_t* vp0_ = FL + ro_ + kv * 64 + VOFF + (size_t)(tid & 63) * ld_ + (tid >> 6) * 16;     \
        rv0 = *(const uint4*)vp0_; rv1 = *(const uint4*)(vp0_ + 8); }
#define AT_STAGE(BUF) { bf16_t* sK = sKb + (BUF) * 64 * 72; bf16_t* sVT = sVb + (BUF) * 64 * 72; const int key = tid >> 3, ds = (tid & 7) * 8; \
        *(uint4*)(sK + key * 72 + ds) = rk0; *(uint4*)(sK + (key + 32) * 72 + ds) = rk1; \
        const unsigned vw0[4] = {rv0.x, rv0.y, rv0.z, rv0.w}; const unsigned vw1[4] = {rv1.x, rv1.y, rv1.z, rv1.w}; \
        const int vk = tid & 63, vd = (tid >> 6) * 16; \
        _Pragma("unroll") for (int e2 = 0; e2 < 4; ++e2) { sVT[(vd + 2 * e2) * 72 + vk] = (bf16_t)(vw0[e2] & 0xffffu); sVT[(vd + 2 * e2 + 1) * 72 + vk] = (bf16_t)(vw0[e2] >> 16); \
            sVT[(vd + 8 + 2 * e2) * 72 + vk] = (bf16_t)(vw1[e2] & 0xffffu); sVT[(vd + 8 + 2 * e2 + 1) * 72 + vk] = (bf16_t)(vw1[e2] >> 16); } }
    __syncthreads();
    AT_LOAD(0); AT_STAGE(0); AT_LOAD(1);
    __syncthreads();
    for (int tile = 0; tile < ntile; ++tile) {
        const bool masked = tile >= 4; const int kpos0 = (nb - 1) * 128 + (bt_lo + tile - 4) * 64;
        if (tile + 1 < ntile) AT_STAGE((tile + 1) & 1);
        AT_LOAD(tile + 2);
        const bf16_t* sK = sKb + (tile & 1) * 64 * 72; const bf16_t* sVT = sVb + (tile & 1) * 64 * 72;
        f32x4 s[2][4];
#pragma unroll
        for (int kt = 0; kt < 4; ++kt) { const bf16x8 K0 = as8(*(const uint4*)(sK + (kt * 16 + fr) * 72 + fq * 8)), K1 = as8(*(const uint4*)(sK + (kt * 16 + fr) * 72 + 32 + fq * 8));
#pragma unroll
            for (int rt = 0; rt < 2; ++rt) { f32x4 a = (f32x4){0.f, 0.f, 0.f, 0.f}; a = MFMA(K0, qf[rt][0], a); a = MFMA(K1, qf[rt][1], a); s[rt][kt] = a; } }
        const int q0w = nb * 128 + w * 32;
        if (masked && (kpos0 < q0w + 31 - 128 || kpos0 + 63 > q0w + 128)) {
#pragma unroll
            for (int rt = 0; rt < 2; ++rt)
#pragma unroll
                for (int kt = 0; kt < 4; ++kt)
#pragma unroll
                    for (int r = 0; r < 4; ++r) { const int qpos = nb * 128 + w * 32 + rt * 16 + fr, kpos = kpos0 + kt * 16 + fq * 4 + r; const int d = qpos - kpos; if (d > 128 || d < -128) s[rt][kt][r] = -1e30f; }
        }
        bf16x8 PB[2][2];
#pragma unroll
        for (int rt = 0; rt < 2; ++rt) {
            float mx = -1e30f;
#pragma unroll
            for (int kt = 0; kt < 4; ++kt) mx = fmaxf(mx, fmaxf(fmaxf(s[rt][kt][0], s[rt][kt][1]), fmaxf(s[rt][kt][2], s[rt][kt][3])));
            mx = fmaxf(mx, __shfl_xor(mx, 16)); mx = fmaxf(mx, __shfl_xor(mx, 32));
            const float mn = fmaxf(mrow[rt], mx), alpha = __expf(mrow[rt] - mn); mrow[rt] = mn; float ps = 0.f;
            float pv[4][4];
#pragma unroll
            for (int kt = 0; kt < 4; ++kt)
#pragma unroll
                for (int r = 0; r < 4; ++r) { pv[kt][r] = __expf(s[rt][kt][r] - mn); ps += pv[kt][r]; }
            lrow[rt] = lrow[rt] * alpha + ps;
#pragma unroll
            for (int kp = 0; kp < 2; ++kp) PB[rt][kp] = as8(make_uint4(pk(pv[2 * kp][0], pv[2 * kp][1]), pk(pv[2 * kp][2], pv[2 * kp][3]), pk(pv[2 * kp + 1][0], pv[2 * kp + 1][1]), pk(pv[2 * kp + 1][2], pv[2 * kp + 1][3])));
#pragma unroll
            for (int dt = 0; dt < 4; ++dt) o[rt][dt] = o[rt][dt] * alpha;
        }
#pragma unroll
        for (int dt = 0; dt < 4; ++dt)
#pragma unroll
            for (int kp = 0; kp < 2; ++kp) { const bf16_t* vp = sVT + (dt * 16 + fr) * 72 + kp * 32 + fq * 4; const uint2 v0 = *(const uint2*)vp, v1 = *(const uint2*)(vp + 16);
                const bf16x8 VA = as8(make_uint4(v0.x, v0.y, v1.x, v1.y));
#pragma unroll
                for (int rt = 0; rt < 2; ++rt) o[rt][dt] = MFMA(VA, PB[rt][kp], o[rt][dt]); }
        __syncthreads();
    }
#undef AT_LOAD
#undef AT_STAGE
#pragma unroll
    for (int rt = 0; rt < 2; ++rt) { float l = lrow[rt]; l += __shfl_xor(l, 16); l += __shfl_xor(l, 32); const float inv = 1.f / l;
        bf16_t* rp = FL + (qrow0 + rt * 16 + fr) * F2LD;
#pragma unroll
        for (int dt = 0; dt < 4; ++dt) { const int d = hq * 64 + dt * 16 + fq * 4; const uint2 gg = *(const uint2*)(rp + GATT + d);
            uint2 ov; ov.x = pk(o[rt][dt][0] * inv * siluf_(bflo(gg.x)), o[rt][dt][1] * inv * siluf_(bfhi(gg.x))); ov.y = pk(o[rt][dt][2] * inv * siluf_(bflo(gg.y)), o[rt][dt][3] * inv * siluf_(bfhi(gg.y)));
            *(uint2*)(rp + QOFF + d) = ov; } }
}

__device__ __forceinline__ void s5tab_phase(const P& p) {
    unsigned char* ws = p.ws; const int gt = blockIdx.x * NTHR + tid_l(), gs = gridDim.x * NTHR;
    const float2* PW = (const float2*)(ws + WS_PW); const float2* BB = (const float2*)(ws + WS_BB);
    for (int idx = gt; idx < 128 * 64; idx += gs) ((float2*)(ws + WS_A32))[idx] = PW[((idx >> 6) * 33 + 32) * 64 + (idx & 63)];
    bf16_t* WX = (bf16_t*)(ws + WS_WX);
    for (int i8 = gt; i8 < 128 * 128 * 512 / 8; i8 += gs) { const int idx = i8 * 8;
        const int k = idx & 511, pc = (idx >> 9) & 127, gd = idx >> 16, pp = pc >> 1, ci = pc & 1, i = k >> 4, h0 = k & 15, dir = gd & 1;
        const int m = dir ? i : 31 - i; const float2 a = PW[(gd * 33 + m) * 64 + pp]; const float4* bp = (const float4*)(BB + (gd * 64 + pp) * 16 + h0);
        const float4 b0 = bp[0], b1 = bp[1], b2 = bp[2], b3 = bp[3];
#define WXV(BX, BY) (ci ? a.x * (BY) + a.y * (BX) : a.x * (BX) - a.y * (BY))
        *(uint4*)(WX + idx) = make_uint4(pk(WXV(b0.x, b0.y), WXV(b0.z, b0.w)), pk(WXV(b1.x, b1.y), WXV(b1.z, b1.w)), pk(WXV(b2.x, b2.y), WXV(b2.z, b2.w)), pk(WXV(b3.x, b3.y), WXV(b3.z, b3.w)));
#undef WXV
    }
    bf16_t* VT = (bf16_t*)(ws + WS_VT);
    for (int i8 = gt; i8 < 64 * 512 * 256 / 8; i8 += gs) { const int idx = i8 * 8;
        const int kk = idx & 255, col = (idx >> 8) & 511, g = idx >> 17, dir = kk >> 7, pp = (kk >> 1) & 63, t = col >> 4, h = col & 15;
        const int m = dir ? 32 - t : t + 1; const float4* ap = (const float4*)(PW + ((g * 2 + dir) * 33 + m) * 64 + pp); const float4 a0 = ap[0], a1 = ap[1];
        const float4 cr = *(const float4*)(p.c_re + (g * 16 + h) * 64 + pp), cm = *(const float4*)(p.c_im + (g * 16 + h) * 64 + pp);
        *(uint4*)(VT + idx) = make_uint4(pk(cr.x * a0.x - cm.x * a0.y, -(cr.x * a0.y + cm.x * a0.x)), pk(cr.y * a0.z - cm.y * a0.w, -(cr.y * a0.w + cm.y * a0.z)),
                                         pk(cr.z * a1.x - cm.z * a1.y, -(cr.z * a1.y + cm.z * a1.x)), pk(cr.w * a1.z - cm.w * a1.w, -(cr.w * a1.w + cm.w * a1.z)));
    }
    bf16_t* KT2 = (bf16_t*)(ws + WS_KT2);
    for (int i4 = gt; i4 < 64 * 63 * 256 / 4; i4 += gs) { const int idx = i4 * 4;
        const int hp = idx & 15, h = (idx >> 4) & 15, mm = (idx >> 8) % 63, g = idx / (63 * 256); float acc0 = 0.f, acc1 = 0.f, acc2 = 0.f, acc3 = 0.f;
        for (int dir = 0; dir < 2; ++dir) { const int m = dir ? 31 - mm : mm - 31; if (m < 0) continue; const int gd = g * 2 + dir;
            for (int pp = 0; pp < 64; ++pp) { const float2 a = PW[(gd * 33 + m) * 64 + pp]; const float4* bp = (const float4*)(BB + (gd * 64 + pp) * 16 + hp); const float4 b0 = bp[0], b1 = bp[1];
                const float cr = p.c_re[(g * 16 + h) * 64 + pp], cim = p.c_im[(g * 16 + h) * 64 + pp];
                const float er = cr * a.x - cim * a.y, ei = cr * a.y + cim * a.x;
                acc0 += er * b0.x - ei * b0.y; acc1 += er * b0.z - ei * b0.w; acc2 += er * b1.x - ei * b1.y; acc3 += er * b1.z - ei * b1.w; } }
        *(uint2*)(KT2 + idx) = make_uint2(pk(acc0, acc1), pk(acc2, acc3)); }
}

__device__ __forceinline__ void s5scan_phase(const P& p) {
    unsigned* S32 = (unsigned*)(p.ws + WS_S); const float2* A32 = (const float2*)(p.ws + WS_A32);
    for (int idx = blockIdx.x * NTHR + tid_l(); idx < 16 * 64 * 2 * 64; idx += gridDim.x * NTHR) {
        const int pp = idx & 63, dir = (idx >> 6) & 1, g = (idx >> 7) & 63, b = idx >> 13; const float2 a = A32[(g * 2 + dir) * 64 + pp];
        float sr = 0.f, si = 0.f;
        unsigned* base = S32 + ((size_t)(b * 72) * 64 + g) * 128 + dir * 64 + pp;
        for (int i0 = 0; i0 < 72; i0 += 8) {
            unsigned wv[8];
#pragma unroll
            for (int j = 0; j < 8; ++j) { const int i = i0 + j, c = dir ? (i < 8 ? 7 - i : 79 - i) : i; wv[j] = base[(size_t)c * 8192]; }
#pragma unroll
            for (int j = 0; j < 8; ++j) { const int i = i0 + j, c = dir ? (i < 8 ? 7 - i : 79 - i) : i; base[(size_t)c * 8192] = pk(sr, si);
                const float nr = a.x * sr - a.y * si + bflo(wv[j]), ni = a.x * si + a.y * sr + bfhi(wv[j]); sr = nr; si = ni; }
        }
    }
}

__device__ __forceinline__ void final_phase(const P& p) {
    const int tid = tid_l(); const int lane = tid & 63, w = tid >> 6;
    for (int tok = blockIdx.x * 8 + w; tok < 32768; tok += gridDim.x * 8) {
        float* row = p.out + (size_t)tok * 1024; float4 v[4]; float ss = 0.f;
#pragma unroll
        for (int m = 0; m < 4; ++m) { v[m] = *(const float4*)(row + m * 256 + lane * 4); ss += v[m].x * v[m].x + v[m].y * v[m].y + v[m].z * v[m].z + v[m].w * v[m].w; }
#pragma unroll
        for (int o = 32; o >= 1; o >>= 1) ss += __shfl_xor(ss, o);
        const float rs = rsqrtf(ss * (1.f / 1024.f) + EPSN);
#pragma unroll
        for (int m = 0; m < 4; ++m) { const int col = m * 256 + lane * 4; const float4 g = *(const float4*)(p.final_g + col);
            float4 o; o.x = v[m].x * rs * g.x; o.y = v[m].y * rs * g.y; o.z = v[m].z * rs * g.z; o.w = v[m].w * rs * g.w; *(float4*)(row + col) = o; }
    }
}

#define LAS __attribute__((address_space(3)))
#define XB_TMO      128
#define XB_XCNT(j)  (256  + 64 * (j))
#define XB_XSUB(j)  (1280 + 64 * (j))
#define XB_XGEN(j)  (2304 + 64 * (j))
#define XB_TOP      3328
#define XB_TOPGEN   3392
#define XCD_BAR_WORDS 3456
#define XB_SPIN_CAP (1u << 18)

__device__ __forceinline__ unsigned xb_ld(unsigned* p)              { return __hip_atomic_load(p, __ATOMIC_RELAXED, __HIP_MEMORY_SCOPE_AGENT); }
__device__ __forceinline__ unsigned xb_add(unsigned* p, unsigned v) { return __hip_atomic_fetch_add(p, v, __ATOMIC_RELAXED, __HIP_MEMORY_SCOPE_AGENT); }
__device__ __forceinline__ unsigned xb_xcc_id() { return (unsigned)__builtin_amdgcn_s_getreg((3 << 11) | 20) & 0xFu; }
#define XB_SPIN(cond, bar) do { unsigned _sp = 0; while (cond) { __builtin_amdgcn_s_sleep(1); \
    if ((++_sp & 255u) == 0u) { if (xb_ld(&(bar)[XB_TMO])) break; if (_sp > XB_SPIN_CAP) { atomicAdd(&(bar)[XB_TMO], 1u); break; } } } } while (0)

struct XcdBarrier {
    unsigned* bar; unsigned x;
    volatile LAS unsigned* st;
};

__device__ __forceinline__ XcdBarrier xcd_barrier_post(unsigned* bar, volatile LAS unsigned* st) {
    XcdBarrier b; b.bar = bar; b.x = xb_xcc_id(); b.st = st;
    if (threadIdx.x == 0) (void)xb_add(&bar[XB_XCNT(b.x)], 1u);
    return b;
}
__device__ __forceinline__ void xcd_barrier_complete(unsigned* bar, unsigned x, unsigned& nloc, unsigned& nx) {
    const unsigned G = gridDim.x * gridDim.y * gridDim.z;
    unsigned sum, cnt, mine, sp = 0u;
    for (;;) {
        sum = 0u; cnt = 0u; mine = 0u;
#pragma unroll
        for (unsigned j = 0; j < 16; ++j) { const unsigned c = xb_ld(&bar[XB_XCNT(j)]); sum += c; cnt += (c > 0u) ? 1u : 0u; mine = (j == x) ? c : mine; }
        if (sum == G) break;
        __builtin_amdgcn_s_sleep(1);
        if ((++sp & 255u) == 0u) { if (xb_ld(&bar[XB_TMO])) break; if (sp > XB_SPIN_CAP) { atomicAdd(&bar[XB_TMO], 1u); break; } }
    }
    nloc = mine > 0u ? mine : 1u; nx = cnt > 0u ? cnt : 1u;
}

__device__ __forceinline__ void xcd_barrier(const XcdBarrier& b) {
    asm volatile("s_waitcnt vmcnt(0)" ::: "memory");
    __syncthreads();
    if (threadIdx.x == 0) {
        unsigned* bar = b.bar;
        __builtin_amdgcn_s_waitcnt(0);
        unsigned nloc = b.st[0], nx = b.st[1];
        if (nloc == 0u) { xcd_barrier_complete(bar, b.x, nloc, nx); b.st[0] = nloc; b.st[1] = nx; }
        const unsigned old = xb_add(&bar[XB_XSUB(b.x)], 1u);
        const unsigned gen = old / nloc;
        if (old + 1u == (gen + 1u) * nloc) {
            __builtin_amdgcn_fence(__ATOMIC_RELEASE, "agent");
            asm volatile("s_waitcnt vmcnt(0)" ::: "memory");
            const unsigned og = xb_add(&bar[XB_TOP], 1u);
            const unsigned tg = og / nx;
            if (og + 1u == (tg + 1u) * nx) xb_add(&bar[XB_TOPGEN], 1u);
            else XB_SPIN(xb_ld(&bar[XB_TOPGEN]) == tg, bar);
            __builtin_amdgcn_fence(__ATOMIC_ACQUIRE, "agent");
            xb_add(&bar[XB_XGEN(b.x)], 1u);
            asm volatile("s_waitcnt vmcnt(0)" ::: "memory");
        } else {
            XB_SPIN(xb_ld(&bar[XB_XGEN(b.x)]) == gen, bar);
            __builtin_amdgcn_fence(__ATOMIC_ACQUIRE, "agent");
            asm volatile("s_waitcnt vmcnt(0)" ::: "memory");
        }
    }
    __syncthreads();
}

struct ListOrder {
    int nM, nN, nwg, base, step, cnt;
    __device__ void init(int M, int N, int base_, int step_, int cnt_) { nM = M / 256; nN = N / 256; nwg = nM * nN; base = base_; step = step_; cnt = cnt_; }
    __device__ bool next(int i, pg8::Unit& u) const {
        if (i >= cnt) return false; const int L = base + i * step; if (L >= nwg) return false;
        int wgid = L; { const int q = nwg / 8, r = nwg % 8, xcd = wgid % 8, off = wgid / 8; wgid = (xcd < r ? xcd * (q + 1) : r * (q + 1) + (xcd - r) * q) + off; }
        const int nig = 8 * nN, gid = wgid / nig, fm = gid * 8, gsz = (nM - fm) < 8 ? (nM - fm) : 8;
        u.pm = fm + ((wgid % nig) % gsz); u.pn = (wgid % nig) / gsz; return true;
    }
    __device__ __forceinline__ void a_ready(const pg8::Unit&) const {}
    __device__ __forceinline__ void done(const pg8::Unit&) const {}
};
template <class Epi>
__device__ __forceinline__ void run_gemm_list(unsigned char* lds, const bf16_t* A, int lda, const bf16_t* Bt, int M, int N, int K, int base, int step, int cnt, const Epi& ep) {
    pg8::Gemm g{A, Bt, M, N, K, lda}; ListOrder S; S.init(M, N, base, step, cnt);
    pg8::gemm_phase<Epi, ListOrder, true, true>((PG8_LAS unsigned char*)lds, g, S, ep);
}
template <class Epi>
__device__ __forceinline__ void run_gemm(unsigned char* lds, const bf16_t* A, int lda, const bf16_t* Bt, int M, int N, int K, int c, const Epi& ep) {
    pg8::Gemm g{A, Bt, M, N, K, lda}; pg8::StaticOrder S; S.init(M, N, gridDim.x, c);
    pg8::gemm_phase<Epi, pg8::StaticOrder, true, true>((PG8_LAS unsigned char*)lds, g, S, ep);
}

__global__ void __launch_bounds__(NTHR) fwd_megakernel(P p) {
    extern __shared__ __attribute__((aligned(16))) unsigned char lds[];
    cg::grid_group grid = cg::this_grid();
    unsigned char* ws = p.ws;
    const int bid = blockIdx.x, nb = gridDim.x;
#define half (tid_l() >> 8)
#define hl (lds + (tid_l() >> 8) * HALF_LDS)

    volatile LAS unsigned* xst = (volatile LAS unsigned*)((LAS unsigned char*)lds + 2 * HALF_LDS);
    if (threadIdx.x == 0) { xst[0] = 0u; xst[1] = 0u; }
    __syncthreads();
    XcdBarrier xb = xcd_barrier_post((unsigned*)(ws + WS_BAR), xst);
    prep_phase(p, lds);
    grid.sync();
    normmod_phase(p, 0, 0, NTOK, 0, nb);
    xcd_barrier(xb);
    const bf16_t* H0 = (const bf16_t*)(ws + WS_H); const bf16_t* W0 = (const bf16_t*)(ws + WS_WIN0);
    PgA epa{ws, p.gk_b, 0};
    run_gemm(lds, H0, 1024, W0, GROWS, 9216, 1024, bid, epa);
    xcd_barrier(xb);
    pre_phase(p, 0, half, hl);
    xcd_barrier(xb);
    for (int grp = 0; grp < 8; ++grp) {
        const int par = grp & 1;
        if (bid < 64) seq_block(p, par, bid, lds);
        if (grp >= 1) {
            PgC epc{p.x, p.ctx, p.out, (float*)(ws + WS_XC), (const float*)(ws + WS_MOD), grp - 1};
            run_gemm_list(lds, (const bf16_t*)(ws + WS_OF + (size_t)(par ^ 1) * OBUF), 2048, (const bf16_t*)(ws + WS_WOUT0), GROWS, 1024, 2048, bid - 64, 72, (bid >= 64 && bid < 136) ? 1 : 0, epc);
        }
        if (grp < 7) {
            int base, step, cnt;
            if (bid >= 136) { base = bid - 136; step = 120; cnt = 4; } else if (bid >= 64) { base = 480 + bid - 64; step = 72; cnt = 2; } else { base = 624 + bid; step = 64; cnt = bid < 24 ? 1 : 0; }
            epa.par = par ^ 1;
            run_gemm_list(lds, H0 + (size_t)(grp + 1) * GROWS * 1024, 1024, W0, GROWS, 9216, 1024, base, step, cnt, epa);
        }
        xcd_barrier(xb);
        if (grp < 7) pre_phase(p, par ^ 1, half, hl);
        gatenorm_phase(p, par);
        xcd_barrier(xb);
    }
    {
        PgC epc{p.x, p.ctx, p.out, (float*)(ws + WS_XC), (const float*)(ws + WS_MOD), 7};
        run_gemm(lds, (const bf16_t*)(ws + WS_OF + OBUF), 2048, (const bf16_t*)(ws + WS_WOUT0), GROWS, 1024, 2048, bid, epc);
        if (bid >= 72) normmod_phase(p, 1, 0, 7 * GROWS, 72, nb - 72);
    }
    xcd_barrier(xb);
    normmod_phase(p, 1, 7 * GROWS, NTOK, 0, nb);
    s5tab_phase(p);
    xcd_barrier(xb);
    {
        PgB epl{(bf16_t*)(ws + WS_F2L), F2LD, (const float2*)(ws + WS_ROPE), 1}; PgB epc{(bf16_t*)(ws + WS_F2C), F2CLD, (const float2*)(ws + WS_ROPE), 0};
        run_gemm(lds, (const bf16_t*)(ws + WS_H), 1024, (const bf16_t*)(ws + WS_WIN1), 32768, 4608, 1024, bid, epl);
        run_gemm(lds, (const bf16_t*)(ws + WS_H) + (size_t)32768 * 1024, 1024, (const bf16_t*)(ws + WS_WIN1), 4096, 1536, 1024, bid, epc);
    }
    xcd_barrier(xb);
    {
        constexpr int NX = 128 * 9;
        for (int it = bid * 2 + half; it < NX + 4096; it += nb * 2) {
            if (it < NX) { const int gd = it / 9, tm = it % 9; LdS5X al{(const bf16_t*)(ws + WS_F2L), gd >> 1}; LdPlain bl{(const bf16_t*)(ws + WS_WX) + (size_t)gd * 128 * 512, 512};
                EpiS5X ep{(bf16_t*)(ws + WS_S), gd >> 1, gd & 1}; gemm_tile(al, bl, ep, tm * 128, 0, 512, hl); }
            else { int a = it - NX;
                if (nb == 256) {
                    const int t = a + 128, li = (t >> 9) * 64 + (((t >> 1) & 255) >> 3) * 2 + (t & 1) - 16; a = ((((t >> 1) & 7) * 2 + (li >> 8)) << 8) + (li & 255); }
                attn_item(p, a, hl); }
        }
    }
    xcd_barrier(xb);
    s5scan_phase(p);
    xcd_barrier(xb);
    {
        for (int it = bid * 2 + half; it < 64 * 32; it += nb * 2) {
            const int local = ((it >> 4) & 31) * 2 + (it & 1); const int g = (nb == 256) ? (it >> 9) * 16 + ((it >> 1) & 7) * 2 + (local >> 5) : it >> 5;
            const int tile = (nb == 256) ? (local & 31) : (it & 31); const int tm = tile >> 2, tn = tile & 3;
            LdS5YA al{(const bf16_t*)(ws + WS_F2L), (const bf16_t*)(ws + WS_S), g}; LdS5YB bl{(const bf16_t*)(ws + WS_KT2), (const bf16_t*)(ws + WS_VT), g};
            EpiS5Y ep{(const bf16_t*)(ws + WS_F2L), (bf16_t*)(ws + WS_H), p.s5_d, g}; gemm_tile(al, bl, ep, tm * 128, tn * 128, 768, hl); }
    }
    xcd_barrier(xb);
    {
        PgGLU ep{(bf16_t*)(ws + WS_F2L)};
        run_gemm(lds, (const bf16_t*)(ws + WS_H), 1024, (const bf16_t*)(ws + WS_WGLU), 32768, 2048, 1024, bid, ep);
    }
    xcd_barrier(xb);
    {
        PgD ep{p.out, (const float*)(ws + WS_MOD) + 17 * 3072};
        run_gemm(lds, (const bf16_t*)(ws + WS_F2L) + QOFF, F2LD, (const bf16_t*)(ws + WS_WOUT1), 32768, 1024, 2048, bid, ep);
    }
    xcd_barrier(xb);
    final_phase(p);
#undef half
#undef hl
}

extern "C" void kernel_launch(void* const* d_in, const int* in_sizes, int n_in, void* d_out, int out_size, void* d_ws, size_t ws_size, hipStream_t stream) {
    static int grid_blocks = 0;
    if (grid_blocks == 0) {
        if (ws_size < WS_TOTAL) { fprintf(stderr, "kernel_launch: workspace too small: %zu < %zu\n", ws_size, (size_t)WS_TOTAL); grid_blocks = -1; return; }
        int dev = 0, cus = 0, per_cu = 0;
        (void)hipGetDevice(&dev);
        (void)hipDeviceGetAttribute(&cus, hipDeviceAttributeMultiprocessorCount, dev);
        (void)hipFuncSetAttribute((const void*)fwd_megakernel, hipFuncAttributeMaxDynamicSharedMemorySize, LDS_BYTES);
        (void)hipOccupancyMaxActiveBlocksPerMultiprocessor(&per_cu, (const void*)fwd_megakernel, NTHR, LDS_BYTES);
        if (per_cu < 1) { fprintf(stderr, "kernel_launch: occupancy query reports %d blocks/CU\n", per_cu); per_cu = 1; }
        grid_blocks = cus;
    }
    if (grid_blocks < 0) return;
    P p{};
    const float** pp = (const float**)&p;
    for (int i = 0; i < 27; ++i) pp[i] = (const float*)d_in[i];
    p.out = (float*)d_out; p.ws = (unsigned char*)d_ws;
    (void)hipMemsetAsync((unsigned char*)d_ws + WS_BAR, 0, 16384, stream);
    void* args[] = {&p};
    hipError_t e = hipLaunchCooperativeKernel((void*)fwd_megakernel, dim3(grid_blocks), dim3(NTHR), args, LDS_BYTES, stream);
    if (e != hipSuccess) fprintf(stderr, "cooperative launch failed: %s (grid %d)\n", hipGetErrorString(e), grid_blocks);
}
```

```cpp
#include <hip/hip_runtime.h>
#include <hip/hip_cooperative_groups.h>
#include <cstdio>
#include <cstdint>
namespace cg = cooperative_groups;

typedef unsigned short bf16_t;
typedef short bf16x8 __attribute__((ext_vector_type(8)));
typedef float f32x4 __attribute__((ext_vector_type(4)));

#define MFMA(a, b, c) __builtin_amdgcn_mfma_f32_16x16x32_bf16(a, b, c, 0, 0, 0)
#define DEV __device__ __forceinline__

constexpr int NTOK = 36864;
constexpr int GROWS = 4608;
constexpr int HALF_LDS = 73728;
constexpr int LDS_BYTES = 2 * HALF_LDS + 64;
constexpr int NTHR = 512;
constexpr float EPSN = 1e-6f;
constexpr int KOFF = 0, VOFF = 256, UOFF = 512, GATT = 1536, QOFF = 2560, GS5 = 3584, F2LD = 4608, F2CLD = 1536;

constexpr size_t WS_WIN1 = 0;
constexpr size_t WS_WGLU = WS_WIN1 + 9437184;
constexpr size_t WS_WOUT1 = WS_WGLU + 4194304;
constexpr size_t WS_XC = WS_WOUT1 + 4194304;
constexpr size_t WS_MOD = WS_XC + 16777216;
constexpr size_t WS_LB = WS_MOD + 417792;
constexpr size_t WS_ROPE = WS_LB + 8192;
constexpr size_t WS_A32 = WS_ROPE + 8192;
constexpr size_t WS_PW = WS_A32 + 65536;
constexpr size_t WS_BB = WS_PW + 2162688;
constexpr size_t WS_R1 = WS_BB + 1048576;
constexpr size_t WS_WIN0 = WS_R1;
constexpr size_t WS_WOUT0 = WS_WIN0 + 18874368;
constexpr size_t WS_WX = WS_R1;
constexpr size_t WS_KT2 = WS_WX + 16777216;
constexpr size_t WS_VT = WS_KT2 + 2064384;
constexpr size_t WS_H = WS_R1 + 35618816;
constexpr size_t WS_S = WS_H + 75497472;
constexpr size_t WS_R3 = WS_S + 37748736;
constexpr size_t WS_FEATB = WS_R3;
constexpr size_t WS_FEATF = WS_FEATB + 56623104;
constexpr size_t WS_QD = WS_FEATF + 56623104;
constexpr size_t WS_KTT = WS_QD + 28311552;
constexpr size_t WS_ATT = WS_KTT + 28311552;
constexpr size_t WS_DEC = WS_ATT + 7077888;
constexpr size_t WS_VTT = WS_DEC + 1769472;
constexpr size_t WS_GATES = WS_VTT + 18874368;
constexpr size_t WS_OF = WS_GATES + 37748736;
constexpr size_t WS_OB = WS_OF + 37748736;
constexpr size_t WS_VTT1 = WS_FEATF + 28311552;
constexpr size_t OBUF = 18874368;
static_assert(WS_OB + 37748736 <= WS_R3 + 314572800, "layer-0 buffers overflow region 3");
constexpr size_t WS_F2L = WS_R3;
constexpr size_t WS_F2C = WS_F2L + 301989888;
constexpr size_t WS_END = WS_F2C + 12582912;
constexpr size_t WS_BAR = WS_END;
constexpr size_t WS_TOTAL = WS_BAR + 16384;
constexpr size_t F2C_DELTA = (WS_F2C - WS_F2L) / 2;

struct P {
    const float *x, *c, *ctx, *c_ctx, *ada_w, *ada_b, *norm_g, *final_g, *ev_w_in, *ev_w_out, *gk_w, *gk_b, *gla_g, *lb_raw, *hg_g,
        *od_w_in, *od_w_out, *sink, *lam_re, *lam_im, *log_dt, *b_re, *b_im, *c_re, *c_im, *s5_d, *glu_w;
    float* out;
    unsigned char* ws;
};

DEV int tid_l() { int t = threadIdx.x; asm volatile("" : "+v"(t)); return t; }
typedef __bf16 bf16v2_t __attribute__((ext_vector_type(2)));
typedef float f32v2_t __attribute__((ext_vector_type(2)));
DEV unsigned pk(float a, float b) { const f32v2_t v = {a, b}; return __builtin_bit_cast(unsigned, __builtin_convertvector(v, bf16v2_t)); }
DEV bf16_t f2bf(float f) { return __builtin_bit_cast(bf16_t, (__bf16)f); }
typedef _Float16 h16v2_t __attribute__((ext_vector_type(2)));
typedef _Float16 h16v8_t __attribute__((ext_vector_type(8)));
DEV unsigned pkh(float a, float b) { const h16v2_t v = {(_Float16)a, (_Float16)b}; return __builtin_bit_cast(unsigned, v); }
DEV void unpackh8(uint4 v, float* f) { const h16v8_t h = __builtin_bit_cast(h16v8_t, v); _Pragma("unroll") for (int e = 0; e < 8; ++e) f[e] = (float)h[e]; }
DEV float bflo(unsigned w) { return __uint_as_float(w << 16); }
DEV float bfhi(unsigned w) { return __uint_as_float(w & 0xffff0000u); }
DEV float bf2f(bf16_t b) { return __uint_as_float((unsigned)b << 16); }
DEV bf16x8 as8(uint4 v) { return __builtin_bit_cast(bf16x8, v); }
DEV float rcpf_(float x) { return __builtin_amdgcn_rcpf(x); }
DEV float sigmoidf_(float x) { return rcpf_(1.f + __expf(-x)); }
DEV float siluf_(float x) { return x * rcpf_(1.f + __expf(-x)); }
DEV float geluf_(float x) { float u = 0.7978845608028654f * (x + 0.044715f * x * x * x); float t = 1.f - 2.f * rcpf_(1.f + __expf(2.f * u)); return 0.5f * x * (1.f + t); }
DEV void unpack8(uint4 v, float* f) { f[0] = bflo(v.x); f[1] = bfhi(v.x); f[2] = bflo(v.y); f[3] = bfhi(v.y); f[4] = bflo(v.z); f[5] = bfhi(v.z); f[6] = bflo(v.w); f[7] = bfhi(v.w); }

namespace pg8 {
#define PG8_LAS __attribute__((address_space(3)))
typedef unsigned short bf16_t;
typedef short bf16x8 __attribute__((ext_vector_type(8)));
typedef float f32x4 __attribute__((ext_vector_type(4)));
typedef unsigned u32x4 __attribute__((ext_vector_type(4)));
constexpr int BM = 256, BK = 64, HALF = 128, HTB = HALF * BK * 2  , STAGE_BYTES = 8 * HTB, NXCD = 8, WGM = 8;

__host__ __device__ __forceinline__ int lds_byte(int r, int c) { const int st = (r >> 4) * 2 + (c >> 5), rr = r & 15, cc = c & 31, ob = rr * 64 + cc * 2; return st * 1024 + (ob ^ (((ob >> 9) & 1) << 5)); }
__host__ __device__ __forceinline__ void stage_rc(int b, int& R, int& C) { const int st = b / 1024, sb = b % 1024, swz = sb ^ (((sb >> 9) & 1) << 5); R = (st >> 1) * 16 + swz / 64; C = (st & 1) * 32 + (swz % 64) / 2; }
__host__ __device__ __forceinline__ int perm32(int rho) { const int n = rho >> 4, i = rho & 15; return 8 * (i >> 2) + 4 * n + (i & 3); }

struct Unit { int pm, pn; };
struct Gemm { const bf16_t* A; const bf16_t* Bt; int M, N, K, lda; };

struct StaticOrder {
    int nM, nN, nwg, G, c;
    __host__ __device__ void init(int M, int N, int G_, int c_) { nM = M / BM; nN = N / BM; nwg = nM * nN; G = G_; c = c_; }
    __host__ __device__ bool next(int i, Unit& u) const {
        const long L = (long)i * G + c; if (L >= nwg) return false;
        int wgid = (int)L; { const int q = nwg / NXCD, r = nwg % NXCD, xcd = wgid % NXCD, off = wgid / NXCD; wgid = (xcd < r ? xcd * (q + 1) : r * (q + 1) + (xcd - r) * q) + off; }
        const int nig = WGM * nN, gid = wgid / nig, fm = gid * WGM, gsz = (nM - fm) < WGM ? (nM - fm) : WGM;
        u.pm = fm + ((wgid % nig) % gsz); u.pn = (wgid % nig) / gsz; return true;
    }
    __device__ __forceinline__ void a_ready(const Unit&) const {}
    __device__ __forceinline__ void done(const Unit&) const {}
};
template <class Epi, class Sched, bool ALIGN_EPI = false, bool SP2 = false>
__device__ __forceinline__ void gemm_phase(PG8_LAS unsigned char* lds, const Gemm g, const Sched& S, const Epi& E) {
    const int tid = tid_l(), wid = __builtin_amdgcn_readfirstlane(tid >> 6), lane = tid & 63, wr = wid >> 2, wc = wid & 3, fr = lane & 15, fq = lane >> 4;
    const int K = g.K, nt = K / BK;
    unsigned voffA[2], voffB[2];
#pragma unroll
    for (int i = 0; i < 2; ++i) { int R, C; stage_rc(tid * 16 + i * 8192, R, C); const int Rb = Epi::PERM ? ((R & ~31) + perm32(R & 31)) : R;
        voffA[i] = (unsigned)(R * g.lda + C) * 2u; voffB[i] = (unsigned)(Rb * K + C) * 2u; }
    const size_t kstep = (size_t)(BK * 2);
    const size_t hstep = (size_t)HALF * K * 2, hstepA = (size_t)HALF * g.lda * 2, tstepA = 2 * hstepA;
    const size_t tstep = 2 * hstep;
    const unsigned ldsw = (unsigned)wid * 1024u;
    const int aoff = lds_byte(wr * 64 + fr, fq * 8), boff = lds_byte(wc * 32 + fr, fq * 8);
#define PG8_SA(b, h) (((b) * 2 + (h)) * HTB)
#define PG8_SB(b, h) ((4 + (b) * 2 + (h)) * HTB)
#define PG8_STAGE(bufoff, gbase, voff) do { _Pragma("unroll") for (int _i = 0; _i < 2; ++_i) \
        __builtin_amdgcn_global_load_lds((const unsigned*)((const char*)(gbase) + (voff)[_i]), (PG8_LAS unsigned*)(lds + (bufoff) + ldsw + _i * 8192), 16, 0, 0); } while (0)
#define PG8_LDA(dst, b, h) do { _Pragma("unroll") for (int m = 0; m < 4; ++m) _Pragma("unroll") for (int k = 0; k < 2; ++k) dst[m][k] = *(const PG8_LAS bf16x8*)(lds + PG8_SA(b, h) + aoff + m * 2048 + k * 1024); } while (0)
#define PG8_LDB(dst, b, h) do { _Pragma("unroll") for (int n = 0; n < 2; ++n) _Pragma("unroll") for (int k = 0; k < 2; ++k) dst[n][k] = *(const PG8_LAS bf16x8*)(lds + PG8_SB(b, h) + boff + n * 2048 + k * 1024); } while (0)
#define PG8_MMA(ai, bj, At, Bt) do { __builtin_amdgcn_s_setprio(1); _Pragma("unroll") for (int m = 0; m < 4; ++m) _Pragma("unroll") for (int n = 0; n < 2; ++n) _Pragma("unroll") for (int k = 0; k < 2; ++k) \
        acc[ai][bj][m][n] = __builtin_amdgcn_mfma_f32_16x16x32_bf16(Bt[n][k], At[m][k], acc[ai][bj][m][n], 0, 0, 0); __builtin_amdgcn_s_setprio(0); } while (0)
#define PG8_WAIT_V(n) asm volatile("s_waitcnt vmcnt(" #n ")" ::: "memory")
#define PG8_WAIT_L(n) asm volatile("s_waitcnt lgkmcnt(" #n ")" ::: "memory")
#define PG8_BAR __builtin_amdgcn_s_barrier()
#define PG8_SCHED __builtin_amdgcn_sched_barrier(0)
    Unit cur, nxt; int ui = 0;
    if (!S.next(0, cur)) return;
    f32x4 acc[2][2][4][2];
#pragma unroll
    for (int a = 0; a < 2; ++a)
#pragma unroll
        for (int b = 0; b < 2; ++b)
#pragma unroll
            for (int m = 0; m < 4; ++m)
#pragma unroll
                for (int n = 0; n < 2; ++n) acc[a][b][m][n] = (f32x4){0.f, 0.f, 0.f, 0.f};
    bf16x8 At[4][2], B0[2][2], B1[2][2];
    const char* cA = (const char*)g.A + (size_t)cur.pm * tstepA; const char* cB = (const char*)g.Bt + (size_t)cur.pn * tstep;
    S.a_ready(cur);
    if constexpr (SP2) {
        PG8_STAGE(PG8_SB(0, 0), cB, voffB); PG8_STAGE(PG8_SB(0, 1), cB + hstep, voffB); PG8_STAGE(PG8_SA(0, 0), cA, voffA); PG8_STAGE(PG8_SA(0, 1), cA + hstepA, voffA);
        if (wr == 1) PG8_BAR;
        PG8_WAIT_V(2); PG8_BAR;
        PG8_STAGE(PG8_SB(1, 0), cB + kstep, voffB); PG8_STAGE(PG8_SA(1, 0), cA + kstep, voffA); PG8_STAGE(PG8_SB(1, 1), cB + hstep + kstep, voffB);
        PG8_WAIT_V(6); PG8_BAR;
    } else {
        PG8_STAGE(PG8_SB(0, 0), cB, voffB); PG8_STAGE(PG8_SA(0, 0), cA, voffA); PG8_STAGE(PG8_SB(0, 1), cB + hstep, voffB); PG8_STAGE(PG8_SA(0, 1), cA + hstepA, voffA);
        if (wr == 1) PG8_BAR;
        PG8_WAIT_V(4); PG8_BAR;
        PG8_STAGE(PG8_SB(1, 0), cB + kstep, voffB); PG8_STAGE(PG8_SA(1, 0), cA + kstep, voffA); PG8_STAGE(PG8_SB(1, 1), cB + hstep + kstep, voffB);
        PG8_WAIT_V(6); PG8_BAR;
    }
    for (;;) {
        const bool has_next = S.next(ui + 1, nxt);
        const char* nA = has_next ? (const char*)g.A + (size_t)nxt.pm * tstepA : cA; const char* nB = has_next ? (const char*)g.Bt + (size_t)nxt.pn * tstep : cB;
        for (int t = 0; t < nt; t += 2) {
            const bool last = (t == nt - 2);
            const char* a1 = cA + (size_t)(t + 1) * kstep;
            const char* a2 = last ? nA : cA + (size_t)(t + 2) * kstep; const char* b2 = last ? nB : cB + (size_t)(t + 2) * kstep;
            const char* a3 = a2 + kstep; const char* b3 = b2 + kstep;
            if (last && has_next) S.a_ready(nxt);
            if constexpr (SP2) {
            PG8_LDB(B0, 0, 0); PG8_LDB(B1, 0, 1); PG8_SCHED; PG8_LDA(At, 0, 0); PG8_STAGE(PG8_SA(1, 1), a1 + hstepA, voffA);
            PG8_WAIT_V(8); PG8_WAIT_L(0); PG8_BAR; PG8_MMA(0, 0, At, B0); PG8_MMA(0, 1, At, B1); PG8_BAR; PG8_SCHED;
            PG8_LDA(At, 0, 1); PG8_STAGE(PG8_SB(0, 0), b2, voffB); PG8_STAGE(PG8_SB(0, 1), b2 + hstep, voffB); PG8_STAGE(PG8_SA(0, 0), a2, voffA);
            PG8_WAIT_V(8); PG8_WAIT_L(0); PG8_BAR; PG8_MMA(1, 0, At, B0); PG8_MMA(1, 1, At, B1); PG8_BAR; PG8_SCHED;
            PG8_LDB(B0, 1, 0); PG8_LDB(B1, 1, 1); PG8_SCHED; PG8_LDA(At, 1, 0); PG8_STAGE(PG8_SA(0, 1), a2 + hstepA, voffA);
            PG8_WAIT_V(8); PG8_WAIT_L(0); PG8_BAR; PG8_MMA(0, 0, At, B0); PG8_MMA(0, 1, At, B1); PG8_BAR; PG8_SCHED;
            PG8_LDA(At, 1, 1); PG8_STAGE(PG8_SB(1, 0), b3, voffB); PG8_STAGE(PG8_SB(1, 1), b3 + hstep, voffB); PG8_STAGE(PG8_SA(1, 0), a3, voffA);
            PG8_WAIT_V(8); PG8_WAIT_L(0); PG8_BAR; PG8_MMA(1, 0, At, B0); PG8_MMA(1, 1, At, B1); PG8_BAR; PG8_SCHED;
            } else {
            PG8_LDB(B0, 0, 0); PG8_SCHED; PG8_LDA(At, 0, 0); PG8_STAGE(PG8_SA(1, 1), a1 + hstepA, voffA);
            PG8_WAIT_L(8); PG8_BAR; PG8_WAIT_L(0); PG8_MMA(0, 0, At, B0); PG8_BAR; PG8_SCHED;
            PG8_LDB(B1, 0, 1); PG8_STAGE(PG8_SB(0, 0), b2, voffB);
            PG8_BAR; PG8_WAIT_L(0); PG8_MMA(0, 1, At, B1); PG8_BAR;
            PG8_LDA(At, 0, 1); PG8_STAGE(PG8_SA(0, 0), a2, voffA);
            PG8_BAR; PG8_WAIT_L(0); PG8_MMA(1, 0, At, B0); PG8_BAR; PG8_SCHED;
            PG8_STAGE(PG8_SB(0, 1), b2 + hstep, voffB);
            PG8_WAIT_V(6); PG8_BAR; PG8_MMA(1, 1, At, B1); PG8_BAR;
            PG8_LDB(B0, 1, 0); PG8_SCHED; PG8_LDA(At, 1, 0); PG8_STAGE(PG8_SA(0, 1), a2 + hstepA, voffA);
            PG8_WAIT_L(8); PG8_BAR; PG8_WAIT_L(0); PG8_MMA(0, 0, At, B0); PG8_BAR; PG8_SCHED;
            PG8_LDB(B1, 1, 1); PG8_STAGE(PG8_SB(1, 0), b3, voffB);
            PG8_BAR; PG8_WAIT_L(0); PG8_MMA(0, 1, At, B1); PG8_BAR;
            PG8_LDA(At, 1, 1); PG8_STAGE(PG8_SA(1, 0), a3, voffA);
            PG8_BAR; PG8_WAIT_L(0); PG8_MMA(1, 0, At, B0); PG8_BAR; PG8_SCHED;
            PG8_STAGE(PG8_SB(1, 1), b3 + hstep, voffB);
            PG8_WAIT_V(6); PG8_BAR; PG8_MMA(1, 1, At, B1); PG8_BAR;
            }
        }
        if constexpr (ALIGN_EPI) { if (wr == 0) PG8_BAR; }
        if constexpr (!Epi::AFTER_DRAIN) { E(acc, cur, wr, wc, fr, fq); S.done(cur); }
        if (!has_next) break;
#pragma unroll
        for (int a = 0; a < 2; ++a)
#pragma unroll
            for (int b = 0; b < 2; ++b)
#pragma unroll
                for (int m = 0; m < 4; ++m)
#pragma unroll
                    for (int n = 0; n < 2; ++n) acc[a][b][m][n] = (f32x4){0.f, 0.f, 0.f, 0.f};
        cur = nxt; cA = nA; cB = nB; ++ui;
        if constexpr (ALIGN_EPI) { if (wr == 1) PG8_BAR; }
    }
    PG8_WAIT_V(0);
    if constexpr (!ALIGN_EPI) { if (wr == 0) PG8_BAR; }
    PG8_BAR;
    if constexpr (Epi::AFTER_DRAIN) { E.fused(acc, cur, wr, wc, fr, fq, lds, wid, lane); S.done(cur); }
#undef PG8_SA
#undef PG8_SB
#undef PG8_STAGE
#undef PG8_LDA
#undef PG8_LDB
#undef PG8_MMA
#undef PG8_WAIT_V
#undef PG8_WAIT_L
#undef PG8_BAR
#undef PG8_SCHED
}
}

template <class AL, class BL, class EP>
__device__ __forceinline__ void gemm_tile(const AL& al, const BL& bl, const EP& ep, int m0, int n0, int K, unsigned char* lds) {
    const int tid = tid_l() & 255, lane = tid & 63, w = tid >> 6, wm = w >> 1, wn = w & 1;
    bf16_t* sA = (bf16_t*)lds;
    bf16_t* sB = sA + 2 * 128 * 72;
    const int lr = tid >> 3, lk = (tid & 7) * 8;
    f32x4 acc[4][4];
#pragma unroll
    for (int i = 0; i < 4; ++i)
#pragma unroll
        for (int j = 0; j < 4; ++j) acc[i][j] = (f32x4){0.f, 0.f, 0.f, 0.f};
    uint4 ra0[4], rb0[4], ra1[4], rb1[4];
#define GLOAD(RA, RB, KT) { const int k_ = (KT) * 64 + lk; _Pragma("unroll") for (int x = 0; x < 4; ++x) { RA[x] = al.load(m0 + lr + 32 * x, k_); RB[x] = bl.load(n0 + lr + 32 * x, k_); } }
#define LSTORE(RA, RB, BUF) { bf16_t* a_ = sA + (BUF) * 128 * 72; bf16_t* b_ = sB + (BUF) * 128 * 72; _Pragma("unroll") for (int x = 0; x < 4; ++x) { *(uint4*)(a_ + (lr + 32 * x) * 72 + lk) = RA[x]; *(uint4*)(b_ + (lr + 32 * x) * 72 + lk) = RB[x]; } }
#define COMPUTE(BUF) { const bf16_t* a_ = sA + (BUF) * 128 * 72; const bf16_t* b_ = sB + (BUF) * 128 * 72; \
        _Pragma("unroll") for (int kh = 0; kh < 2; ++kh) { bf16x8 fw[4], ft[4]; \
            _Pragma("unroll") for (int i = 0; i < 4; ++i) fw[i] = as8(*(const uint4*)(b_ + (wn * 64 + i * 16 + (lane & 15)) * 72 + kh * 32 + (lane >> 4) * 8)); \
            _Pragma("unroll") for (int j = 0; j < 4; ++j) ft[j] = as8(*(const uint4*)(a_ + (wm * 64 + j * 16 + (lane & 15)) * 72 + kh * 32 + (lane >> 4) * 8)); \
            _Pragma("unroll") for (int i = 0; i < 4; ++i) _Pragma("unroll") for (int j = 0; j < 4; ++j) acc[i][j] = MFMA(fw[i], ft[j], acc[i][j]); } }
    const int nk = K >> 6;
    __syncthreads();
    GLOAD(ra0, rb0, 0); GLOAD(ra1, rb1, 1);
    LSTORE(ra0, rb0, 0);
    __syncthreads();
    for (int kt = 0; kt < nk; kt += 2) {
        GLOAD(ra0, rb0, (kt + 2 < nk ? kt + 2 : nk - 1));
        COMPUTE(0);
        LSTORE(ra1, rb1, 1);
        __syncthreads();
        GLOAD(ra1, rb1, (kt + 3 < nk ? kt + 3 : nk - 1));
        COMPUTE(1);
        if (kt + 2 < nk) LSTORE(ra0, rb0, 0);
        __syncthreads();
    }
#undef GLOAD
#undef LSTORE
#undef COMPUTE
    ep(acc, m0 + wm * 64, n0 + wn * 64, lane);
}
DEV void tile_map8(int it, int NT, int& tm, int& tn) { const int x = it & 7, q = it >> 3, c = NT >> 3; tn = x + 8 * (q % c); tm = q / c; }

struct LdPlain { const bf16_t* base; int ld; DEV uint4 load(int row, int k) const { return *(const uint4*)(base + (size_t)row * ld + k); } };
struct LdH1L { const bf16_t* H; DEV uint4 load(int m, int k) const { const int b = m >> 11, t = m & 2047; return *(const uint4*)(H + (size_t)(b * 2304 + 256 + t) * 1024 + k); } };
struct LdH1C { const bf16_t* H; DEV uint4 load(int m, int k) const { const int b = m >> 8, j = m & 255; return *(const uint4*)(H + (size_t)(b * 2304 + j) * 1024 + k); } };
struct LdD { const bf16_t* F; DEV uint4 load(int m, int k) const { const int kk = k < 1024 ? QOFF + k : GS5 + k - 1024; return *(const uint4*)(F + (size_t)m * F2LD + kk); } };
struct LdS5X { const bf16_t* FL; int g;
    DEV uint4 load(int n, int k) const { const int b = n / 72, c = n - b * 72, i = k >> 4, h = k & 15;
        const size_t off = c < 8 ? F2C_DELTA + (size_t)(b * 256 + c * 32 + i) * F2CLD : (size_t)(b * 2048 + (c - 8) * 32 + i) * F2LD;
        return *(const uint4*)(FL + off + UOFF + g * 16 + h); } };
struct LdS5YA { const bf16_t* FL; const bf16_t* S; int g;
    DEV uint4 load(int n, int k) const { const int b = n >> 6, cl = n & 63;
        const bf16_t* p = k < 512 ? FL + (size_t)(b * 2048 + cl * 32 + (k >> 4)) * F2LD + UOFF + g * 16 + (k & 15) : S + ((size_t)(b * 72 + cl + 8) * 64 + g) * 256 + (k - 512);
        return *(const uint4*)p; } };
struct LdS5YB { const bf16_t* KT2; const bf16_t* VT; int g;
    DEV uint4 load(int col, int k) const { const int t = col >> 4, h = col & 15;
        const bf16_t* p = k < 512 ? KT2 + ((size_t)(g * 63 + (t - (k >> 4) + 31)) * 16 + h) * 16 + (k & 15) : VT + ((size_t)g * 512 + col) * 256 + (k - 512);
        return *(const uint4*)p; } };

#define PG_ROWS_COLS(...) \
    _Pragma("unroll") for (int ai = 0; ai < 2; ++ai) _Pragma("unroll") for (int m = 0; m < 4; ++m) { const int row = u.pm * 256 + ai * 128 + wr * 64 + m * 16 + fr; \
        _Pragma("unroll") for (int bj = 0; bj < 2; ++bj) _Pragma("unroll") for (int n = 0; n < 2; ++n) { const int col = u.pn * 256 + bj * 128 + wc * 32 + n * 16 + fq * 4; const f32x4 v = acc[ai][bj][m][n]; __VA_ARGS__ } }
struct PgA {
    static constexpr bool PERM = false, AFTER_DRAIN = false;
    unsigned char* ws; const float* gkb; int par;
    DEV void operator()(const f32x4 (&acc)[2][2][4][2], const pg8::Unit& u, int wr, int wc, int fr, int fq) const {
        bf16_t* featb = (bf16_t*)(ws + WS_FEATB); unsigned short* featf = (unsigned short*)(ws + WS_FEATF);   bf16_t* gates = (bf16_t*)(ws + WS_GATES + (size_t)par * OBUF);
        PG_ROWS_COLS(
            if ((col >= 2048 && col < 3072) || (col >= 7168 && col < 8192)) {
                const int oc = col < 3072 ? col - 2048 : col - 6144;
                uint2 o; o.x = pk(v[0], v[1]); o.y = pk(v[2], v[3]); *(uint2*)(gates + (size_t)row * 2048 + oc) = o;
            } else if ((col >= 1024 && col < 2048) || (col >= 6144 && col < 7168)) {
                const int vc = col < 2048 ? col - 1024 : col - 5120; const int bl_ = row / 2304, j_ = row - bl_ * 2304;
                bf16_t* vt = (bf16_t*)(ws + (par ? WS_VTT1 : WS_VTT)) + (((size_t)(bl_ * 72 + (j_ >> 5)) * 2048 + vc) * 32 + (j_ & 31));
                const unsigned p01 = pk(v[0], v[1]), p23 = pk(v[2], v[3]);
                vt[0] = (bf16_t)(p01 & 0xffffu); vt[32] = (bf16_t)(p01 >> 16); vt[64] = (bf16_t)(p23 & 0xffffu); vt[96] = (bf16_t)(p23 >> 16);
            } else if (col < 4096 || (col >= 6144 && col < 8192)) {
                const float s = col < 512 ? 0.08838834764831845f : 1.f; const int oc = col < 4096 ? col : col - 2048;
                uint2 o; o.x = pk(v[0] * s, v[1] * s); o.y = pk(v[2] * s, v[3] * s); *(uint2*)(featb + (size_t)row * 6144 + oc) = o;
            } else if (col < 6144) {
                const int cc = col - 4096;
                *(uint2*)(featf + (size_t)row * 3072 + cc) = make_uint2(pkh(v[0], v[1]), pkh(v[2], v[3]));
            } else {
                const int cc = col - 8192; const f32x4 bb = *(const f32x4*)(gkb + cc);
                *(uint2*)(featf + (size_t)row * 3072 + 2048 + cc) = make_uint2(pkh(v[0] + bb[0], v[1] + bb[1]), pkh(v[2] + bb[2], v[3] + bb[3]));
            })
    }
};
struct PgC {
    static constexpr bool PERM = false, AFTER_DRAIN = false;
    const float* x; const float* ctx; float* out; float* xc; const float* mod; int grp;
    DEV void operator()(const f32x4 (&acc)[2][2][4][2], const pg8::Unit& u, int wr, int wc, int fr, int fq) const {
        PG_ROWS_COLS(
            const int R = grp * GROWS + row; const int b = R / 2304, jj = R - b * 2304; const bool isc = jj < 256;
            const size_t ro = isc ? (size_t)(b * 256 + jj) * 1024 : (size_t)(b * 2048 + jj - 256) * 1024;
            const f32x4 s = *(const f32x4*)((isc ? ctx : x) + ro + col); const f32x4 gt = *(const f32x4*)(mod + (size_t)(isc ? 16 : b) * 3072 + 2048 + col);
            *(f32x4*)((isc ? xc : out) + ro + col) = s + gt * v; )
    }
};
struct PgB {
    static constexpr bool PERM = false, AFTER_DRAIN = false;
    bf16_t* F; int ld; const float2* rope; int latent;
    DEV void operator()(const f32x4 (&acc)[2][2][4][2], const pg8::Unit& u, int wr, int wc, int fr, int fq) const {
#pragma unroll
        for (int ai = 0; ai < 2; ++ai)
#pragma unroll
            for (int m = 0; m < 4; ++m) { const int row = u.pm * 256 + ai * 128 + wr * 64 + m * 16 + fr; const int t = row & 2047;
#pragma unroll
                for (int bj = 0; bj < 2; ++bj) { const int cb = u.pn * 256 + bj * 128 + wc * 32; f32x4 v0 = acc[ai][bj][m][0], v1 = acc[ai][bj][m][1];
                    const bool isq = cb >= QOFF && cb < QOFF + 1024;
                    if (latent && (cb < VOFF || isq)) { const float sc = isq ? 0.18033688011112042f : 1.f; const int pos = (cb & 32) ? (t & 63) : (t >> 6); f32x4 o0, o1;
#pragma unroll
                        for (int r = 0; r < 4; ++r) { const float2 cs = rope[pos * 16 + fq * 4 + r]; o0[r] = (v0[r] * cs.x - v1[r] * cs.y) * sc; o1[r] = (v1[r] * cs.x + v0[r] * cs.y) * sc; }
                        v0 = o0; v1 = o1; }
                    uint2 o; o.x = pk(v0[0], v0[1]); o.y = pk(v0[2], v0[3]); *(uint2*)(F + (size_t)row * ld + cb + fq * 4) = o;
                    o.x = pk(v1[0], v1[1]); o.y = pk(v1[2], v1[3]); *(uint2*)(F + (size_t)row * ld + cb + 16 + fq * 4) = o; } }
    }
};
struct PgGLU {
    static constexpr bool PERM = false, AFTER_DRAIN = false;
    bf16_t* F;
    DEV void operator()(const f32x4 (&acc)[2][2][4][2], const pg8::Unit& u, int wr, int wc, int fr, int fq) const {
#pragma unroll
        for (int ai = 0; ai < 2; ++ai)
#pragma unroll
            for (int m = 0; m < 4; ++m) { const int row = u.pm * 256 + ai * 128 + wr * 64 + m * 16 + fr;
#pragma unroll
                for (int n = 0; n < 2; ++n) { const int oc = u.pn * 128 + wc * 32 + n * 16 + fq * 4; const f32x4 a = acc[ai][0][m][n], b = acc[ai][1][m][n];
                    bf16_t* pp = F + (size_t)row * F2LD + GS5 + oc; const uint2 gg = *(const uint2*)pp;
                    const float g0 = bflo(gg.x), g1 = bfhi(gg.x), g2 = bflo(gg.y), g3 = bfhi(gg.y);
                    uint2 o; o.x = pk(a[0] * sigmoidf_(b[0]) * siluf_(g0), a[1] * sigmoidf_(b[1]) * siluf_(g1)); o.y = pk(a[2] * sigmoidf_(b[2]) * siluf_(g2), a[3] * sigmoidf_(b[3]) * siluf_(g3));
                    *(uint2*)pp = o; } }
    }
};
struct PgD {
    static constexpr bool PERM = false, AFTER_DRAIN = false;
    float* out; const float* mod;
    DEV void operator()(const f32x4 (&acc)[2][2][4][2], const pg8::Unit& u, int wr, int wc, int fr, int fq) const {
        PG_ROWS_COLS(
            float* dst = out + (size_t)row * 1024 + col; const f32x4 gt = *(const f32x4*)(mod + (size_t)(row >> 11) * 3072 + 2048 + col);
            *(f32x4*)dst = *(const f32x4*)dst + gt * v; )
    }
};
struct EpiS5X { bf16_t* S; int g, dir;
    DEV void operator()(f32x4 (&acc)[4][4], int mrow0, int ncol0, int lane) const {
#pragma unroll
        for (int j = 0; j < 4; ++j) { const int n = mrow0 + j * 16 + (lane & 15);
#pragma unroll
            for (int i = 0; i < 4; ++i) { const int col = ncol0 + i * 16 + (lane >> 4) * 4; const f32x4 v = acc[i][j];
                uint2 o; o.x = pk(v[0], v[1]); o.y = pk(v[2], v[3]); *(uint2*)(S + (((size_t)n * 64 + g) * 2 + dir) * 128 + col) = o; } }
    }
};
struct EpiS5Y { const bf16_t* FL; bf16_t* Z; const float* dsk; int g;
    DEV void operator()(f32x4 (&acc)[4][4], int mrow0, int ncol0, int lane) const {
#pragma unroll
        for (int j = 0; j < 4; ++j) { const int n = mrow0 + j * 16 + (lane & 15); const int b = n >> 6, cl = n & 63;
#pragma unroll
            for (int i = 0; i < 4; ++i) { const int t = (ncol0 >> 4) + i, h = (lane >> 4) * 4; const f32x4 v = acc[i][j];
                const size_t m = (size_t)b * 2048 + cl * 32 + t; const uint2 uu = *(const uint2*)(FL + m * F2LD + UOFF + g * 16 + h);
                const float4 dd = *(const float4*)(dsk + g * 16 + h);
                uint2 o; o.x = pk(geluf_(v[0] + dd.x * bflo(uu.x)), geluf_(v[1] + dd.y * bfhi(uu.x))); o.y = pk(geluf_(v[2] + dd.z * bflo(uu.y)), geluf_(v[3] + dd.w * bfhi(uu.y)));
                *(uint2*)(Z + m * 1024 + g * 16 + h) = o; } }
    }
};

template <class MAP>
__device__ __forceinline__ void transpose_tile(const float* src, int ldsrc, bf16_t* dst, int K, int n0, int k0, const MAP& map, unsigned char* lds) {
    float* tile = (float*)lds;
    const int tid = tid_l() & 255;
    __syncthreads();
#pragma unroll
    for (int e = 0; e < 16; ++e) { const int idx = tid + e * 256; const int kk = idx >> 6, nn = idx & 63; tile[kk * 65 + nn] = src[(size_t)(k0 + kk) * ldsrc + map(n0 + nn)]; }
    __syncthreads();
    const int nn = tid >> 2, kq = (tid & 3) * 16;
    unsigned o[8];
#pragma unroll
    for (int e = 0; e < 8; ++e) o[e] = pk(tile[(kq + 2 * e) * 65 + nn], tile[(kq + 2 * e + 1) * 65 + nn]);
    uint4* d = (uint4*)(dst + (size_t)(n0 + nn) * K + k0 + kq);
    d[0] = make_uint4(o[0], o[1], o[2], o[3]); d[1] = make_uint4(o[4], o[5], o[6], o[7]);
}
struct MapIn0 { DEV int operator()(int n) const { return n < 2048 ? n : n + 32; } };
struct MapId { DEV int operator()(int n) const { return n; } };
struct MapIn1 { DEV int operator()(int n) const { return n < 512 ? n + 1024 : n < 1536 ? n + 2048 : n < 2560 ? n : n < 3584 ? n - 2560 : n; } };
struct MapGlu { DEV int operator()(int n) const { return ((n >> 7) & 1) * 1024 + (n >> 8) * 128 + (n & 127); } };

__device__ __forceinline__ void prep_phase(const P& p, unsigned char* lds) {
    unsigned char* ws = p.ws;
    const int tid5 = tid_l(), half = tid5 >> 8, tid = tid5 & 255, nb = gridDim.x, bid = blockIdx.x;
    lds += half * HALF_LDS;
    constexpr int N_IN0 = 128 * 16, N_G = 16 * 16, N_OUT0 = 16 * 32, N_IN1 = 72 * 16, N_GLU = 32 * 16, N_OUT1 = 16 * 32, N_ADA = 96;
    constexpr int E0 = N_IN0, E1 = E0 + N_G, E2 = E1 + N_OUT0, E3 = E2 + N_IN1, E4 = E3 + N_GLU, E5 = E4 + N_OUT1, E6 = E5 + N_ADA;
    for (int it = bid * 2 + half; it < E6; it += nb * 2) {
        if (it < E0) { transpose_tile(p.ev_w_in, 8224, (bf16_t*)(ws + WS_WIN0), 1024, (it >> 4) * 64, (it & 15) * 64, MapIn0(), lds); }
        else if (it < E1) {
            const int i2 = it - E0; const int n0 = (i2 >> 4) * 64, k0 = (i2 & 15) * 64; const int nn = tid >> 2, kq = (tid & 3) * 16;
            const int n = n0 + nn, dd = n >> 9, cc = n & 511; float gw[16];
#pragma unroll
            for (int r = 0; r < 16; ++r) gw[r] = p.gk_w[(size_t)(dd * 16 + r) * 512 + cc];
            unsigned o[8];
#pragma unroll
            for (int e = 0; e < 8; ++e) { float v2[2];
#pragma unroll
                for (int q = 0; q < 2; ++q) { const float* wr = p.ev_w_in + (size_t)(k0 + kq + 2 * e + q) * 8224 + 2048 + dd * 16; float a = 0.f;
#pragma unroll
                    for (int r = 0; r < 16; ++r) a += wr[r] * gw[r];
                    v2[q] = a; }
                o[e] = pk(v2[0], v2[1]); }
            uint4* d = (uint4*)((bf16_t*)(ws + WS_WIN0) + (size_t)(8192 + n) * 1024 + k0 + kq);
            d[0] = make_uint4(o[0], o[1], o[2], o[3]); d[1] = make_uint4(o[4], o[5], o[6], o[7]);
        }
        else if (it < E2) { const int i2 = it - E1; transpose_tile(p.ev_w_out, 1024, (bf16_t*)(ws + WS_WOUT0), 2048, (i2 >> 5) * 64, (i2 & 31) * 64, MapId(), lds); }
        else if (it < E3) { const int i2 = it - E2; transpose_tile(p.od_w_in, 4608, (bf16_t*)(ws + WS_WIN1), 1024, (i2 >> 4) * 64, (i2 & 15) * 64, MapIn1(), lds); }
        else if (it < E4) { const int i2 = it - E3; transpose_tile(p.glu_w, 2048, (bf16_t*)(ws + WS_WGLU), 1024, (i2 >> 4) * 64, (i2 & 15) * 64, MapGlu(), lds); }
        else if (it < E5) { const int i2 = it - E4; transpose_tile(p.od_w_out, 1024, (bf16_t*)(ws + WS_WOUT1), 2048, (i2 >> 5) * 64, (i2 & 31) * 64, MapId(), lds); }
        else {
            const int i2 = it - E5; const int layer = i2 / 48, col0 = (i2 % 48) * 64;
            float* sc = (float*)lds;
            __syncthreads();
            for (int idx = tid; idx < 17 * 1024; idx += 256) { const int r = idx >> 10, k = idx & 1023; const float v = r < 16 ? p.c[r * 1024 + k] : p.c_ctx[k]; sc[idx] = v / (1.f + expf(-v)); }
            __syncthreads();
            const int cl = tid & 63, kq = tid >> 6; float a[17];
#pragma unroll
            for (int r = 0; r < 17; ++r) a[r] = 0.f;
            const float* wp = p.ada_w + (size_t)layer * 1024 * 3072 + col0 + cl;
            for (int k = kq * 256; k < kq * 256 + 256; k += 8) { float wv[8];
#pragma unroll
                for (int j = 0; j < 8; ++j) wv[j] = wp[(size_t)(k + j) * 3072];
#pragma unroll
                for (int j = 0; j < 8; ++j)
#pragma unroll
                    for (int r = 0; r < 17; ++r) a[r] += sc[r * 1024 + k + j] * wv[j]; }
            __syncthreads();
#pragma unroll
            for (int r = 0; r < 17; ++r) sc[(kq * 17 + r) * 64 + cl] = a[r];
            __syncthreads();
            for (int idx = tid; idx < 17 * 64; idx += 256) { const int r = idx >> 6, c2 = idx & 63;
                const float v = sc[(0 * 17 + r) * 64 + c2] + sc[(1 * 17 + r) * 64 + c2] + sc[(2 * 17 + r) * 64 + c2] + sc[(3 * 17 + r) * 64 + c2];
                ((float*)(ws + WS_MOD))[((size_t)layer * 17 + r) * 3072 + col0 + c2] = v + p.ada_b[layer * 3072 + col0 + c2]; }
        }
    }
    const int gt = bid * NTHR + tid5, gs = nb * NTHR;
    for (int idx = gt; idx < 2048; idx += gs) { const int d = idx >> 10, col = idx & 1023; const float r0 = p.lb_raw[d * 2048 + col], r1 = p.lb_raw[d * 2048 + 1024 + col]; ((float*)(ws + WS_LB))[idx] = 1.f / (1.f + expf(r1 - r0)); }
    for (int idx = gt; idx < 1024; idx += gs) { const int pos = idx >> 4, i = idx & 15; const float fr = powf(10000.f, -(float)i / 16.f); float s, c; sincosf((float)pos * fr, &s, &c); ((float2*)(ws + WS_ROPE))[idx] = make_float2(c, s); }
    for (int idx = gt; idx < 128 * 33 * 64; idx += gs) { const int pp = idx & 63, m = (idx >> 6) % 33, gd = idx / (64 * 33), g = gd >> 1, dir = gd & 1;
        const float lre = p.lam_re[dir * 4096 + g * 64 + pp], lim = p.lam_im[dir * 4096 + g * 64 + pp], dt = expf(p.log_dt[dir * 64 + g]);
        const float mag = expf(lre * dt * (float)m); float s, c; sincosf(lim * dt * (float)m, &s, &c); ((float2*)(ws + WS_PW))[idx] = make_float2(mag * c, mag * s); }
    for (int idx = gt; idx < 128 * 64 * 16; idx += gs) { const int h = idx & 15, pp = (idx >> 4) & 63, gd = idx >> 10, g = gd >> 1, dir = gd & 1;
        const float lre = p.lam_re[dir * 4096 + g * 64 + pp], lim = p.lam_im[dir * 4096 + g * 64 + pp], dt = expf(p.log_dt[dir * 64 + g]);
        const float mag = expf(lre * dt); float s, c; sincosf(lim * dt, &s, &c); const float xr = mag * c - 1.f, xi = mag * s, den = lre * lre + lim * lim;
        const float qr = (xr * lre + xi * lim) / den, qi = (xi * lre - xr * lim) / den; const float br = p.b_re[(g * 64 + pp) * 16 + h], bi = p.b_im[(g * 64 + pp) * 16 + h];
        ((float2*)(ws + WS_BB))[idx] = make_float2(qr * br - qi * bi, qr * bi + qi * br); }
}

__device__ __forceinline__ void normmod_phase(const P& p, int layer, int tok_lo, int tok_hi, int blk0, int nblk) {
    const int tid = tid_l(); const int lane = tid & 63, w = tid >> 6;
    const float* xc = (const float*)(p.ws + WS_XC); const float* mod = (const float*)(p.ws + WS_MOD) + (size_t)layer * 17 * 3072;
    bf16_t* H = (bf16_t*)(p.ws + WS_H); const float* ng = p.norm_g + layer * 1024;
    for (int tok = tok_lo + (blockIdx.x - blk0) * 8 + w; tok < tok_hi; tok += nblk * 8) {
        const int b = tok / 2304, j = tok - b * 2304; const bool isc = j < 256;
        const float* src = isc ? (layer == 0 ? p.ctx : xc) + (size_t)(b * 256 + j) * 1024 : (layer == 0 ? p.x : p.out) + (size_t)(b * 2048 + j - 256) * 1024;
        const float* md = mod + (size_t)(isc ? 16 : b) * 3072;
        const int hrow = layer == 0 ? tok : (isc ? 32768 + b * 256 + j : b * 2048 + j - 256);
        float4 v[4]; float ss = 0.f;
#pragma unroll
        for (int m = 0; m < 4; ++m) { v[m] = *(const float4*)(src + m * 256 + lane * 4); ss += v[m].x * v[m].x + v[m].y * v[m].y + v[m].z * v[m].z + v[m].w * v[m].w; }
#pragma unroll
        for (int o = 32; o >= 1; o >>= 1) ss += __shfl_xor(ss, o);
        const float rs = rsqrtf(ss * (1.f / 1024.f) + EPSN);
#pragma unroll
        for (int m = 0; m < 4; ++m) { const int col = m * 256 + lane * 4; const float4 g = *(const float4*)(ng + col), sh = *(const float4*)(md + col), sc = *(const float4*)(md + 1024 + col);
            uint2 o; o.x = pk(v[m].x * rs * g.x * (1.f + sc.x) + sh.x, v[m].y * rs * g.y * (1.f + sc.y) + sh.y); o.y = pk(v[m].z * rs * g.z * (1.f + sc.z) + sh.z, v[m].w * rs * g.w * (1.f + sc.w) + sh.w);
            *(uint2*)(H + (size_t)hrow * 1024 + col) = o; }
    }
}

__device__ __forceinline__ void pre_phase(const P& p, int par, int half, unsigned char* lds) {
    const int tid = tid_l() & 255, lane = tid & 63, w = tid >> 6;
    float* sG = (float*)lds;
    bf16_t* sQ = (bf16_t*)(lds + 33792);
    bf16_t* sK = sQ + 32 * 136;
    bf16_t* sT = sK + 32 * 136;
    bf16_t* sAtt = sT + 128 * 40;
    const bf16_t* FB = (const bf16_t*)(p.ws + WS_FEATB); const unsigned short* FF = (const unsigned short*)(p.ws + WS_FEATF);
    const int li = tid >> 3, seg = tid & 7, stride = gridDim.x * 2;
    uint4 nq0, nq1, nk0, nk1, ng00, ng01, ng10, ng11;
#define PRE_DEC(IT) const int chunk = (IT) % 72, t2 = (IT) / 72, head12 = t2 % 12, bl = t2 / 12; const int hgrn = head12 >= 4, head = hgrn ? head12 - 4 : head12; \
        const size_t row = (size_t)bl * 2304 + chunk * 32 + li;
#define PRE_LOAD(IT) { PRE_DEC(IT) const bf16_t* fb_ = FB + row * 6144; const int qo_ = hgrn ? 3072 + head * 128 : head * 128, ko_ = hgrn ? qo_ : 512 + head * 128; \
        nq0 = *(const uint4*)(fb_ + qo_ + seg * 16); nq1 = *(const uint4*)(fb_ + qo_ + seg * 16 + 8); nk0 = *(const uint4*)(fb_ + ko_ + seg * 16); nk1 = *(const uint4*)(fb_ + ko_ + seg * 16 + 8); \
        const unsigned short* f0_ = FF + row * 3072 + (hgrn ? head * 128 : 2048 + head * 128) + seg * 16; const unsigned short* f1_ = f0_ + (hgrn ? 1024 : 512); \
        ng00 = *(const uint4*)(f0_); ng01 = *(const uint4*)(f0_ + 8); ng10 = *(const uint4*)(f1_); ng11 = *(const uint4*)(f1_ + 8); }
    int it = blockIdx.x * 2 + half;
    if (it < 1728) PRE_LOAD(it)
    for (; it < 1728; it += stride) {
        PRE_DEC(it)
        const bf16_t* fb = FB + row * 6144;
        float q[16], kk_[16], g0[16], g1[16];
        unpack8(nq0, q); unpack8(nq1, q + 8); unpack8(nk0, kk_); unpack8(nk1, kk_ + 8);
        unpackh8(ng00, g0); unpackh8(ng01, g0 + 8); unpackh8(ng10, g1); unpackh8(ng11, g1 + 8);
        float kh0[16], kh1[16];
#pragma unroll
        for (int e = 0; e < 16; ++e) { kh0[e] = 0.f; kh1[e] = 0.f; }
        if (hgrn) {
            const float* lbp = (const float*)(p.ws + WS_LB) + head * 128 + seg * 16;
#pragma unroll
            for (int e4 = 0; e4 < 4; ++e4) { const float4 l0 = *(const float4*)(lbp + e4 * 4), l1 = *(const float4*)(lbp + 1024 + e4 * 4); const float la[4] = {l0.x, l0.y, l0.z, l0.w}, lc[4] = {l1.x, l1.y, l1.z, l1.w};
#pragma unroll
                for (int r = 0; r < 4; ++r) { const int e = e4 * 4 + r; const float f0 = la[r] + (1.f - la[r]) * rcpf_(1.f + __expf(-g0[e])), f1 = lc[r] + (1.f - lc[r]) * rcpf_(1.f + __expf(-g1[e]));
                    kh0[e] = 1.f - f0; kh1[e] = 1.f - f1; g0[e] = __logf(f0); g1[e] = __logf(f1); } }
        } else {
#pragma unroll
            for (int e = 0; e < 16; ++e) { g0[e] = (fminf(g0[e], 0.f) - __logf(1.f + __expf(-fabsf(g0[e])))) * 0.0625f; g1[e] = (fminf(g1[e], 0.f) - __logf(1.f + __expf(-fabsf(g1[e])))) * 0.0625f; }
        }
        { const int nx = it + stride < 1728 ? it + stride : it; PRE_LOAD(nx) }
#pragma unroll
        for (int e = 0; e < 4; ++e) { *(float4*)(sG + li * 132 + seg * 16 + e * 4) = make_float4(g0[4 * e], g0[4 * e + 1], g0[4 * e + 2], g0[4 * e + 3]);
            *(float4*)(sG + 32 * 132 + li * 132 + seg * 16 + e * 4) = make_float4(g1[4 * e], g1[4 * e + 1], g1[4 * e + 2], g1[4 * e + 3]); }
        __syncthreads();
        { float* pl = sG + (tid >> 7) * 32 * 132 + (tid & 127); float a = 0.f;
#pragma unroll
            for (int i = 0; i < 32; ++i) { a += pl[i * 132]; pl[i * 132] = a; } }
        __syncthreads();
#pragma unroll
        for (int dir = 0; dir < 2; ++dir) {
            const int hd = hgrn ? 8 + head * 2 + dir : head * 2 + dir;
            const size_t hb = ((size_t)(bl * 24 + hd) * 72 + chunk);
            float g[16];
#pragma unroll
            for (int e = 0; e < 16; ++e) g[e] = dir ? g1[e] : g0[e];
            {
                unsigned oq[8], ok[8];
                float Pv[16], PLv[16];
                const float* sGd = sG + dir * 32 * 132;
#pragma unroll
                for (int e4 = 0; e4 < 4; ++e4) { const float4 a4 = *(const float4*)(sGd + li * 132 + seg * 16 + e4 * 4), b4 = *(const float4*)(sGd + 31 * 132 + seg * 16 + e4 * 4);
                    Pv[4 * e4] = a4.x; Pv[4 * e4 + 1] = a4.y; Pv[4 * e4 + 2] = a4.z; Pv[4 * e4 + 3] = a4.w; PLv[4 * e4] = b4.x; PLv[4 * e4 + 1] = b4.y; PLv[4 * e4 + 2] = b4.z; PLv[4 * e4 + 3] = b4.w; }
                bf16_t* qd_g = (bf16_t*)(p.ws + WS_QD) + hb * 4096 + li * 128 + (seg >> 1) * 32 + (seg & 1) * 4;
#pragma unroll
                for (int e = 0; e < 16; e += 2) {
                    float qd[2], ki[2];
#pragma unroll
                    for (int u = 0; u < 2; ++u) { const float Pi = Pv[e + u], PL = PLv[e + u];
                        const float bc = dir ? PL - Pi + g[e + u] : Pi; const float kv = hgrn ? (dir ? kh1[e + u] : kh0[e + u]) : kk_[e + u];
                        qd[u] = q[e + u] * __expf(bc); ki[u] = kv * __expf(fminf(-bc, 87.f)); const float ktl = kv * __expf(PL - bc);
                        sT[((e + u) * 8 + seg) * 40 + li] = f2bf(ktl);
                        if (li == 31) ((float*)(p.ws + WS_DEC))[hb * 128 + seg * 16 + e + u] = __expf(PL); }
                    oq[e >> 1] = pk(qd[0], qd[1]); ok[e >> 1] = pk(ki[0], ki[1]);
                }
                *(uint4*)(sQ + li * 136 + seg * 16) = make_uint4(oq[0], oq[1], oq[2], oq[3]); *(uint4*)(sQ + li * 136 + seg * 16 + 8) = make_uint4(oq[4], oq[5], oq[6], oq[7]);
                *(uint4*)(sK + li * 136 + seg * 16) = make_uint4(ok[0], ok[1], ok[2], ok[3]); *(uint4*)(sK + li * 136 + seg * 16 + 8) = make_uint4(ok[4], ok[5], ok[6], ok[7]);
#pragma unroll
                for (int qg = 0; qg < 4; ++qg) *(uint2*)(qd_g + qg * 8) = make_uint2(oq[qg * 2], oq[qg * 2 + 1]);
            }
            __syncthreads();
            {
                const int ti = w >> 1, tj = w & 1; f32x4 a = (f32x4){0.f, 0.f, 0.f, 0.f};
                if (dir ? !(ti == 1 && tj == 0) : !(ti == 0 && tj == 1)) {
#pragma unroll
                    for (int kk = 0; kk < 4; ++kk) { const bf16x8 A = as8(*(const uint4*)(sQ + (ti * 16 + (lane & 15)) * 136 + kk * 32 + (lane >> 4) * 8)); const bf16x8 B = as8(*(const uint4*)(sK + (tj * 16 + (lane & 15)) * 136 + kk * 32 + (lane >> 4) * 8)); a = MFMA(A, B, a); }
                }
#pragma unroll
                for (int r = 0; r < 4; ++r) { const int c = ti * 16 + (lane >> 4) * 4 + r, s2 = tj * 16 + (lane & 15); const bool keep = dir ? (s2 >= c) : (s2 <= c); sAtt[c * 40 + s2] = f2bf(keep ? a[r] : 0.f); }
            }
            __syncthreads();
            {
                const int d = tid >> 1, part = tid & 1; bf16_t* kt_g = (bf16_t*)(p.ws + WS_KTT) + hb * 4096 + d * 32 + part * 16;
                const int dr = (d & 15) * 8 + (d >> 4);
                *(uint4*)kt_g = *(const uint4*)(sT + dr * 40 + part * 16); *(uint4*)(kt_g + 8) = *(const uint4*)(sT + dr * 40 + part * 16 + 8);
                if (tid < 128) { const int r = tid >> 2, pt = tid & 3; *(uint4*)((bf16_t*)(p.ws + WS_ATT) + hb * 1024 + r * 32 + pt * 8) = *(const uint4*)(sAtt + r * 40 + pt * 8); }
            }
            if (dir == 0) __syncthreads();
        }
    }
#undef PRE_DEC
#undef PRE_LOAD
}

__device__ __forceinline__ void seq_block(const P& p, int par, int blk, unsigned char* lds) {
    const int tid = tid_l(), lane = tid & 63, w = tid >> 6, fr = lane & 15, fq = lane >> 4;
    int bl, hd, vcol0;
    if (blk < 32) { bl = blk >> 4; hd = (blk >> 1) & 7; vcol0 = (hd >> 1) * 256 + (blk & 1) * 128; } else { const int b2 = blk - 32; bl = b2 >> 4; hd = 8 + (b2 & 15); vcol0 = 1024 + ((hd - 8) >> 1) * 128; }
    const int dir = hd & 1, vcol = vcol0 + w * 16;
    bf16_t* O = (bf16_t*)(p.ws + (dir ? WS_OB : WS_OF) + (size_t)par * OBUF);
    const size_t hb = (size_t)(bl * 24 + hd) * 72;
    const size_t QDo = WS_QD + hb * 8192, KTo = WS_KTT + hb * 8192, ATo = WS_ATT + hb * 2048, DCo = WS_DEC + hb * 512, VTo = (par ? WS_VTT1 : WS_VTT) + (size_t)bl * 72 * 131072;
    const char* wsb = (const char*)p.ws;
    const size_t o0 = QDo + ((((w >> 2) * 16 + fr) * 128 + (w & 3) * 32 + fq * 8) * 2);
    const size_t o1 = w < 2 ? ATo + (((w * 16 + fr) * 32 + fq * 8) * 2) : KTo + ((((w - 2) * 16 + fr) * 32 + fq * 8) * 2);
    const size_t o2 = w < 2 ? KTo + ((((w + 6) * 16 + fr) * 32 + fq * 8) * 2) : DCo + (lane & 31) * 16;
    const size_t o3 = VTo + (((vcol + fr) * 32 + fq * 8) * 2);
    const char* b0 = wsb + o0; const char* b1 = wsb + o1; const char* b2 = wsb + o2; const char* b3 = wsb + o3;
    const unsigned s0 = 8192, s1 = w < 2 ? 2048u : 8192u, s2 = w < 2 ? 8192u : 512u, s3 = 131072;
    const int id0 = w, id1 = w + 8, id2 = w < 3 ? w + 16 : 18, id3 = 19 + w;
    f32x4 S[8];
#pragma unroll
    for (int d = 0; d < 8; ++d) S[d] = (f32x4){0.f, 0.f, 0.f, 0.f};
    uint4 stA0, stA1, stA2, stA3, stB0, stB1, stB2, stB3, stC0, stC1, stC2, stC3, stD0, stD1, stD2, stD3;
#define SQ_CH(CC) (dir ? ((CC) < 8 ? 7 - (CC) : 79 - (CC)) : (CC))
#define SQ_LOAD(ST, CC) { const size_t c_ = (size_t)SQ_CH((CC) < 72 ? (CC) : 71); ST##0 = *(const uint4*)(b0 + c_ * s0); ST##1 = *(const uint4*)(b1 + c_ * s1); ST##2 = *(const uint4*)(b2 + c_ * s2); ST##3 = *(const uint4*)(b3 + c_ * s3); }
#define SQ_STEP(ST, CC) { unsigned char* sl = lds + ((CC) & 1) * 27648; \
        *(uint4*)(sl + id0 * 1024 + lane * 16) = ST##0; *(uint4*)(sl + id1 * 1024 + lane * 16) = ST##1; if (w < 3) *(uint4*)(sl + id2 * 1024 + lane * 16) = ST##2; *(uint4*)(sl + id3 * 1024 + lane * 16) = ST##3; \
        SQ_LOAD(ST, (CC) + 4); \
        __syncthreads(); \
        const int c = SQ_CH(CC); \
        const bf16x8 Bv = as8(*(const uint4*)(sl + id3 * 1024 + lane * 16)); \
        bf16x8 SB[4]; \
        _Pragma("unroll") for (int kk = 0; kk < 4; ++kk) SB[kk] = as8(make_uint4(pk(S[2 * kk][0], S[2 * kk][1]), pk(S[2 * kk][2], S[2 * kk][3]), pk(S[2 * kk + 1][0], S[2 * kk + 1][1]), pk(S[2 * kk + 1][2], S[2 * kk + 1][3]))); \
        _Pragma("unroll") for (int ci = 0; ci < 2; ++ci) { f32x4 o = (f32x4){0.f, 0.f, 0.f, 0.f}; \
            o = MFMA(Bv, as8(*(const uint4*)(sl + (8 + ci) * 1024 + lane * 16)), o); \
            _Pragma("unroll") for (int kk = 0; kk < 4; ++kk) o = MFMA(SB[kk], as8(*(const uint4*)(sl + (ci * 4 + kk) * 1024 + lane * 16)), o); \
            uint2 ov; ov.x = pk(o[0], o[1]); ov.y = pk(o[2], o[3]); \
            *(uint2*)(O + ((size_t)bl * 2304 + c * 32 + ci * 16 + fr) * 2048 + vcol + fq * 4) = ov; } \
        _Pragma("unroll") for (int dt = 0; dt < 8; ++dt) { const f32x4 dcv = *(const f32x4*)(sl + 18 * 1024 + (dt * 4 + fq) * 16); \
            S[dt] = S[dt] * dcv; S[dt] = MFMA(as8(*(const uint4*)(sl + (10 + dt) * 1024 + lane * 16)), Bv, S[dt]); } }
    SQ_LOAD(stA, 0); SQ_LOAD(stB, 1); SQ_LOAD(stC, 2); SQ_LOAD(stD, 3);
    __syncthreads();
    for (int cc = 0; cc < 72; cc += 4) { SQ_STEP(stA, cc); SQ_STEP(stB, cc + 1); SQ_STEP(stC, cc + 2); SQ_STEP(stD, cc + 3); }
    __syncthreads();
#undef SQ_CH
#undef SQ_LOAD
#undef SQ_STEP
}

__device__ __forceinline__ void gatenorm_phase(const P& p, int par) {
    const int tid = tid_l(); const int lane = tid & 63, w = tid >> 6;
    bf16_t* OF = (bf16_t*)(p.ws + WS_OF + (size_t)par * OBUF); const bf16_t* OB = (const bf16_t*)(p.ws + WS_OB + (size_t)par * OBUF); const bf16_t* GT = (const bf16_t*)(p.ws + WS_GATES + (size_t)par * OBUF);
    for (int r = blockIdx.x * 8 + w; r < GROWS; r += gridDim.x * 8) {
#pragma unroll
        for (int m = 0; m < 4; ++m) { const int col = m * 512 + lane * 8;
            float a[8], b[8], gt[8]; unpack8(*(const uint4*)(OF + (size_t)r * 2048 + col), a); unpack8(*(const uint4*)(OB + (size_t)r * 2048 + col), b);
            unpack8(*(const uint4*)(GT + (size_t)r * 2048 + col), gt);
            float ss = 0.f;
#pragma unroll
            for (int e = 0; e < 8; ++e) { a[e] += b[e]; ss += a[e] * a[e]; }
            ss += __shfl_xor(ss, 1); ss += __shfl_xor(ss, 2); ss += __shfl_xor(ss, 4); ss += __shfl_xor(ss, 8);
            float rs; const float* gw;
            if (m < 2) { ss += __shfl_xor(ss, 16); rs = rsqrtf(ss * (1.f / 256.f) + EPSN); gw = p.gla_g + (col & 255); } else { rs = rsqrtf(ss * (1.f / 128.f) + EPSN); gw = p.hg_g + (col & 127); }
            unsigned o[4];
#pragma unroll
            for (int e = 0; e < 8; e += 2) o[e >> 1] = pk(a[e] * rs * gw[e] * siluf_(gt[e]), a[e + 1] * rs * gw[e + 1] * siluf_(gt[e + 1]));
            *(uint4*)(OF + (size_t)r * 2048 + col) = make_uint4(o[0], o[1], o[2], o[3]); }
    }
}

#define DPPF(V, CTRL) __builtin_bit_cast(float, __builtin_amdgcn_update_dpp(0, __builtin_bit_cast(int, (V)), (CTRL), 0xF, 0xF, false))
DEV float rowmax16(float v) { v = fmaxf(v, DPPF(v, 0xB1)); v = fmaxf(v, DPPF(v, 0x4E)); v = fmaxf(v, DPPF(v, 0x124)); v = fmaxf(v, DPPF(v, 0x128)); return v; }
DEV float rowsum16(float v) { v += DPPF(v, 0xB1); v += DPPF(v, 0x4E); v += DPPF(v, 0x124); v += DPPF(v, 0x128); return v; }
__device__ __forceinline__ void attn_item(const P& p, int item, unsigned char* lds) {
    const int tid = tid_l() & 255, lane = tid & 63, w = tid >> 6, fr = lane & 15, fq = lane >> 4;
    bf16_t* sKb = (bf16_t*)lds;
    bf16_t* sVb = sKb + 2 * 64 * 72;
    bf16_t* FL = (bf16_t*)(p.ws + WS_F2L);
    const int nb = (item >> 1) & 15, hq = ((item >> 5) & 7) * 2 + (item & 1), b = item >> 8, kv = hq >> 2;
    const float sinkv = p.sink[hq] * 1.4426950408889634f;
    const size_t qrow0 = (size_t)b * 2048 + nb * 128 + w * 32;
    bf16x8 qf[2][2];
#pragma unroll
    for (int rt = 0; rt < 2; ++rt)
#pragma unroll
        for (int kk = 0; kk < 2; ++kk) qf[rt][kk] = as8(*(const uint4*)(FL + (qrow0 + rt * 16 + fr) * F2LD + QOFF + hq * 64 + kk * 32 + fq * 8));
    float mrow[2], lrow[2]; f32x4 o[2][4];
#pragma unroll
    for (int rt = 0; rt < 2; ++rt) { mrow[rt] = sinkv; lrow[rt] = fq == 0 ? 1.f : 0.f;
#pragma unroll
        for (int dt = 0; dt < 4; ++dt) o[rt][dt] = (f32x4){0.f, 0.f, 0.f, 0.f}; }
    const int bt_lo = nb == 0 ? 2 : 0, ntile = 4 + ((nb == 15 ? 3 : 5) - bt_lo + 1);
    uint4 rk0, rk1, rv0, rv1;
#define AT_LOAD(T) { const int t_ = (T) < ntile ? (T) : ntile - 1; const bool cx_ = t_ < 4; const int kp_ = (nb - 1) * 128 + (bt_lo + t_ - 4) * 64; \
        const size_t ro_ = cx_ ? F2C_DELTA + (size_t)(b * 256 + t_ * 64) * F2CLD : (size_t)(b * 2048 + kp_) * F2LD; const int ld_ = cx_ ? F2CLD : F2LD; \
        const bf16_t* kp0_ = FL + ro_ + kv * 64 + (size_t)(tid >> 3) * ld_ + (tid & 7) * 8; \
        rk0 = *(const uint4*)(kp0_ + KOFF); rk1 = *(const uint4*)(kp0_ + (size_t)32 * ld_ + KOFF); \
        const bf16_t* vp0_ = FL + ro_ + kv * 64 + VOFF + (size_t)(tid & 63) * ld_ + (tid >> 6) * 16;     \
        rv0 = *(const uint4*)vp0_; rv1 = *(const uint4*)(vp0_ + 8); }
#define AT_STAGE(BUF) { bf16_t* sK = sKb + (BUF) * 64 * 72; bf16_t* sVT = sVb + (BUF) * 64 * 72; const int key = tid >> 3, ds = (tid & 7) * 8; \
        *(uint4*)(sK + key * 72 + ds) = rk0; *(uint4*)(sK + (key + 32) * 72 + ds) = rk1; \
        const unsigned vw0[4] = {rv0.x, rv0.y, rv0.z, rv0.w}; const unsigned vw1[4] = {rv1.x, rv1.y, rv1.z, rv1.w}; \
        const int vk = tid & 63, vd = (tid >> 6) * 16; \
        _Pragma("unroll") for (int e2 = 0; e2 < 4; ++e2) { sVT[(vd + 2 * e2) * 72 + vk] = (bf16_t)(vw0[e2] & 0xffffu); sVT[(vd + 2 * e2 + 1) * 72 + vk] = (bf16_t)(vw0[e2] >> 16); \
            sVT[(vd + 8 + 2 * e2) * 72 + vk] = (bf16_t)(vw1[e2] & 0xffffu); sVT[(vd + 8 + 2 * e2 + 1) * 72 + vk] = (bf16_t)(vw1[e2] >> 16); } }
    __syncthreads();
    AT_LOAD(0); AT_STAGE(0); AT_LOAD(1);
    __syncthreads();
    for (int tile = 0; tile < ntile; ++tile) {
        const bool masked = tile >= 4; const int kpos0 = (nb - 1) * 128 + (bt_lo + tile - 4) * 64;
        if (tile + 1 < ntile) AT_STAGE((tile + 1) & 1);
        AT_LOAD(tile + 2);
        const bf16_t* sK = sKb + (tile & 1) * 64 * 72; const bf16_t* sVT = sVb + (tile & 1) * 64 * 72;
        f32x4 s[2][4];
#pragma unroll
        for (int kt = 0; kt < 4; ++kt) { const bf16x8 K0 = as8(*(const uint4*)(sK + (kt * 16 + fr) * 72 + fq * 8)), K1 = as8(*(const uint4*)(sK + (kt * 16 + fr) * 72 + 32 + fq * 8));
#pragma unroll
            for (int rt = 0; rt < 2; ++rt) { f32x4 a = (f32x4){0.f, 0.f, 0.f, 0.f}; a = MFMA(K0, qf[rt][0], a); a = MFMA(K1, qf[rt][1], a); s[rt][kt] = a; } }
        const int q0w = nb * 128 + w * 32;
        if (masked && (kpos0 < q0w + 31 - 128 || kpos0 + 63 > q0w + 128)) {
#pragma unroll
            for (int rt = 0; rt < 2; ++rt)
#pragma unroll
                for (int kt = 0; kt < 4; ++kt)
#pragma unroll
                    for (int r = 0; r < 4; ++r) { const int qpos = nb * 128 + w * 32 + rt * 16 + fr, kpos = kpos0 + kt * 16 + fq * 4 + r; const int d = qpos - kpos; if (d > 128 || d < -128) s[rt][kt][r] = -1e30f; }
        }
        bf16x8 PB[2][2];
#pragma unroll
        for (int rt = 0; rt < 2; ++rt) {
            float mx = -1e30f;
#pragma unroll
            for (int kt = 0; kt < 4; ++kt) mx = fmaxf(mx, fmaxf(fmaxf(s[rt][kt][0], s[rt][kt][1]), fmaxf(s[rt][kt][2], s[rt][kt][3])));
            mx = fmaxf(mx, __shfl_xor(mx, 16)); mx = fmaxf(mx, __shfl_xor(mx, 32));
            const float mn = fmaxf(mrow[rt], mx), alpha = __builtin_amdgcn_exp2f(mrow[rt] - mn); mrow[rt] = mn; float ps = 0.f;
            float pv[4][4];
#pragma unroll
            for (int kt = 0; kt < 4; ++kt)
#pragma unroll
                for (int r = 0; r < 4; ++r) { pv[kt][r] = __builtin_amdgcn_exp2f(s[rt][kt][r] - mn); ps += pv[kt][r]; }
            lrow[rt] = lrow[rt] * alpha + ps;
#pragma unroll
            for (int kp = 0; kp < 2; ++kp) PB[rt][kp] = as8(make_uint4(pk(pv[2 * kp][0], pv[2 * kp][1]), pk(pv[2 * kp][2], pv[2 * kp][3]), pk(pv[2 * kp + 1][0], pv[2 * kp + 1][1]), pk(pv[2 * kp + 1][2], pv[2 * kp + 1][3])));
#pragma unroll
            for (int dt = 0; dt < 4; ++dt) o[rt][dt] = o[rt][dt] * alpha;
        }
#pragma unroll
        for (int dt = 0; dt < 4; ++dt)
#pragma unroll
            for (int kp = 0; kp < 2; ++kp) { const bf16_t* vp = sVT + (dt * 16 + fr) * 72 + kp * 32 + fq * 4; const uint2 v0 = *(const uint2*)vp, v1 = *(const uint2*)(vp + 16);
                const bf16x8 VA = as8(make_uint4(v0.x, v0.y, v1.x, v1.y));
#pragma unroll
                for (int rt = 0; rt < 2; ++rt) o[rt][dt] = MFMA(VA, PB[rt][kp], o[rt][dt]); }
        __syncthreads();
    }
#undef AT_LOAD
#undef AT_STAGE
#pragma unroll
    for (int rt = 0; rt < 2; ++rt) { float l = lrow[rt]; l += __shfl_xor(l, 16); l += __shfl_xor(l, 32); const float inv = 1.f / l;
        bf16_t* rp = FL + (qrow0 + rt * 16 + fr) * F2LD;
#pragma unroll
        for (int dt = 0; dt < 4; ++dt) { const int d = hq * 64 + dt * 16 + fq * 4; const uint2 gg = *(const uint2*)(rp + GATT + d);
            uint2 ov; ov.x = pk(o[rt][dt][0] * inv * siluf_(bflo(gg.x)), o[rt][dt][1] * inv * siluf_(bfhi(gg.x))); ov.y = pk(o[rt][dt][2] * inv * siluf_(bflo(gg.y)), o[rt][dt][3] * inv * siluf_(bfhi(gg.y)));
            *(uint2*)(rp + QOFF + d) = ov; } }
}

__device__ __forceinline__ void s5tab_phase(const P& p) {
    unsigned char* ws = p.ws; const int gt = blockIdx.x * NTHR + tid_l(), gs = gridDim.x * NTHR;
    const float2* PW = (const float2*)(ws + WS_PW); const float2* BB = (const float2*)(ws + WS_BB);
    for (int idx = gt; idx < 128 * 64; idx += gs) ((float2*)(ws + WS_A32))[idx] = PW[((idx >> 6) * 33 + 32) * 64 + (idx & 63)];
    bf16_t* WX = (bf16_t*)(ws + WS_WX);
    for (int i8 = gt; i8 < 128 * 128 * 512 / 8; i8 += gs) { const int idx = i8 * 8;
        const int k = idx & 511, pc = (idx >> 9) & 127, gd = idx >> 16, pp = pc >> 1, ci = pc & 1, i = k >> 4, h0 = k & 15, dir = gd & 1;
        const int m = dir ? i : 31 - i; const float2 a = PW[(gd * 33 + m) * 64 + pp]; const float4* bp = (const float4*)(BB + (gd * 64 + pp) * 16 + h0);
        const float4 b0 = bp[0], b1 = bp[1], b2 = bp[2], b3 = bp[3];
#define WXV(BX, BY) (ci ? a.x * (BY) + a.y * (BX) : a.x * (BX) - a.y * (BY))
        *(uint4*)(WX + idx) = make_uint4(pk(WXV(b0.x, b0.y), WXV(b0.z, b0.w)), pk(WXV(b1.x, b1.y), WXV(b1.z, b1.w)), pk(WXV(b2.x, b2.y), WXV(b2.z, b2.w)), pk(WXV(b3.x, b3.y), WXV(b3.z, b3.w)));
#undef WXV
    }
    bf16_t* VT = (bf16_t*)(ws + WS_VT);
    for (int i8 = gt; i8 < 64 * 512 * 256 / 8; i8 += gs) { const int idx = i8 * 8;
        const int kk = idx & 255, col = (idx >> 8) & 511, g = idx >> 17, dir = kk >> 7, pp = (kk >> 1) & 63, t = col >> 4, h = col & 15;
        const int m = dir ? 32 - t : t + 1; const float4* ap = (const float4*)(PW + ((g * 2 + dir) * 33 + m) * 64 + pp); const float4 a0 = ap[0], a1 = ap[1];
        const float4 cr = *(const float4*)(p.c_re + (g * 16 + h) * 64 + pp), cm = *(const float4*)(p.c_im + (g * 16 + h) * 64 + pp);
        *(uint4*)(VT + idx) = make_uint4(pk(cr.x * a0.x - cm.x * a0.y, -(cr.x * a0.y + cm.x * a0.x)), pk(cr.y * a0.z - cm.y * a0.w, -(cr.y * a0.w + cm.y * a0.z)),
                                         pk(cr.z * a1.x - cm.z * a1.y, -(cr.z * a1.y + cm.z * a1.x)), pk(cr.w * a1.z - cm.w * a1.w, -(cr.w * a1.w + cm.w * a1.z)));
    }
    bf16_t* KT2 = (bf16_t*)(ws + WS_KT2);
    for (int i4 = gt; i4 < 64 * 63 * 256 / 4; i4 += gs) { const int idx = i4 * 4;
        const int hp = idx & 15, h = (idx >> 4) & 15, mm = (idx >> 8) % 63, g = idx / (63 * 256); float acc0 = 0.f, acc1 = 0.f, acc2 = 0.f, acc3 = 0.f;
        for (int dir = 0; dir < 2; ++dir) { const int m = dir ? 31 - mm : mm - 31; if (m < 0) continue; const int gd = g * 2 + dir;
            for (int pp = 0; pp < 64; ++pp) { const float2 a = PW[(gd * 33 + m) * 64 + pp]; const float4* bp = (const float4*)(BB + (gd * 64 + pp) * 16 + hp); const float4 b0 = bp[0], b1 = bp[1];
                const float cr = p.c_re[(g * 16 + h) * 64 + pp], cim = p.c_im[(g * 16 + h) * 64 + pp];
                const float er = cr * a.x - cim * a.y, ei = cr * a.y + cim * a.x;
                acc0 += er * b0.x - ei * b0.y; acc1 += er * b0.z - ei * b0.w; acc2 += er * b1.x - ei * b1.y; acc3 += er * b1.z - ei * b1.w; } }
        *(uint2*)(KT2 + idx) = make_uint2(pk(acc0, acc1), pk(acc2, acc3)); }
}

__device__ __forceinline__ void s5scan_phase(const P& p) {
    unsigned* S32 = (unsigned*)(p.ws + WS_S); const float2* A32 = (const float2*)(p.ws + WS_A32);
    for (int idx = blockIdx.x * NTHR + tid_l(); idx < 16 * 64 * 2 * 64; idx += gridDim.x * NTHR) {
        const int pp = idx & 63, dir = (idx >> 6) & 1, g = (idx >> 7) & 63, b = idx >> 13; const float2 a = A32[(g * 2 + dir) * 64 + pp];
        float sr = 0.f, si = 0.f;
        unsigned* base = S32 + ((size_t)(b * 72) * 64 + g) * 128 + dir * 64 + pp;
        for (int i0 = 0; i0 < 72; i0 += 8) {
            unsigned wv[8];
#pragma unroll
            for (int j = 0; j < 8; ++j) { const int i = i0 + j, c = dir ? (i < 8 ? 7 - i : 79 - i) : i; wv[j] = base[(size_t)c * 8192]; }
#pragma unroll
            for (int j = 0; j < 8; ++j) { const int i = i0 + j, c = dir ? (i < 8 ? 7 - i : 79 - i) : i; base[(size_t)c * 8192] = pk(sr, si);
                const float nr = a.x * sr - a.y * si + bflo(wv[j]), ni = a.x * si + a.y * sr + bfhi(wv[j]); sr = nr; si = ni; }
        }
    }
}

__device__ __forceinline__ void final_phase(const P& p) {
    const int tid = tid_l(); const int lane = tid & 63, w = tid >> 6;
    for (int tok = blockIdx.x * 8 + w; tok < 32768; tok += gridDim.x * 8) {
        float* row = p.out + (size_t)tok * 1024; float4 v[4]; float ss = 0.f;
#pragma unroll
        for (int m = 0; m < 4; ++m) { v[m] = *(const float4*)(row + m * 256 + lane * 4); ss += v[m].x * v[m].x + v[m].y * v[m].y + v[m].z * v[m].z + v[m].w * v[m].w; }
#pragma unroll
        for (int o = 32; o >= 1; o >>= 1) ss += __shfl_xor(ss, o);
        const float rs = rsqrtf(ss * (1.f / 1024.f) + EPSN);
#pragma unroll
        for (int m = 0; m < 4; ++m) { const int col = m * 256 + lane * 4; const float4 g = *(const float4*)(p.final_g + col);
            float4 o; o.x = v[m].x * rs * g.x; o.y = v[m].y * rs * g.y; o.z = v[m].z * rs * g.z; o.w = v[m].w * rs * g.w; *(float4*)(row + col) = o; }
    }
}

#define LAS __attribute__((address_space(3)))
#define XB_TMO      128
#define XB_XCNT(j)  (256  + 64 * (j))
#define XB_XSUB(j)  (1280 + 64 * (j))
#define XB_XGEN(j)  (2304 + 64 * (j))
#define XB_TOP      3328
#define XB_TOPGEN   3392
#define XCD_BAR_WORDS 3456
#define XB_SPIN_CAP (1u << 18)

__device__ __forceinline__ unsigned xb_ld(unsigned* p)              { return __hip_atomic_load(p, __ATOMIC_RELAXED, __HIP_MEMORY_SCOPE_AGENT); }
__device__ __forceinline__ unsigned xb_add(unsigned* p, unsigned v) { return __hip_atomic_fetch_add(p, v, __ATOMIC_RELAXED, __HIP_MEMORY_SCOPE_AGENT); }
__device__ __forceinline__ unsigned xb_xcc_id() { return (unsigned)__builtin_amdgcn_s_getreg((3 << 11) | 20) & 0xFu; }
#define XB_SPIN(cond, bar) do { unsigned _sp = 0; while (cond) { __builtin_amdgcn_s_sleep(1); \
    if ((++_sp & 255u) == 0u) { if (xb_ld(&(bar)[XB_TMO])) break; if (_sp > XB_SPIN_CAP) { atomicAdd(&(bar)[XB_TMO], 1u); break; } } } } while (0)

struct XcdBarrier {
    unsigned* bar; unsigned x;
    volatile LAS unsigned* st;
};

__device__ __forceinline__ XcdBarrier xcd_barrier_post(unsigned* bar, volatile LAS unsigned* st) {
    XcdBarrier b; b.bar = bar; b.x = xb_xcc_id(); b.st = st;
    if (threadIdx.x == 0) (void)xb_add(&bar[XB_XCNT(b.x)], 1u);
    return b;
}
__device__ __forceinline__ void xcd_barrier_complete(unsigned* bar, unsigned x, unsigned& nloc, unsigned& nx) {
    const unsigned G = gridDim.x * gridDim.y * gridDim.z;
    unsigned sum, cnt, mine, sp = 0u;
    for (;;) {
        sum = 0u; cnt = 0u; mine = 0u;
#pragma unroll
        for (unsigned j = 0; j < 16; ++j) { const unsigned c = xb_ld(&bar[XB_XCNT(j)]); sum += c; cnt += (c > 0u) ? 1u : 0u; mine = (j == x) ? c : mine; }
        if (sum == G) break;
        __builtin_amdgcn_s_sleep(1);
        if ((++sp & 255u) == 0u) { if (xb_ld(&bar[XB_TMO])) break; if (sp > XB_SPIN_CAP) { atomicAdd(&bar[XB_TMO], 1u); break; } }
    }
    nloc = mine > 0u ? mine : 1u; nx = cnt > 0u ? cnt : 1u;
}

__device__ __forceinline__ void xcd_barrier(const XcdBarrier& b) {
    asm volatile("s_waitcnt vmcnt(0)" ::: "memory");
    __syncthreads();
    if (threadIdx.x == 0) {
        unsigned* bar = b.bar;
        __builtin_amdgcn_s_waitcnt(0);
        unsigned nloc = b.st[0], nx = b.st[1];
        if (nloc == 0u) { xcd_barrier_complete(bar, b.x, nloc, nx); b.st[0] = nloc; b.st[1] = nx; }
        const unsigned old = xb_add(&bar[XB_XSUB(b.x)], 1u);
        const unsigned gen = old / nloc;
        if (old + 1u == (gen + 1u) * nloc) {
            __builtin_amdgcn_fence(__ATOMIC_RELEASE, "agent");
            asm volatile("s_waitcnt vmcnt(0)" ::: "memory");
            const unsigned og = xb_add(&bar[XB_TOP], 1u);
            const unsigned tg = og / nx;
            if (og + 1u == (tg + 1u) * nx) xb_add(&bar[XB_TOPGEN], 1u);
            else XB_SPIN(xb_ld(&bar[XB_TOPGEN]) == tg, bar);
            __builtin_amdgcn_fence(__ATOMIC_ACQUIRE, "agent");
            xb_add(&bar[XB_XGEN(b.x)], 1u);
            asm volatile("s_waitcnt vmcnt(0)" ::: "memory");
        } else {
            XB_SPIN(xb_ld(&bar[XB_XGEN(b.x)]) == gen, bar);
            __builtin_amdgcn_fence(__ATOMIC_ACQUIRE, "agent");
            asm volatile("s_waitcnt vmcnt(0)" ::: "memory");
        }
    }
    __syncthreads();
}

struct ListOrder {
    int nM, nN, nwg, base, step, cnt;
    __device__ void init(int M, int N, int base_, int step_, int cnt_) { nM = M / 256; nN = N / 256; nwg = nM * nN; base = base_; step = step_; cnt = cnt_; }
    __device__ bool next(int i, pg8::Unit& u) const {
        if (i >= cnt) return false; const int L = base + i * step; if (L >= nwg) return false;
        int wgid = L; { const int q = nwg / 8, r = nwg % 8, xcd = wgid % 8, off = wgid / 8; wgid = (xcd < r ? xcd * (q + 1) : r * (q + 1) + (xcd - r) * q) + off; }
        const int nig = 8 * nN, gid = wgid / nig, fm = gid * 8, gsz = (nM - fm) < 8 ? (nM - fm) : 8;
        u.pm = fm + ((wgid % nig) % gsz); u.pn = (wgid % nig) / gsz; return true;
    }
    __device__ __forceinline__ void a_ready(const pg8::Unit&) const {}
    __device__ __forceinline__ void done(const pg8::Unit&) const {}
};
template <class Epi>
__device__ __forceinline__ void run_gemm_list(unsigned char* lds, const bf16_t* A, int lda, const bf16_t* Bt, int M, int N, int K, int base, int step, int cnt, const Epi& ep) {
    pg8::Gemm g{A, Bt, M, N, K, lda}; ListOrder S; S.init(M, N, base, step, cnt);
    pg8::gemm_phase<Epi, ListOrder, true, true>((PG8_LAS unsigned char*)lds, g, S, ep);
}
template <class Epi>
__device__ __forceinline__ void run_gemm(unsigned char* lds, const bf16_t* A, int lda, const bf16_t* Bt, int M, int N, int K, int c, const Epi& ep) {
    pg8::Gemm g{A, Bt, M, N, K, lda}; pg8::StaticOrder S; S.init(M, N, gridDim.x, c);
    pg8::gemm_phase<Epi, pg8::StaticOrder, true, true>((PG8_LAS unsigned char*)lds, g, S, ep);
}

__global__ void __launch_bounds__(NTHR) fwd_megakernel(P p) {
    extern __shared__ __attribute__((aligned(16))) unsigned char lds[];
    cg::grid_group grid = cg::this_grid();
    unsigned char* ws = p.ws;
    const int bid = blockIdx.x, nb = gridDim.x;
#define half (tid_l() >> 8)
#define hl (lds + (tid_l() >> 8) * HALF_LDS)

    volatile LAS unsigned* xst = (volatile LAS unsigned*)((LAS unsigned char*)lds + 2 * HALF_LDS);
    if (threadIdx.x == 0) { xst[0] = 0u; xst[1] = 0u; }
    __syncthreads();
    XcdBarrier xb = xcd_barrier_post((unsigned*)(ws + WS_BAR), xst);
    prep_phase(p, lds);
    grid.sync();
    normmod_phase(p, 0, 0, NTOK, 0, nb);
    xcd_barrier(xb);
    const bf16_t* H0 = (const bf16_t*)(ws + WS_H); const bf16_t* W0 = (const bf16_t*)(ws + WS_WIN0);
    PgA epa{ws, p.gk_b, 0};
    run_gemm(lds, H0, 1024, W0, GROWS, 9216, 1024, bid, epa);
    xcd_barrier(xb);
    pre_phase(p, 0, half, hl);
    xcd_barrier(xb);
    for (int grp = 0; grp < 8; ++grp) {
        const int par = grp & 1;
        if (bid < 64) seq_block(p, par, bid, lds);
        if (grp >= 1) {
            PgC epc{p.x, p.ctx, p.out, (float*)(ws + WS_XC), (const float*)(ws + WS_MOD), grp - 1};
            run_gemm_list(lds, (const bf16_t*)(ws + WS_OF + (size_t)(par ^ 1) * OBUF), 2048, (const bf16_t*)(ws + WS_WOUT0), GROWS, 1024, 2048, bid - 64, 72, (bid >= 64 && bid < 136) ? 1 : 0, epc);
        }
        if (grp < 7) {
            int base, step, cnt;
            if (bid >= 136) { base = bid - 136; step = 120; cnt = 4; } else if (bid >= 64) { base = 480 + bid - 64; step = 72; cnt = 2; } else { base = 624 + bid; step = 64; cnt = bid < 24 ? 1 : 0; }
            epa.par = par ^ 1;
            run_gemm_list(lds, H0 + (size_t)(grp + 1) * GROWS * 1024, 1024, W0, GROWS, 9216, 1024, base, step, cnt, epa);
        }
        xcd_barrier(xb);
        if (grp < 7) pre_phase(p, par ^ 1, half, hl);
        gatenorm_phase(p, par);
        xcd_barrier(xb);
    }
    {
        PgC epc{p.x, p.ctx, p.out, (float*)(ws + WS_XC), (const float*)(ws + WS_MOD), 7};
        run_gemm(lds, (const bf16_t*)(ws + WS_OF + OBUF), 2048, (const bf16_t*)(ws + WS_WOUT0), GROWS, 1024, 2048, bid, epc);
        if (bid >= 72) normmod_phase(p, 1, 0, 7 * GROWS, 72, nb - 72);
    }
    xcd_barrier(xb);
    normmod_phase(p, 1, 7 * GROWS, NTOK, 0, nb);
    s5tab_phase(p);
    xcd_barrier(xb);
    {
        PgB epl{(bf16_t*)(ws + WS_F2L), F2LD, (const float2*)(ws + WS_ROPE), 1}; PgB epc{(bf16_t*)(ws + WS_F2C), F2CLD, (const float2*)(ws + WS_ROPE), 0};
        run_gemm(lds, (const bf16_t*)(ws + WS_H), 1024, (const bf16_t*)(ws + WS_WIN1), 32768, 4608, 1024, bid, epl);
        run_gemm(lds, (const bf16_t*)(ws + WS_H) + (size_t)32768 * 1024, 1024, (const bf16_t*)(ws + WS_WIN1), 4096, 1536, 1024, bid, epc);
    }
    xcd_barrier(xb);
    {
        constexpr int NX = 128 * 9;
        for (int it = bid * 2 + half; it < NX + 4096; it += nb * 2) {
            if (it < NX) { const int gd = it / 9, tm = it % 9; LdS5X al{(const bf16_t*)(ws + WS_F2L), gd >> 1}; LdPlain bl{(const bf16_t*)(ws + WS_WX) + (size_t)gd * 128 * 512, 512};
                EpiS5X ep{(bf16_t*)(ws + WS_S), gd >> 1, gd & 1}; gemm_tile(al, bl, ep, tm * 128, 0, 512, hl); }
            else { int a = it - NX;
                if (nb == 256) {
                    const int t = a + 128, li = (t >> 9) * 64 + (((t >> 1) & 255) >> 3) * 2 + (t & 1) - 16; a = ((((t >> 1) & 7) * 2 + (li >> 8)) << 8) + (li & 255); }
                attn_item(p, a, hl); }
        }
    }
    xcd_barrier(xb);
    s5scan_phase(p);
    xcd_barrier(xb);
    {
        for (int it = bid * 2 + half; it < 64 * 32; it += nb * 2) {
            const int local = ((it >> 4) & 31) * 2 + (it & 1); const int g = (nb == 256) ? (it >> 9) * 16 + ((it >> 1) & 7) * 2 + (local >> 5) : it >> 5;
            const int tile = (nb == 256) ? (local & 31) : (it & 31); const int tm = tile >> 2, tn = tile & 3;
            LdS5YA al{(const bf16_t*)(ws + WS_F2L), (const bf16_t*)(ws + WS_S), g}; LdS5YB bl{(const bf16_t*)(ws + WS_KT2), (const bf16_t*)(ws + WS_VT), g};
            EpiS5Y ep{(const bf16_t*)(ws + WS_F2L), (bf16_t*)(ws + WS_H), p.s5_d, g}; gemm_tile(al, bl, ep, tm * 128, tn * 128, 768, hl); }
    }
    xcd_barrier(xb);
    {
        PgGLU ep{(bf16_t*)(ws + WS_F2L)};
        run_gemm(lds, (const bf16_t*)(ws + WS_H), 1024, (const bf16_t*)(ws + WS_WGLU), 32768, 2048, 1024, bid, ep);
    }
    xcd_barrier(xb);
    {
        PgD ep{p.out, (const float*)(ws + WS_MOD) + 17 * 3072};
        run_gemm(lds, (const bf16_t*)(ws + WS_F2L) + QOFF, F2LD, (const bf16_t*)(ws + WS_WOUT1), 32768, 1024, 2048, bid, ep);
    }
    xcd_barrier(xb);
    final_phase(p);
#undef half
#undef hl
}

extern "C" void kernel_launch(void* const* d_in, const int* in_sizes, int n_in, void* d_out, int out_size, void* d_ws, size_t ws_size, hipStream_t stream) {
    static int grid_blocks = 0;
    if (grid_blocks == 0) {
        if (ws_size < WS_TOTAL) { fprintf(stderr, "kernel_launch: workspace too small: %zu < %zu\n", ws_size, (size_t)WS_TOTAL); grid_blocks = -1; return; }
        int dev = 0, cus = 0, per_cu = 0;
        (void)hipGetDevice(&dev);
        (void)hipDeviceGetAttribute(&cus, hipDeviceAttributeMultiprocessorCount, dev);
        (void)hipFuncSetAttribute((const void*)fwd_megakernel, hipFuncAttributeMaxDynamicSharedMemorySize, LDS_BYTES);
        (void)hipOccupancyMaxActiveBlocksPerMultiprocessor(&per_cu, (const void*)fwd_megakernel, NTHR, LDS_BYTES);
        if (per_cu < 1) { fprintf(stderr, "kernel_launch: occupancy query reports %d blocks/CU\n", per_cu); per_cu = 1; }
        grid_blocks = cus;
    }
    if (grid_blocks < 0) return;
    P p{};
    const float** pp = (const float**)&p;
    for (int i = 0; i < 27; ++i) pp[i] = (const float*)d_in[i];
    p.out = (float*)d_out; p.ws = (unsigned char*)d_ws;
    (void)hipMemsetAsync((unsigned char*)d_ws + WS_BAR, 0, 16384, stream);
    void* args[] = {&p};
    hipError_t e = hipLaunchCooperativeKernel((void*)fwd_megakernel, dim3(grid_blocks), dim3(NTHR), args, LDS_BYTES, stream);
    if (e != hipSuccess) fprintf(stderr, "cooperative launch failed: %s (grid %d)\n", hipGetErrorString(e), grid_blocks);
}
```

```cpp
#include <hip/hip_runtime.h>
#include <hip/hip_cooperative_groups.h>
#include <cstdio>
#include <cstdint>
namespace cg = cooperative_groups;

typedef unsigned short bf16_t;
typedef short bf16x8 __attribute__((ext_vector_type(8)));
typedef float f32x4 __attribute__((ext_vector_type(4)));

#define MFMA(a, b, c) __builtin_amdgcn_mfma_f32_16x16x32_bf16(a, b, c, 0, 0, 0)
#define DEV __device__ __forceinline__

constexpr int NTOK = 36864;
constexpr int GROWS = 4608;
constexpr int HALF_LDS = 73728;
constexpr int LDS_BYTES = 2 * HALF_LDS + 64;
constexpr int NTHR = 512;
constexpr float EPSN = 1e-6f;
constexpr int KOFF = 0, VOFF = 256, UOFF = 512, GATT = 1536, QOFF = 2560, GS5 = 3584, F2LD = 4608, F2CLD = 1536;

constexpr size_t WS_WIN1 = 0;
constexpr size_t WS_WGLU = WS_WIN1 + 9437184;
constexpr size_t WS_WOUT1 = WS_WGLU + 4194304;
constexpr size_t WS_XC = WS_WOUT1 + 4194304;
constexpr size_t WS_MOD = WS_XC + 16777216;
constexpr size_t WS_LB = WS_MOD + 417792;
constexpr size_t WS_ROPE = WS_LB + 8192;
constexpr size_t WS_A32 = WS_ROPE + 8192;
constexpr size_t WS_PW = WS_A32 + 65536;
constexpr size_t WS_BB = WS_PW + 2162688;
constexpr size_t WS_R1 = WS_BB + 1048576;
constexpr size_t WS_WIN0 = WS_R1;
constexpr size_t WS_WOUT0 = WS_WIN0 + 18874368;
constexpr size_t WS_WX = WS_R1;
constexpr size_t WS_KT2 = WS_WX + 16777216;
constexpr size_t WS_VT = WS_KT2 + 2064384;
constexpr size_t WS_H = WS_R1 + 35618816;
constexpr size_t WS_S = WS_H + 75497472;
constexpr size_t WS_R3 = WS_S + 37748736;
constexpr size_t WS_FEATB = WS_R3;
constexpr size_t WS_FEATF = WS_FEATB + 56623104;
constexpr size_t WS_QD = WS_FEATF + 56623104;
constexpr size_t WS_KTT = WS_QD + 28311552;
constexpr size_t WS_ATT = WS_KTT + 28311552;
constexpr size_t WS_DEC = WS_ATT + 7077888;
constexpr size_t WS_VTT = WS_DEC + 1769472;
constexpr size_t WS_GATES = WS_VTT + 18874368;
constexpr size_t WS_OF = WS_GATES + 37748736;
constexpr size_t WS_OB = WS_OF + 37748736;
constexpr size_t WS_VTT1 = WS_FEATF + 28311552;
constexpr size_t OBUF = 18874368;
static_assert(WS_OB + 37748736 <= WS_R3 + 314572800, "layer-0 buffers overflow region 3");
constexpr size_t WS_F2L = WS_R3;
constexpr size_t WS_F2C = WS_F2L + 301989888;
constexpr size_t WS_END = WS_F2C + 12582912;
constexpr size_t WS_BAR = WS_END;
constexpr size_t WS_TOTAL = WS_BAR + 16384;
constexpr size_t F2C_DELTA = (WS_F2C - WS_F2L) / 2;

struct P {
    const float *x, *c, *ctx, *c_ctx, *ada_w, *ada_b, *norm_g, *final_g, *ev_w_in, *ev_w_out, *gk_w, *gk_b, *gla_g, *lb_raw, *hg_g,
        *od_w_in, *od_w_out, *sink, *lam_re, *lam_im, *log_dt, *b_re, *b_im, *c_re, *c_im, *s5_d, *glu_w;
    float* out;
    unsigned char* ws;
};

DEV int tid_l() { int t = threadIdx.x; asm volatile("" : "+v"(t)); return t; }
typedef __bf16 bf16v2_t __attribute__((ext_vector_type(2)));
typedef float f32v2_t __attribute__((ext_vector_type(2)));
DEV unsigned pk(float a, float b) { const f32v2_t v = {a, b}; return __builtin_bit_cast(unsigned, __builtin_convertvector(v, bf16v2_t)); }
DEV bf16_t f2bf(float f) { return __builtin_bit_cast(bf16_t, (__bf16)f); }
typedef _Float16 h16v2_t __attribute__((ext_vector_type(2)));
typedef _Float16 h16v8_t __attribute__((ext_vector_type(8)));
DEV unsigned pkh(float a, float b) { const h16v2_t v = {(_Float16)a, (_Float16)b}; return __builtin_bit_cast(unsigned, v); }
DEV void unpackh8(uint4 v, float* f) { const h16v8_t h = __builtin_bit_cast(h16v8_t, v); _Pragma("unroll") for (int e = 0; e < 8; ++e) f[e] = (float)h[e]; }
DEV float bflo(unsigned w) { return __uint_as_float(w << 16); }
DEV float bfhi(unsigned w) { return __uint_as_float(w & 0xffff0000u); }
DEV float bf2f(bf16_t b) { return __uint_as_float((unsigned)b << 16); }
DEV bf16x8 as8(uint4 v) { return __builtin_bit_cast(bf16x8, v); }
DEV float rcpf_(float x) { return __builtin_amdgcn_rcpf(x); }
DEV float sigmoidf_(float x) { return rcpf_(1.f + __expf(-x)); }
DEV float siluf_(float x) { return x * rcpf_(1.f + __expf(-x)); }
DEV float geluf_(float x) { float u = 0.7978845608028654f * (x + 0.044715f * x * x * x); float t = 1.f - 2.f * rcpf_(1.f + __expf(2.f * u)); return 0.5f * x * (1.f + t); }
DEV void unpack8(uint4 v, float* f) { f[0] = bflo(v.x); f[1] = bfhi(v.x); f[2] = bflo(v.y); f[3] = bfhi(v.y); f[4] = bflo(v.z); f[5] = bfhi(v.z); f[6] = bflo(v.w); f[7] = bfhi(v.w); }

namespace pg8 {
#define PG8_LAS __attribute__((address_space(3)))
typedef unsigned short bf16_t;
typedef short bf16x8 __attribute__((ext_vector_type(8)));
typedef float f32x4 __attribute__((ext_vector_type(4)));
typedef unsigned u32x4 __attribute__((ext_vector_type(4)));
constexpr int BM = 256, BK = 64, HALF = 128, HTB = HALF * BK * 2  , STAGE_BYTES = 8 * HTB, NXCD = 8, WGM = 8;

__host__ __device__ __forceinline__ int lds_byte(int r, int c) { const int st = (r >> 4) * 2 + (c >> 5), rr = r & 15, cc = c & 31, ob = rr * 64 + cc * 2; return st * 1024 + (ob ^ (((ob >> 9) & 1) << 5)); }
__host__ __device__ __forceinline__ void stage_rc(int b, int& R, int& C) { const int st = b / 1024, sb = b % 1024, swz = sb ^ (((sb >> 9) & 1) << 5); R = (st >> 1) * 16 + swz / 64; C = (st & 1) * 32 + (swz % 64) / 2; }
__host__ __device__ __forceinline__ int perm32(int rho) { const int n = rho >> 4, i = rho & 15; return 8 * (i >> 2) + 4 * n + (i & 3); }

struct Unit { int pm, pn; };
struct Gemm { const bf16_t* A; const bf16_t* Bt; int M, N, K, lda; };

struct StaticOrder {
    int nM, nN, nwg, G, c;
    __host__ __device__ void init(int M, int N, int G_, int c_) { nM = M / BM; nN = N / BM; nwg = nM * nN; G = G_; c = c_; }
    __host__ __device__ bool next(int i, Unit& u) const {
        const long L = (long)i * G + c; if (L >= nwg) return false;
        int wgid = (int)L; { const int q = nwg / NXCD, r = nwg % NXCD, xcd = wgid % NXCD, off = wgid / NXCD; wgid = (xcd < r ? xcd * (q + 1) : r * (q + 1) + (xcd - r) * q) + off; }
        const int nig = WGM * nN, gid = wgid / nig, fm = gid * WGM, gsz = (nM - fm) < WGM ? (nM - fm) : WGM;
        u.pm = fm + ((wgid % nig) % gsz); u.pn = (wgid % nig) / gsz; return true;
    }
    __device__ __forceinline__ void a_ready(const Unit&) const {}
    __device__ __forceinline__ void done(const Unit&) const {}
};
template <class Epi, class Sched, bool ALIGN_EPI = false, bool SP2 = false>
__device__ __forceinline__ void gemm_phase(PG8_LAS unsigned char* lds, const Gemm g, const Sched& S, const Epi& E) {
    const int tid = tid_l(), wid = __builtin_amdgcn_readfirstlane(tid >> 6), lane = tid & 63, wr = wid >> 2, wc = wid & 3, fr = lane & 15, fq = lane >> 4;
    const int K = g.K, nt = K / BK;
    unsigned voffA[2], voffB[2];
#pragma unroll
    for (int i = 0; i < 2; ++i) { int R, C; stage_rc(tid * 16 + i * 8192, R, C); const int Rb = Epi::PERM ? ((R & ~31) + perm32(R & 31)) : R;
        voffA[i] = (unsigned)(R * g.lda + C) * 2u; voffB[i] = (unsigned)(Rb * K + C) * 2u; }
    const size_t kstep = (size_t)(BK * 2);
    const size_t hstep = (size_t)HALF * K * 2, hstepA = (size_t)HALF * g.lda * 2, tstepA = 2 * hstepA;
    const size_t tstep = 2 * hstep;
    const unsigned ldsw = (unsigned)wid * 1024u;
    const int aoff = lds_byte(wr * 64 + fr, fq * 8), boff = lds_byte(wc * 32 + fr, fq * 8);
#define PG8_SA(b, h) (((b) * 2 + (h)) * HTB)
#define PG8_SB(b, h) ((4 + (b) * 2 + (h)) * HTB)
#define PG8_STAGE(bufoff, gbase, voff) do { _Pragma("unroll") for (int _i = 0; _i < 2; ++_i) \
        __builtin_amdgcn_global_load_lds((const unsigned*)((const char*)(gbase) + (voff)[_i]), (PG8_LAS unsigned*)(lds + (bufoff) + ldsw + _i * 8192), 16, 0, 0); } while (0)
#define PG8_LDA(dst, b, h) do { _Pragma("unroll") for (int m = 0; m < 4; ++m) _Pragma("unroll") for (int k = 0; k < 2; ++k) dst[m][k] = *(const PG8_LAS bf16x8*)(lds + PG8_SA(b, h) + aoff + m * 2048 + k * 1024); } while (0)
#define PG8_LDB(dst, b, h) do { _Pragma("unroll") for (int n = 0; n < 2; ++n) _Pragma("unroll") for (int k = 0; k < 2; ++k) dst[n][k] = *(const PG8_LAS bf16x8*)(lds + PG8_SB(b, h) + boff + n * 2048 + k * 1024); } while (0)
#define PG8_MMA(ai, bj, At, Bt) do { __builtin_amdgcn_s_setprio(1); _Pragma("unroll") for (int m = 0; m < 4; ++m) _Pragma("unroll") for (int n = 0; n < 2; ++n) _Pragma("unroll") for (int k = 0; k < 2; ++k) \
        acc[ai][bj][m][n] = __builtin_amdgcn_mfma_f32_16x16x32_bf16(Bt[n][k], At[m][k], acc[ai][bj][m][n], 0, 0, 0); __builtin_amdgcn_s_setprio(0); } while (0)
#define PG8_WAIT_V(n) asm volatile("s_waitcnt vmcnt(" #n ")" ::: "memory")
#define PG8_WAIT_L(n) asm volatile("s_waitcnt lgkmcnt(" #n ")" ::: "memory")
#define PG8_BAR __builtin_amdgcn_s_barrier()
#define PG8_SCHED __builtin_amdgcn_sched_barrier(0)
    Unit cur, nxt; int ui = 0;
    if (!S.next(0, cur)) return;
    f32x4 acc[2][2][4][2];
#pragma unroll
    for (int a = 0; a < 2; ++a)
#pragma unroll
        for (int b = 0; b < 2; ++b)
#pragma unroll
            for (int m = 0; m < 4; ++m)
#pragma unroll
                for (int n = 0; n < 2; ++n) acc[a][b][m][n] = (f32x4){0.f, 0.f, 0.f, 0.f};
    bf16x8 At[4][2], B0[2][2], B1[2][2];
    const char* cA = (const char*)g.A + (size_t)cur.pm * tstepA; const char* cB = (const char*)g.Bt + (size_t)cur.pn * tstep;
    S.a_ready(cur);
    if constexpr (SP2) {
        PG8_STAGE(PG8_SB(0, 0), cB, voffB); PG8_STAGE(PG8_SB(0, 1), cB + hstep, voffB); PG8_STAGE(PG8_SA(0, 0), cA, voffA); PG8_STAGE(PG8_SA(0, 1), cA + hstepA, voffA);
        if (wr == 1) PG8_BAR;
        PG8_WAIT_V(2); PG8_BAR;
        PG8_STAGE(PG8_SB(1, 0), cB + kstep, voffB); PG8_STAGE(PG8_SA(1, 0), cA + kstep, voffA); PG8_STAGE(PG8_SB(1, 1), cB + hstep + kstep, voffB);
        PG8_WAIT_V(6); PG8_BAR;
    } else {
        PG8_STAGE(PG8_SB(0, 0), cB, voffB); PG8_STAGE(PG8_SA(0, 0), cA, voffA); PG8_STAGE(PG8_SB(0, 1), cB + hstep, voffB); PG8_STAGE(PG8_SA(0, 1), cA + hstepA, voffA);
        if (wr == 1) PG8_BAR;
        PG8_WAIT_V(4); PG8_BAR;
        PG8_STAGE(PG8_SB(1, 0), cB + kstep, voffB); PG8_STAGE(PG8_SA(1, 0), cA + kstep, voffA); PG8_STAGE(PG8_SB(1, 1), cB + hstep + kstep, voffB);
        PG8_WAIT_V(6); PG8_BAR;
    }
    for (;;) {
        const bool has_next = S.next(ui + 1, nxt);
        const char* nA = has_next ? (const char*)g.A + (size_t)nxt.pm * tstepA : cA; const char* nB = has_next ? (const char*)g.Bt + (size_t)nxt.pn * tstep : cB;
        for (int t = 0; t < nt; t += 2) {
            const bool last = (t == nt - 2);
            const char* a1 = cA + (size_t)(t + 1) * kstep;
            const char* a2 = last ? nA : cA + (size_t)(t + 2) * kstep; const char* b2 = last ? nB : cB + (size_t)(t + 2) * kstep;
            const char* a3 = a2 + kstep; const char* b3 = b2 + kstep;
            if (last && has_next) S.a_ready(nxt);
            if constexpr (SP2) {
            PG8_LDB(B0, 0, 0); PG8_LDB(B1, 0, 1); PG8_SCHED; PG8_LDA(At, 0, 0); PG8_STAGE(PG8_SA(1, 1), a1 + hstepA, voffA);
            PG8_WAIT_V(8); PG8_WAIT_L(0); PG8_BAR; PG8_MMA(0, 0, At, B0); PG8_MMA(0, 1, At, B1); PG8_BAR; PG8_SCHED;
            PG8_LDA(At, 0, 1); PG8_STAGE(PG8_SB(0, 0), b2, voffB); PG8_STAGE(PG8_SB(0, 1), b2 + hstep, voffB); PG8_STAGE(PG8_SA(0, 0), a2, voffA);
            PG8_WAIT_V(8); PG8_WAIT_L(0); PG8_BAR; PG8_MMA(1, 0, At, B0); PG8_MMA(1, 1, At, B1); PG8_BAR; PG8_SCHED;
            PG8_LDB(B0, 1, 0); PG8_LDB(B1, 1, 1); PG8_SCHED; PG8_LDA(At, 1, 0); PG8_STAGE(PG8_SA(0, 1), a2 + hstepA, voffA);
            PG8_WAIT_V(8); PG8_WAIT_L(0); PG8_BAR; PG8_MMA(0, 0, At, B0); PG8_MMA(0, 1, At, B1); PG8_BAR; PG8_SCHED;
            PG8_LDA(At, 1, 1); PG8_STAGE(PG8_SB(1, 0), b3, voffB); PG8_STAGE(PG8_SB(1, 1), b3 + hstep, voffB); PG8_STAGE(PG8_SA(1, 0), a3, voffA);
            PG8_WAIT_V(8); PG8_WAIT_L(0); PG8_BAR; PG8_MMA(1, 0, At, B0); PG8_MMA(1, 1, At, B1); PG8_BAR; PG8_SCHED;
            } else {
            PG8_LDB(B0, 0, 0); PG8_SCHED; PG8_LDA(At, 0, 0); PG8_STAGE(PG8_SA(1, 1), a1 + hstepA, voffA);
            PG8_WAIT_L(8); PG8_BAR; PG8_WAIT_L(0); PG8_MMA(0, 0, At, B0); PG8_BAR; PG8_SCHED;
            PG8_LDB(B1, 0, 1); PG8_STAGE(PG8_SB(0, 0), b2, voffB);
            PG8_BAR; PG8_WAIT_L(0); PG8_MMA(0, 1, At, B1); PG8_BAR;
            PG8_LDA(At, 0, 1); PG8_STAGE(PG8_SA(0, 0), a2, voffA);
            PG8_BAR; PG8_WAIT_L(0); PG8_MMA(1, 0, At, B0); PG8_BAR; PG8_SCHED;
            PG8_STAGE(PG8_SB(0, 1), b2 + hstep, voffB);
            PG8_WAIT_V(6); PG8_BAR; PG8_MMA(1, 1, At, B1); PG8_BAR;
            PG8_LDB(B0, 1, 0); PG8_SCHED; PG8_LDA(At, 1, 0); PG8_STAGE(PG8_SA(0, 1), a2 + hstepA, voffA);
            PG8_WAIT_L(8); PG8_BAR; PG8_WAIT_L(0); PG8_MMA(0, 0, At, B0); PG8_BAR; PG8_SCHED;
            PG8_LDB(B1, 1, 1); PG8_STAGE(PG8_SB(1, 0), b3, voffB);
            PG8_BAR; PG8_WAIT_L(0); PG8_MMA(0, 1, At, B1); PG8_BAR;
            PG8_LDA(At, 1, 1); PG8_STAGE(PG8_SA(1, 0), a3, voffA);
            PG8_BAR; PG8_WAIT_L(0); PG8_MMA(1, 0, At, B0); PG8_BAR; PG8_SCHED;
            PG8_STAGE(PG8_SB(1, 1), b3 + hstep, voffB);
            PG8_WAIT_V(6); PG8_BAR; PG8_MMA(1, 1, At, B1); PG8_BAR;
            }
        }
        if constexpr (ALIGN_EPI) { if (wr == 0) PG8_BAR; }
        if constexpr (!Epi::AFTER_DRAIN) { E(acc, cur, wr, wc, fr, fq); S.done(cur); }
        if (!has_next) break;
#pragma unroll
        for (int a = 0; a < 2; ++a)
#pragma unroll
            for (int b = 0; b < 2; ++b)
#pragma unroll
                for (int m = 0; m < 4; ++m)
#pragma unroll
                    for (int n = 0; n < 2; ++n) acc[a][b][m][n] = (f32x4){0.f, 0.f, 0.f, 0.f};
        cur = nxt; cA = nA; cB = nB; ++ui;
        if constexpr (ALIGN_EPI) { if (wr == 1) PG8_BAR; }
    }
    PG8_WAIT_V(0);
    if constexpr (!ALIGN_EPI) { if (wr == 0) PG8_BAR; }
    PG8_BAR;
    if constexpr (Epi::AFTER_DRAIN) { E.fused(acc, cur, wr, wc, fr, fq, lds, wid, lane); S.done(cur); }
#undef PG8_SA
#undef PG8_SB
#undef PG8_STAGE
#undef PG8_LDA
#undef PG8_LDB
#undef PG8_MMA
#undef PG8_WAIT_V
#undef PG8_WAIT_L
#undef PG8_BAR
#undef PG8_SCHED
}
}

template <class AL, class BL, class EP>
__device__ __forceinline__ void gemm_tile(const AL& al, const BL& bl, const EP& ep, int m0, int n0, int K, unsigned char* lds) {
    const int tid = tid_l() & 255, lane = tid & 63, w = tid >> 6, wm = w >> 1, wn = w & 1;
    bf16_t* sA = (bf16_t*)lds;
    bf16_t* sB = sA + 2 * 128 * 72;
    const int lr = tid >> 3, lk = (tid & 7) * 8;
    f32x4 acc[4][4];
#pragma unroll
    for (int i = 0; i < 4; ++i)
#pragma unroll
        for (int j = 0; j < 4; ++j) acc[i][j] = (f32x4){0.f, 0.f, 0.f, 0.f};
    uint4 ra0[4], rb0[4], ra1[4], rb1[4];
#define GLOAD(RA, RB, KT) { const int k_ = (KT) * 64 + lk; _Pragma("unroll") for (int x = 0; x < 4; ++x) { RA[x] = al.load(m0 + lr + 32 * x, k_); RB[x] = bl.load(n0 + lr + 32 * x, k_); } }
#define LSTORE(RA, RB, BUF) { bf16_t* a_ = sA + (BUF) * 128 * 72; bf16_t* b_ = sB + (BUF) * 128 * 72; _Pragma("unroll") for (int x = 0; x < 4; ++x) { *(uint4*)(a_ + (lr + 32 * x) * 72 + lk) = RA[x]; *(uint4*)(b_ + (lr + 32 * x) * 72 + lk) = RB[x]; } }
#define COMPUTE(BUF) { const bf16_t* a_ = sA + (BUF) * 128 * 72; const bf16_t* b_ = sB + (BUF) * 128 * 72; \
        _Pragma("unroll") for (int kh = 0; kh < 2; ++kh) { bf16x8 fw[4], ft[4]; \
            _Pragma("unroll") for (int i = 0; i < 4; ++i) fw[i] = as8(*(const uint4*)(b_ + (wn * 64 + i * 16 + (lane & 15)) * 72 + kh * 32 + (lane >> 4) * 8)); \
            _Pragma("unroll") for (int j = 0; j < 4; ++j) ft[j] = as8(*(const uint4*)(a_ + (wm * 64 + j * 16 + (lane & 15)) * 72 + kh * 32 + (lane >> 4) * 8)); \
            _Pragma("unroll") for (int i = 0; i < 4; ++i) _Pragma("unroll") for (int j = 0; j < 4; ++j) acc[i][j] = MFMA(fw[i], ft[j], acc[i][j]); } }
    const int nk = K >> 6;
    __syncthreads();
    GLOAD(ra0, rb0, 0); GLOAD(ra1, rb1, 1);
    LSTORE(ra0, rb0, 0);
    __syncthreads();
    for (int kt = 0; kt < nk; kt += 2) {
        GLOAD(ra0, rb0, (kt + 2 < nk ? kt + 2 : nk - 1));
        COMPUTE(0);
        LSTORE(ra1, rb1, 1);
        __syncthreads();
        GLOAD(ra1, rb1, (kt + 3 < nk ? kt + 3 : nk - 1));
        COMPUTE(1);
        if (kt + 2 < nk) LSTORE(ra0, rb0, 0);
        __syncthreads();
    }
#undef GLOAD
#undef LSTORE
#undef COMPUTE
    ep(acc, m0 + wm * 64, n0 + wn * 64, lane);
}
DEV void tile_map8(int it, int NT, int& tm, int& tn) { const int x = it & 7, q = it >> 3, c = NT >> 3; tn = x + 8 * (q % c); tm = q / c; }

struct LdPlain { const bf16_t* base; int ld; DEV uint4 load(int row, int k) const { return *(const uint4*)(base + (size_t)row * ld + k); } };
struct LdH1L { const bf16_t* H; DEV uint4 load(int m, int k) const { const int b = m >> 11, t = m & 2047; return *(const uint4*)(H + (size_t)(b * 2304 + 256 + t) * 1024 + k); } };
struct LdH1C { const bf16_t* H; DEV uint4 load(int m, int k) const { const int b = m >> 8, j = m & 255; return *(const uint4*)(H + (size_t)(b * 2304 + j) * 1024 + k); } };
struct LdD { const bf16_t* F; DEV uint4 load(int m, int k) const { const int kk = k < 1024 ? QOFF + k : GS5 + k - 1024; return *(const uint4*)(F + (size_t)m * F2LD + kk); } };
struct LdS5X { const bf16_t* FL; int g;
    DEV uint4 load(int n, int k) const { const int b = n / 72, c = n - b * 72, i = k >> 4, h = k & 15;
        const size_t off = c < 8 ? F2C_DELTA + (size_t)(b * 256 + c * 32 + i) * F2CLD : (size_t)(b * 2048 + (c - 8) * 32 + i) * F2LD;
        return *(const uint4*)(FL + off + UOFF + g * 16 + h); } };
struct LdS5YA { const bf16_t* FL; const bf16_t* S; int g;
    DEV uint4 load(int n, int k) const { const int b = n >> 6, cl = n & 63;
        const bf16_t* p = k < 512 ? FL + (size_t)(b * 2048 + cl * 32 + (k >> 4)) * F2LD + UOFF + g * 16 + (k & 15) : S + ((size_t)(b * 72 + cl + 8) * 64 + g) * 256 + (k - 512);
        return *(const uint4*)p; } };
struct LdS5YB { const bf16_t* KT2; const bf16_t* VT; int g;
    DEV uint4 load(int col, int k) const { const int t = col >> 4, h = col & 15;
        const bf16_t* p = k < 512 ? KT2 + ((size_t)(g * 63 + (t - (k >> 4) + 31)) * 16 + h) * 16 + (k & 15) : VT + ((size_t)g * 512 + col) * 256 + (k - 512);
        return *(const uint4*)p; } };

#define PG_ROWS_COLS(...) \
    _Pragma("unroll") for (int ai = 0; ai < 2; ++ai) _Pragma("unroll") for (int m = 0; m < 4; ++m) { const int row = u.pm * 256 + ai * 128 + wr * 64 + m * 16 + fr; \
        _Pragma("unroll") for (int bj = 0; bj < 2; ++bj) _Pragma("unroll") for (int n = 0; n < 2; ++n) { const int col = u.pn * 256 + bj * 128 + wc * 32 + n * 16 + fq * 4; const f32x4 v = acc[ai][bj][m][n]; __VA_ARGS__ } }
struct PgA {
    static constexpr bool PERM = false, AFTER_DRAIN = false;
    unsigned char* ws; const float* gkb; int par;
    DEV void operator()(const f32x4 (&acc)[2][2][4][2], const pg8::Unit& u, int wr, int wc, int fr, int fq) const {
        bf16_t* featb = (bf16_t*)(ws + WS_FEATB); unsigned short* featf = (unsigned short*)(ws + WS_FEATF);   bf16_t* gates = (bf16_t*)(ws + WS_GATES + (size_t)par * OBUF);
        PG_ROWS_COLS(
            if ((col >= 2048 && col < 3072) || (col >= 7168 && col < 8192)) {
                const int oc = col < 3072 ? col - 2048 : col - 6144;
                uint2 o; o.x = pk(v[0], v[1]); o.y = pk(v[2], v[3]); *(uint2*)(gates + (size_t)row * 2048 + oc) = o;
            } else if ((col >= 1024 && col < 2048) || (col >= 6144 && col < 7168)) {
                const int vc = col < 2048 ? col - 1024 : col - 5120; const int bl_ = row / 2304, j_ = row - bl_ * 2304;
                bf16_t* vt = (bf16_t*)(ws + (par ? WS_VTT1 : WS_VTT)) + (((size_t)(bl_ * 72 + (j_ >> 5)) * 2048 + vc) * 32 + (j_ & 31));
                const unsigned p01 = pk(v[0], v[1]), p23 = pk(v[2], v[3]);
                vt[0] = (bf16_t)(p01 & 0xffffu); vt[32] = (bf16_t)(p01 >> 16); vt[64] = (bf16_t)(p23 & 0xffffu); vt[96] = (bf16_t)(p23 >> 16);
            } else if (col < 4096 || (col >= 6144 && col < 8192)) {
                const float s = col < 512 ? 0.08838834764831845f : 1.f; const int oc = col < 4096 ? col : col - 2048;
                uint2 o; o.x = pk(v[0] * s, v[1] * s); o.y = pk(v[2] * s, v[3] * s); *(uint2*)(featb + (size_t)row * 6144 + oc) = o;
            } else if (col < 6144) {
                const int cc = col - 4096;
                *(uint2*)(featf + (size_t)row * 3072 + cc) = make_uint2(pkh(v[0], v[1]), pkh(v[2], v[3]));
            } else {
                const int cc = col - 8192; const f32x4 bb = *(const f32x4*)(gkb + cc);
                *(uint2*)(featf + (size_t)row * 3072 + 2048 + cc) = make_uint2(pkh(v[0] + bb[0], v[1] + bb[1]), pkh(v[2] + bb[2], v[3] + bb[3]));
            })
    }
};
struct PgC {
    static constexpr bool PERM = false, AFTER_DRAIN = false;
    const float* x; const float* ctx; float* out; float* xc; const float* mod; int grp;
    DEV void operator()(const f32x4 (&acc)[2][2][4][2], const pg8::Unit& u, int wr, int wc, int fr, int fq) const {
        PG_ROWS_COLS(
            const int R = grp * GROWS + row; const int b = R / 2304, jj = R - b * 2304; const bool isc = jj < 256;
            const size_t ro = isc ? (size_t)(b * 256 + jj) * 1024 : (size_t)(b * 2048 + jj - 256) * 1024;
            const f32x4 s = *(const f32x4*)((isc ? ctx : x) + ro + col); const f32x4 gt = *(const f32x4*)(mod + (size_t)(isc ? 16 : b) * 3072 + 2048 + col);
            *(f32x4*)((isc ? xc : out) + ro + col) = s + gt * v; )
    }
};
struct PgB {
    static constexpr bool PERM = false, AFTER_DRAIN = false;
    bf16_t* F; int ld; const float2* rope; int latent;
    DEV void operator()(const f32x4 (&acc)[2][2][4][2], const pg8::Unit& u, int wr, int wc, int fr, int fq) const {
#pragma unroll
        for (int ai = 0; ai < 2; ++ai)
#pragma unroll
            for (int m = 0; m < 4; ++m) { const int row = u.pm * 256 + ai * 128 + wr * 64 + m * 16 + fr; const int t = row & 2047;
#pragma unroll
                for (int bj = 0; bj < 2; ++bj) { const int cb = u.pn * 256 + bj * 128 + wc * 32; f32x4 v0 = acc[ai][bj][m][0], v1 = acc[ai][bj][m][1];
                    const bool isq = cb >= QOFF && cb < QOFF + 1024;
                    if (latent && (cb < VOFF || isq)) { const float sc = isq ? 0.18033688011112042f : 1.f; const int pos = (cb & 32) ? (t & 63) : (t >> 6); f32x4 o0, o1;
#pragma unroll
                        for (int r = 0; r < 4; ++r) { const float2 cs = rope[pos * 16 + fq * 4 + r]; o0[r] = (v0[r] * cs.x - v1[r] * cs.y) * sc; o1[r] = (v1[r] * cs.x + v0[r] * cs.y) * sc; }
                        v0 = o0; v1 = o1; }
                    uint2 o; o.x = pk(v0[0], v0[1]); o.y = pk(v0[2], v0[3]); *(uint2*)(F + (size_t)row * ld + cb + fq * 4) = o;
                    o.x = pk(v1[0], v1[1]); o.y = pk(v1[2], v1[3]); *(uint2*)(F + (size_t)row * ld + cb + 16 + fq * 4) = o; } }
    }
};
struct PgGLU {
    static constexpr bool PERM = false, AFTER_DRAIN = false;
    bf16_t* F;
    DEV void operator()(const f32x4 (&acc)[2][2][4][2], const pg8::Unit& u, int wr, int wc, int fr, int fq) const {
#pragma unroll
        for (int ai = 0; ai < 2; ++ai)
#pragma unroll
            for (int m = 0; m < 4; ++m) { const int row = u.pm * 256 + ai * 128 + wr * 64 + m * 16 + fr;
#pragma unroll
                for (int n = 0; n < 2; ++n) { const int oc = u.pn * 128 + wc * 32 + n * 16 + fq * 4; const f32x4 a = acc[ai][0][m][n], b = acc[ai][1][m][n];
                    bf16_t* pp = F + (size_t)row * F2LD + GS5 + oc; const uint2 gg = *(const uint2*)pp;
                    const float g0 = bflo(gg.x), g1 = bfhi(gg.x), g2 = bflo(gg.y), g3 = bfhi(gg.y);
                    uint2 o; o.x = pk(a[0] * sigmoidf_(b[0]) * siluf_(g0), a[1] * sigmoidf_(b[1]) * siluf_(g1)); o.y = pk(a[2] * sigmoidf_(b[2]) * siluf_(g2), a[3] * sigmoidf_(b[3]) * siluf_(g3));
                    *(uint2*)pp = o; } }
    }
};
struct PgD {
    static constexpr bool PERM = false, AFTER_DRAIN = false;
    float* out; const float* mod;
    DEV void operator()(const f32x4 (&acc)[2][2][4][2], const pg8::Unit& u, int wr, int wc, int fr, int fq) const {
        PG_ROWS_COLS(
            float* dst = out + (size_t)row * 1024 + col; const f32x4 gt = *(const f32x4*)(mod + (size_t)(row >> 11) * 3072 + 2048 + col);
            *(f32x4*)dst = *(const f32x4*)dst + gt * v; )
    }
};
struct EpiS5X { bf16_t* S; int g, dir;
    DEV void operator()(f32x4 (&acc)[4][4], int mrow0, int ncol0, int lane) const {
#pragma unroll
        for (int j = 0; j < 4; ++j) { const int n = mrow0 + j * 16 + (lane & 15);
#pragma unroll
            for (int i = 0; i < 4; ++i) { const int col = ncol0 + i * 16 + (lane >> 4) * 4; const f32x4 v = acc[i][j];
                uint2 o; o.x = pk(v[0], v[1]); o.y = pk(v[2], v[3]); *(uint2*)(S + (((size_t)n * 64 + g) * 2 + dir) * 128 + col) = o; } }
    }
};
struct EpiS5Y { const bf16_t* FL; bf16_t* Z; const float* dsk; int g;
    DEV void operator()(f32x4 (&acc)[4][4], int mrow0, int ncol0, int lane) const {
#pragma unroll
        for (int j = 0; j < 4; ++j) { const int n = mrow0 + j * 16 + (lane & 15); const int b = n >> 6, cl = n & 63;
#pragma unroll
            for (int i = 0; i < 4; ++i) { const int t = (ncol0 >> 4) + i, h = (lane >> 4) * 4; const f32x4 v = acc[i][j];
                const size_t m = (size_t)b * 2048 + cl * 32 + t; const uint2 uu = *(const uint2*)(FL + m * F2LD + UOFF + g * 16 + h);
                const float4 dd = *(const float4*)(dsk + g * 16 + h);
                uint2 o; o.x = pk(geluf_(v[0] + dd.x * bflo(uu.x)), geluf_(v[1] + dd.y * bfhi(uu.x))); o.y = pk(geluf_(v[2] + dd.z * bflo(uu.y)), geluf_(v[3] + dd.w * bfhi(uu.y)));
                *(uint2*)(Z + m * 1024 + g * 16 + h) = o; } }
    }
};

template <class MAP>
__device__ __forceinline__ void transpose_tile(const float* src, int ldsrc, bf16_t* dst, int K, int n0, int k0, const MAP& map, unsigned char* lds) {
    float* tile = (float*)lds;
    const int tid = tid_l() & 255;
    __syncthreads();
#pragma unroll
    for (int e = 0; e < 16; ++e) { const int idx = tid + e * 256; const int kk = idx >> 6, nn = idx & 63; tile[kk * 65 + nn] = src[(size_t)(k0 + kk) * ldsrc + map(n0 + nn)]; }
    __syncthreads();
    const int nn = tid >> 2, kq = (tid & 3) * 16;
    unsigned o[8];
#pragma unroll
    for (int e = 0; e < 8; ++e) o[e] = pk(tile[(kq + 2 * e) * 65 + nn], tile[(kq + 2 * e + 1) * 65 + nn]);
    uint4* d = (uint4*)(dst + (size_t)(n0 + nn) * K + k0 + kq);
    d[0] = make_uint4(o[0], o[1], o[2], o[3]); d[1] = make_uint4(o[4], o[5], o[6], o[7]);
}
struct MapIn0 { DEV int operator()(int n) const { return n < 2048 ? n : n + 32; } };
struct MapId { DEV int operator()(int n) const { return n; } };
struct MapIn1 { DEV int operator()(int n) const { return n < 512 ? n + 1024 : n < 1536 ? n + 2048 : n < 2560 ? n : n < 3584 ? n - 2560 : n; } };
struct MapGlu { DEV int operator()(int n) const { return ((n >> 7) & 1) * 1024 + (n >> 8) * 128 + (n & 127); } };

__device__ __forceinline__ void prep_phase(const P& p, unsigned char* lds) {
    unsigned char* ws = p.ws;
    const int tid5 = tid_l(), half = tid5 >> 8, tid = tid5 & 255, nb = gridDim.x, bid = blockIdx.x;
    lds += half * HALF_LDS;
    constexpr int N_IN0 = 128 * 16, N_G = 16 * 16, N_OUT0 = 16 * 32, N_IN1 = 72 * 16, N_GLU = 32 * 16, N_OUT1 = 16 * 32, N_ADA = 96;
    constexpr int E0 = N_IN0, E1 = E0 + N_G, E2 = E1 + N_OUT0, E3 = E2 + N_IN1, E4 = E3 + N_GLU, E5 = E4 + N_OUT1, E6 = E5 + N_ADA;
    for (int it = bid * 2 + half; it < E6; it += nb * 2) {
        if (it < E0) { transpose_tile(p.ev_w_in, 8224, (bf16_t*)(ws + WS_WIN0), 1024, (it >> 4) * 64, (it & 15) * 64, MapIn0(), lds); }
        else if (it < E1) {
            const int i2 = it - E0; const int n0 = (i2 >> 4) * 64, k0 = (i2 & 15) * 64; const int nn = tid >> 2, kq = (tid & 3) * 16;
            const int n = n0 + nn, dd = n >> 9, cc = n & 511; float gw[16];
#pragma unroll
            for (int r = 0; r < 16; ++r) gw[r] = p.gk_w[(size_t)(dd * 16 + r) * 512 + cc];
            unsigned o[8];
#pragma unroll
            for (int e = 0; e < 8; ++e) { float v2[2];
#pragma unroll
                for (int q = 0; q < 2; ++q) { const float* wr = p.ev_w_in + (size_t)(k0 + kq + 2 * e + q) * 8224 + 2048 + dd * 16; float a = 0.f;
#pragma unroll
                    for (int r = 0; r < 16; ++r) a += wr[r] * gw[r];
                    v2[q] = a; }
                o[e] = pk(v2[0], v2[1]); }
            uint4* d = (uint4*)((bf16_t*)(ws + WS_WIN0) + (size_t)(8192 + n) * 1024 + k0 + kq);
            d[0] = make_uint4(o[0], o[1], o[2], o[3]); d[1] = make_uint4(o[4], o[5], o[6], o[7]);
        }
        else if (it < E2) { const int i2 = it - E1; transpose_tile(p.ev_w_out, 1024, (bf16_t*)(ws + WS_WOUT0), 2048, (i2 >> 5) * 64, (i2 & 31) * 64, MapId(), lds); }
        else if (it < E3) { const int i2 = it - E2; transpose_tile(p.od_w_in, 4608, (bf16_t*)(ws + WS_WIN1), 1024, (i2 >> 4) * 64, (i2 & 15) * 64, MapIn1(), lds); }
        else if (it < E4) { const int i2 = it - E3; transpose_tile(p.glu_w, 2048, (bf16_t*)(ws + WS_WGLU), 1024, (i2 >> 4) * 64, (i2 & 15) * 64, MapGlu(), lds); }
        else if (it < E5) { const int i2 = it - E4; transpose_tile(p.od_w_out, 1024, (bf16_t*)(ws + WS_WOUT1), 2048, (i2 >> 5) * 64, (i2 & 31) * 64, MapId(), lds); }
        else {
            const int i2 = it - E5; const int layer = i2 / 48, col0 = (i2 % 48) * 64;
            float* sc = (float*)lds;
            __syncthreads();
            for (int idx = tid; idx < 17 * 1024; idx += 256) { const int r = idx >> 10, k = idx & 1023; const float v = r < 16 ? p.c[r * 1024 + k] : p.c_ctx[k]; sc[idx] = v / (1.f + expf(-v)); }
            __syncthreads();
            const int cl = tid & 63, kq = tid >> 6; float a[17];
#pragma unroll
            for (int r = 0; r < 17; ++r) a[r] = 0.f;
            const float* wp = p.ada_w + (size_t)layer * 1024 * 3072 + col0 + cl;
            for (int k = kq * 256; k < kq * 256 + 256; k += 8) { float wv[8];
#pragma unroll
                for (int j = 0; j < 8; ++j) wv[j] = wp[(size_t)(k + j) * 3072];
#pragma unroll
                for (int j = 0; j < 8; ++j)
#pragma unroll
                    for (int r = 0; r < 17; ++r) a[r] += sc[r * 1024 + k + j] * wv[j]; }
            __syncthreads();
#pragma unroll
            for (int r = 0; r < 17; ++r) sc[(kq * 17 + r) * 64 + cl] = a[r];
            __syncthreads();
            for (int idx = tid; idx < 17 * 64; idx += 256) { const int r = idx >> 6, c2 = idx & 63;
                const float v = sc[(0 * 17 + r) * 64 + c2] + sc[(1 * 17 + r) * 64 + c2] + sc[(2 * 17 + r) * 64 + c2] + sc[(3 * 17 + r) * 64 + c2];
                ((float*)(ws + WS_MOD))[((size_t)layer * 17 + r) * 3072 + col0 + c2] = v + p.ada_b[layer * 3072 + col0 + c2]; }
        }
    }
    const int gt = bid * NTHR + tid5, gs = nb * NTHR;
    for (int idx = gt; idx < 2048; idx += gs) { const int d = idx >> 10, col = idx & 1023; const float r0 = p.lb_raw[d * 2048 + col], r1 = p.lb_raw[d * 2048 + 1024 + col]; ((float*)(ws + WS_LB))[idx] = 1.f / (1.f + expf(r1 - r0)); }
    for (int idx = gt; idx < 1024; idx += gs) { const int pos = idx >> 4, i = idx & 15; const float fr = powf(10000.f, -(float)i / 16.f); float s, c; sincosf((float)pos * fr, &s, &c); ((float2*)(ws + WS_ROPE))[idx] = make_float2(c, s); }
    for (int idx = gt; idx < 128 * 33 * 64; idx += gs) { const int pp = idx & 63, m = (idx >> 6) % 33, gd = idx / (64 * 33), g = gd >> 1, dir = gd & 1;
        const float lre = p.lam_re[dir * 4096 + g * 64 + pp], lim = p.lam_im[dir * 4096 + g * 64 + pp], dt = expf(p.log_dt[dir * 64 + g]);
        const float mag = expf(lre * dt * (float)m); float s, c; sincosf(lim * dt * (float)m, &s, &c); ((float2*)(ws + WS_PW))[idx] = make_float2(mag * c, mag * s); }
    for (int idx = gt; idx < 128 * 64 * 16; idx += gs) { const int h = idx & 15, pp = (idx >> 4) & 63, gd = idx >> 10, g = gd >> 1, dir = gd & 1;
        const float lre = p.lam_re[dir * 4096 + g * 64 + pp], lim = p.lam_im[dir * 4096 + g * 64 + pp], dt = expf(p.log_dt[dir * 64 + g]);
        const float mag = expf(lre * dt); float s, c; sincosf(lim * dt, &s, &c); const float xr = mag * c - 1.f, xi = mag * s, den = lre * lre + lim * lim;
        const float qr = (xr * lre + xi * lim) / den, qi = (xi * lre - xr * lim) / den; const float br = p.b_re[(g * 64 + pp) * 16 + h], bi = p.b_im[(g * 64 + pp) * 16 + h];
        ((float2*)(ws + WS_BB))[idx] = make_float2(qr * br - qi * bi, qr * bi + qi * br); }
}

__device__ __forceinline__ void normmod_phase(const P& p, int layer, int tok_lo, int tok_hi, int blk0, int nblk) {
    const int tid = tid_l(); const int lane = tid & 63, w = tid >> 6;
    const float* xc = (const float*)(p.ws + WS_XC); const float* mod = (const float*)(p.ws + WS_MOD) + (size_t)layer * 17 * 3072;
    bf16_t* H = (bf16_t*)(p.ws + WS_H); const float* ng = p.norm_g + layer * 1024;
    for (int tok = tok_lo + (blockIdx.x - blk0) * 8 + w; tok < tok_hi; tok += nblk * 8) {
        const int b = tok / 2304, j = tok - b * 2304; const bool isc = j < 256;
        const float* src = isc ? (layer == 0 ? p.ctx : xc) + (size_t)(b * 256 + j) * 1024 : (layer == 0 ? p.x : p.out) + (size_t)(b * 2048 + j - 256) * 1024;
        const float* md = mod + (size_t)(isc ? 16 : b) * 3072;
        const int hrow = layer == 0 ? tok : (isc ? 32768 + b * 256 + j : b * 2048 + j - 256);
        float4 v[4]; float ss = 0.f;
#pragma unroll
        for (int m = 0; m < 4; ++m) { v[m] = *(const float4*)(src + m * 256 + lane * 4); ss += v[m].x * v[m].x + v[m].y * v[m].y + v[m].z * v[m].z + v[m].w * v[m].w; }
#pragma unroll
        for (int o = 32; o >= 1; o >>= 1) ss += __shfl_xor(ss, o);
        const float rs = rsqrtf(ss * (1.f / 1024.f) + EPSN);
#pragma unroll
        for (int m = 0; m < 4; ++m) { const int col = m * 256 + lane * 4; const float4 g = *(const float4*)(ng + col), sh = *(const float4*)(md + col), sc = *(const float4*)(md + 1024 + col);
            uint2 o; o.x = pk(v[m].x * rs * g.x * (1.f + sc.x) + sh.x, v[m].y * rs * g.y * (1.f + sc.y) + sh.y); o.y = pk(v[m].z * rs * g.z * (1.f + sc.z) + sh.z, v[m].w * rs * g.w * (1.f + sc.w) + sh.w);
            *(uint2*)(H + (size_t)hrow * 1024 + col) = o; }
    }
}

__device__ __forceinline__ void pre_phase(const P& p, int par, int half, unsigned char* lds) {
    const int tid = tid_l() & 255, lane = tid & 63, w = tid >> 6;
    float* sG = (float*)lds;
    bf16_t* sQ = (bf16_t*)(lds + 33792);
    bf16_t* sK = sQ + 32 * 136;
    bf16_t* sT = sK + 32 * 136;
    bf16_t* sAtt = sT + 128 * 40;
    const bf16_t* FB = (const bf16_t*)(p.ws + WS_FEATB); const unsigned short* FF = (const unsigned short*)(p.ws + WS_FEATF);
    const int li = tid >> 3, seg = tid & 7, stride = gridDim.x * 2;
    uint4 nq0, nq1, nk0, nk1, ng00, ng01, ng10, ng11;
#define PRE_DEC(IT) const int chunk = (IT) % 72, t2 = (IT) / 72, head12 = t2 % 12, bl = t2 / 12; const int hgrn = head12 >= 4, head = hgrn ? head12 - 4 : head12; \
        const size_t row = (size_t)bl * 2304 + chunk * 32 + li;
#define PRE_LOAD(IT) { PRE_DEC(IT) const bf16_t* fb_ = FB + row * 6144; const int qo_ = hgrn ? 3072 + head * 128 : head * 128, ko_ = hgrn ? qo_ : 512 + head * 128; \
        nq0 = *(const uint4*)(fb_ + qo_ + seg * 16); nq1 = *(const uint4*)(fb_ + qo_ + seg * 16 + 8); nk0 = *(const uint4*)(fb_ + ko_ + seg * 16); nk1 = *(const uint4*)(fb_ + ko_ + seg * 16 + 8); \
        const unsigned short* f0_ = FF + row * 3072 + (hgrn ? head * 128 : 2048 + head * 128) + seg * 16; const unsigned short* f1_ = f0_ + (hgrn ? 1024 : 512); \
        ng00 = *(const uint4*)(f0_); ng01 = *(const uint4*)(f0_ + 8); ng10 = *(const uint4*)(f1_); ng11 = *(const uint4*)(f1_ + 8); }
    int it = blockIdx.x * 2 + half;
    if (it < 1728) PRE_LOAD(it)
    for (; it < 1728; it += stride) {
        PRE_DEC(it)
        const bf16_t* fb = FB + row * 6144;
        float q[16], kk_[16], g0[16], g1[16];
        unpack8(nq0, q); unpack8(nq1, q + 8); unpack8(nk0, kk_); unpack8(nk1, kk_ + 8);
        unpackh8(ng00, g0); unpackh8(ng01, g0 + 8); unpackh8(ng10, g1); unpackh8(ng11, g1 + 8);
        float kh0[16], kh1[16];
#pragma unroll
        for (int e = 0; e < 16; ++e) { kh0[e] = 0.f; kh1[e] = 0.f; }
        if (hgrn) {
            const float* lbp = (const float*)(p.ws + WS_LB) + head * 128 + seg * 16;
#pragma unroll
            for (int e4 = 0; e4 < 4; ++e4) { const float4 l0 = *(const float4*)(lbp + e4 * 4), l1 = *(const float4*)(lbp + 1024 + e4 * 4); const float la[4] = {l0.x, l0.y, l0.z, l0.w}, lc[4] = {l1.x, l1.y, l1.z, l1.w};
#pragma unroll
                for (int r = 0; r < 4; ++r) { const int e = e4 * 4 + r; const float f0 = la[r] + (1.f - la[r]) * rcpf_(1.f + __expf(-g0[e])), f1 = lc[r] + (1.f - lc[r]) * rcpf_(1.f + __expf(-g1[e]));
                    kh0[e] = 1.f - f0; kh1[e] = 1.f - f1; g0[e] = __logf(f0); g1[e] = __logf(f1); } }
        } else {
#pragma unroll
            for (int e = 0; e < 16; ++e) { g0[e] = (fminf(g0[e], 0.f) - __logf(1.f + __expf(-fabsf(g0[e])))) * 0.0625f; g1[e] = (fminf(g1[e], 0.f) - __logf(1.f + __expf(-fabsf(g1[e])))) * 0.0625f; }
        }
        { const int nx = it + stride < 1728 ? it + stride : it; PRE_LOAD(nx) }
#pragma unroll
        for (int e = 0; e < 4; ++e) { *(float4*)(sG + li * 132 + seg * 16 + e * 4) = make_float4(g0[4 * e], g0[4 * e + 1], g0[4 * e + 2], g0[4 * e + 3]);
            *(float4*)(sG + 32 * 132 + li * 132 + seg * 16 + e * 4) = make_float4(g1[4 * e], g1[4 * e + 1], g1[4 * e + 2], g1[4 * e + 3]); }
        __syncthreads();
        { float* pl = sG + (tid >> 7) * 32 * 132 + (tid & 127); float a = 0.f;
#pragma unroll
            for (int i = 0; i < 32; ++i) { a += pl[i * 132]; pl[i * 132] = a; } }
        __syncthreads();
#pragma unroll
        for (int dir = 0; dir < 2; ++dir) {
            const int hd = hgrn ? 8 + head * 2 + dir : head * 2 + dir;
            const size_t hb = ((size_t)(bl * 24 + hd) * 72 + chunk);
            float g[16];
#pragma unroll
            for (int e = 0; e < 16; ++e) g[e] = dir ? g1[e] : g0[e];
            {
                unsigned oq[8], ok[8];
                float Pv[16], PLv[16];
                const float* sGd = sG + dir * 32 * 132;
#pragma unroll
                for (int e4 = 0; e4 < 4; ++e4) { const float4 a4 = *(const float4*)(sGd + li * 132 + seg * 16 + e4 * 4), b4 = *(const float4*)(sGd + 31 * 132 + seg * 16 + e4 * 4);
                    Pv[4 * e4] = a4.x; Pv[4 * e4 + 1] = a4.y; Pv[4 * e4 + 2] = a4.z; Pv[4 * e4 + 3] = a4.w; PLv[4 * e4] = b4.x; PLv[4 * e4 + 1] = b4.y; PLv[4 * e4 + 2] = b4.z; PLv[4 * e4 + 3] = b4.w; }
                bf16_t* qd_g = (bf16_t*)(p.ws + WS_QD) + hb * 4096 + li * 128 + (seg >> 1) * 32 + (seg & 1) * 4;
#pragma unroll
                for (int e = 0; e < 16; e += 2) {
                    float qd[2], ki[2];
#pragma unroll
                    for (int u = 0; u < 2; ++u) { const float Pi = Pv[e + u], PL = PLv[e + u];
                        const float bc = dir ? PL - Pi + g[e + u] : Pi; const float kv = hgrn ? (dir ? kh1[e + u] : kh0[e + u]) : kk_[e + u];
                        qd[u] = q[e + u] * __expf(bc); ki[u] = kv * __expf(fminf(-bc, 87.f)); const float ktl = kv * __expf(PL - bc);
                        sT[((e + u) * 8 + seg) * 40 + li] = f2bf(ktl);
                        if (li == 31) ((float*)(p.ws + WS_DEC))[hb * 128 + seg * 16 + e + u] = __expf(PL); }
                    oq[e >> 1] = pk(qd[0], qd[1]); ok[e >> 1] = pk(ki[0], ki[1]);
                }
                *(uint4*)(sQ + li * 136 + seg * 16) = make_uint4(oq[0], oq[1], oq[2], oq[3]); *(uint4*)(sQ + li * 136 + seg * 16 + 8) = make_uint4(oq[4], oq[5], oq[6], oq[7]);
                *(uint4*)(sK + li * 136 + seg * 16) = make_uint4(ok[0], ok[1], ok[2], ok[3]); *(uint4*)(sK + li * 136 + seg * 16 + 8) = make_uint4(ok[4], ok[5], ok[6], ok[7]);
#pragma unroll
                for (int qg = 0; qg < 4; ++qg) *(uint2*)(qd_g + qg * 8) = make_uint2(oq[qg * 2], oq[qg * 2 + 1]);
            }
            __syncthreads();
            {
                const int ti = w >> 1, tj = w & 1; f32x4 a = (f32x4){0.f, 0.f, 0.f, 0.f};
                if (dir ? !(ti == 1 && tj == 0) : !(ti == 0 && tj == 1)) {
#pragma unroll
                    for (int kk = 0; kk < 4; ++kk) { const bf16x8 A = as8(*(const uint4*)(sQ + (ti * 16 + (lane & 15)) * 136 + kk * 32 + (lane >> 4) * 8)); const bf16x8 B = as8(*(const uint4*)(sK + (tj * 16 + (lane & 15)) * 136 + kk * 32 + (lane >> 4) * 8)); a = MFMA(A, B, a); }
                }
#pragma unroll
                for (int r = 0; r < 4; ++r) { const int c = ti * 16 + (lane >> 4) * 4 + r, s2 = tj * 16 + (lane & 15); const bool keep = dir ? (s2 >= c) : (s2 <= c); sAtt[c * 40 + s2] = f2bf(keep ? a[r] : 0.f); }
            }
            __syncthreads();
            {
                const int d = tid >> 1, part = tid & 1; bf16_t* kt_g = (bf16_t*)(p.ws + WS_KTT) + hb * 4096 + d * 32 + part * 16;
                const int dr = (d & 15) * 8 + (d >> 4);
                *(uint4*)kt_g = *(const uint4*)(sT + dr * 40 + part * 16); *(uint4*)(kt_g + 8) = *(const uint4*)(sT + dr * 40 + part * 16 + 8);
                if (tid < 128) { const int r = tid >> 2, pt = tid & 3; *(uint4*)((bf16_t*)(p.ws + WS_ATT) + hb * 1024 + r * 32 + pt * 8) = *(const uint4*)(sAtt + r * 40 + pt * 8); }
            }
            if (dir == 0) __syncthreads();
        }
    }
#undef PRE_DEC
#undef PRE_LOAD
}

__device__ __forceinline__ void seq_block(const P& p, int par, int blk, unsigned char* lds) {
    const int tid = tid_l(), lane = tid & 63, w = tid >> 6, fr = lane & 15, fq = lane >> 4;
    int bl, hd, vcol0;
    if (blk < 32) { bl = blk >> 4; hd = (blk >> 1) & 7; vcol0 = (hd >> 1) * 256 + (blk & 1) * 128; } else { const int b2 = blk - 32; bl = b2 >> 4; hd = 8 + (b2 & 15); vcol0 = 1024 + ((hd - 8) >> 1) * 128; }
    const int dir = hd & 1, vcol = vcol0 + w * 16;
    bf16_t* O = (bf16_t*)(p.ws + (dir ? WS_OB : WS_OF) + (size_t)par * OBUF);
    const size_t hb = (size_t)(bl * 24 + hd) * 72;
    const size_t QDo = WS_QD + hb * 8192, KTo = WS_KTT + hb * 8192, ATo = WS_ATT + hb * 2048, DCo = WS_DEC + hb * 512, VTo = (par ? WS_VTT1 : WS_VTT) + (size_t)bl * 72 * 131072;
    const char* wsb = (const char*)p.ws;
    const size_t o0 = QDo + ((((w >> 2) * 16 + fr) * 128 + (w & 3) * 32 + fq * 8) * 2);
    const size_t o1 = w < 2 ? ATo + (((w * 16 + fr) * 32 + fq * 8) * 2) : KTo + ((((w - 2) * 16 + fr) * 32 + fq * 8) * 2);
    const size_t o2 = w < 2 ? KTo + ((((w + 6) * 16 + fr) * 32 + fq * 8) * 2) : DCo + (lane & 31) * 16;
    const size_t o3 = VTo + (((vcol + fr) * 32 + fq * 8) * 2);
    const char* b0 = wsb + o0; const char* b1 = wsb + o1; const char* b2 = wsb + o2; const char* b3 = wsb + o3;
    const unsigned s0 = 8192, s1 = w < 2 ? 2048u : 8192u, s2 = w < 2 ? 8192u : 512u, s3 = 131072;
    const int id0 = w, id1 = w + 8, id2 = w < 3 ? w + 16 : 18, id3 = 19 + w;
    f32x4 S[8];
#pragma unroll
    for (int d = 0; d < 8; ++d) S[d] = (f32x4){0.f, 0.f, 0.f, 0.f};
    uint4 stA0, stA1, stA2, stA3, stB0, stB1, stB2, stB3, stC0, stC1, stC2, stC3, stD0, stD1, stD2, stD3;
#define SQ_CH(CC) (dir ? ((CC) < 8 ? 7 - (CC) : 79 - (CC)) : (CC))
#define SQ_LOAD(ST, CC) { const size_t c_ = (size_t)SQ_CH((CC) < 72 ? (CC) : 71); ST##0 = *(const uint4*)(b0 + c_ * s0); ST##1 = *(const uint4*)(b1 + c_ * s1); ST##2 = *(const uint4*)(b2 + c_ * s2); ST##3 = *(const uint4*)(b3 + c_ * s3); }
#define SQ_STEP(ST, CC) { unsigned char* sl = lds + ((CC) & 1) * 27648; \
        *(uint4*)(sl + id0 * 1024 + lane * 16) = ST##0; *(uint4*)(sl + id1 * 1024 + lane * 16) = ST##1; if (w < 3) *(uint4*)(sl + id2 * 1024 + lane * 16) = ST##2; *(uint4*)(sl + id3 * 1024 + lane * 16) = ST##3; \
        SQ_LOAD(ST, (CC) + 4); \
        __syncthreads(); \
        const int c = SQ_CH(CC); \
        const bf16x8 Bv = as8(*(const uint4*)(sl + id3 * 1024 + lane * 16)); \
        bf16x8 SB[4]; \
        _Pragma("unroll") for (int kk = 0; kk < 4; ++kk) SB[kk] = as8(make_uint4(pk(S[2 * kk][0], S[2 * kk][1]), pk(S[2 * kk][2], S[2 * kk][3]), pk(S[2 * kk + 1][0], S[2 * kk + 1][1]), pk(S[2 * kk + 1][2], S[2 * kk + 1][3]))); \
        _Pragma("unroll") for (int ci = 0; ci < 2; ++ci) { f32x4 o = (f32x4){0.f, 0.f, 0.f, 0.f}; \
            o = MFMA(Bv, as8(*(const uint4*)(sl + (8 + ci) * 1024 + lane * 16)), o); \
            _Pragma("unroll") for (int kk = 0; kk < 4; ++kk) o = MFMA(SB[kk], as8(*(const uint4*)(sl + (ci * 4 + kk) * 1024 + lane * 16)), o); \
            uint2 ov; ov.x = pk(o[0], o[1]); ov.y = pk(o[2], o[3]); \
            *(uint2*)(O + ((size_t)bl * 2304 + c * 32 + ci * 16 + fr) * 2048 + vcol + fq * 4) = ov; } \
        _Pragma("unroll") for (int dt = 0; dt < 8; ++dt) { const f32x4 dcv = *(const f32x4*)(sl + 18 * 1024 + (dt * 4 + fq) * 16); \
            S[dt] = S[dt] * dcv; S[dt] = MFMA(as8(*(const uint4*)(sl + (10 + dt) * 1024 + lane * 16)), Bv, S[dt]); } }
    SQ_LOAD(stA, 0); SQ_LOAD(stB, 1); SQ_LOAD(stC, 2); SQ_LOAD(stD, 3);
    __syncthreads();
    for (int cc = 0; cc < 72; cc += 4) { SQ_STEP(stA, cc); SQ_STEP(stB, cc + 1); SQ_STEP(stC, cc + 2); SQ_STEP(stD, cc + 3); }
    __syncthreads();
#undef SQ_CH
#undef SQ_LOAD
#undef SQ_STEP
}

__device__ __forceinline__ void gatenorm_phase(const P& p, int par) {
    const int tid = tid_l(); const int lane = tid & 63, w = tid >> 6;
    bf16_t* OF = (bf16_t*)(p.ws + WS_OF + (size_t)par * OBUF); const bf16_t* OB = (const bf16_t*)(p.ws + WS_OB + (size_t)par * OBUF); const bf16_t* GT = (const bf16_t*)(p.ws + WS_GATES + (size_t)par * OBUF);
    for (int r = blockIdx.x * 8 + w; r < GROWS; r += gridDim.x * 8) {
#pragma unroll
        for (int m = 0; m < 4; ++m) { const int col = m * 512 + lane * 8;
            float a[8], b[8], gt[8]; unpack8(*(const uint4*)(OF + (size_t)r * 2048 + col), a); unpack8(*(const uint4*)(OB + (size_t)r * 2048 + col), b);
            unpack8(*(const uint4*)(GT + (size_t)r * 2048 + col), gt);
            float ss = 0.f;
#pragma unroll
            for (int e = 0; e < 8; ++e) { a[e] += b[e]; ss += a[e] * a[e]; }
            ss += __shfl_xor(ss, 1); ss += __shfl_xor(ss, 2); ss += __shfl_xor(ss, 4); ss += __shfl_xor(ss, 8);
            float rs; const float* gw;
            if (m < 2) { ss += __shfl_xor(ss, 16); rs = rsqrtf(ss * (1.f / 256.f) + EPSN); gw = p.gla_g + (col & 255); } else { rs = rsqrtf(ss * (1.f / 128.f) + EPSN); gw = p.hg_g + (col & 127); }
            unsigned o[4];
#pragma unroll
            for (int e = 0; e < 8; e += 2) o[e >> 1] = pk(a[e] * rs * gw[e] * siluf_(gt[e]), a[e + 1] * rs * gw[e + 1] * siluf_(gt[e + 1]));
            *(uint4*)(OF + (size_t)r * 2048 + col) = make_uint4(o[0], o[1], o[2], o[3]); }
    }
}

#define DPPF(V, CTRL) __builtin_bit_cast(float, __builtin_amdgcn_update_dpp(0, __builtin_bit_cast(int, (V)), (CTRL), 0xF, 0xF, false))
DEV float rowmax16(float v) { v = fmaxf(v, DPPF(v, 0xB1)); v = fmaxf(v, DPPF(v, 0x4E)); v = fmaxf(v, DPPF(v, 0x124)); v = fmaxf(v, DPPF(v, 0x128)); return v; }
DEV float rowsum16(float v) { v += DPPF(v, 0xB1); v += DPPF(v, 0x4E); v += DPPF(v, 0x124); v += DPPF(v, 0x128); return v; }
__device__ __forceinline__ void attn_item(const P& p, int item, unsigned char* lds) {
    const int tid = tid_l() & 255, lane = tid & 63, w = tid >> 6, fr = lane & 15, fq = lane >> 4;
    bf16_t* sKb = (bf16_t*)lds;
    bf16_t* sVb = sKb + 2 * 64 * 72;
    bf16_t* FL = (bf16_t*)(p.ws + WS_F2L);
    const int nb = (item >> 1) & 15, hq = ((item >> 5) & 7) * 2 + (item & 1), b = item >> 8, kv = hq >> 2;
    const float sinkv = p.sink[hq] * 1.4426950408889634f;
    const size_t qrow0 = (size_t)b * 2048 + nb * 128 + w * 32;
    bf16x8 qf[2][2];
#pragma unroll
    for (int rt = 0; rt < 2; ++rt)
#pragma unroll
        for (int kk = 0; kk < 2; ++kk) qf[rt][kk] = as8(*(const uint4*)(FL + (qrow0 + rt * 16 + fr) * F2LD + QOFF + hq * 64 + kk * 32 + fq * 8));
    float mrow[2], lrow[2]; f32x4 o[2][4];
#pragma unroll
    for (int rt = 0; rt < 2; ++rt) { mrow[rt] = sinkv; lrow[rt] = fq == 0 ? 1.f : 0.f;
#pragma unroll
        for (int dt = 0; dt < 4; ++dt) o[rt][dt] = (f32x4){0.f, 0.f, 0.f, 0.f}; }
    const int bt_lo = nb == 0 ? 2 : 0, ntile = 4 + ((nb == 15 ? 3 : 5) - bt_lo + 1);
    uint4 rk0, rk1, rv0, rv1;
#define AT_LOAD(T) { const int t_ = (T) < ntile ? (T) : ntile - 1; const bool cx_ = t_ < 4; const int kp_ = (nb - 1) * 128 + (bt_lo + t_ - 4) * 64; \
        const size_t ro_ = cx_ ? F2C_DELTA + (size_t)(b * 256 + t_ * 64) * F2CLD : (size_t)(b * 2048 + kp_) * F2LD; const int ld_ = cx_ ? F2CLD : F2LD; \
        const bf16_t* kp0_ = FL + ro_ + kv * 64 + (size_t)(tid >> 3) * ld_ + (tid & 7) * 8; \
        rk0 = *(const uint4*)(kp0_ + KOFF); rk1 = *(const uint4*)(kp0_ + (size_t)32 * ld_ + KOFF); \
        const bf16_t* vp0_ = FL + ro_ + kv * 64 + VOFF + (size_t)(tid & 63) * ld_ + (tid >> 6) * 16;     \
        rv0 = *(const uint4*)vp0_; rv1 = *(const uint4*)(vp0_ + 8); }
#define AT_STAGE(BUF) { bf16_t* sK = sKb + (BUF) * 64 * 72; bf16_t* sVT = sVb + (BUF) * 64 * 72; const int key = tid >> 3, ds = (tid & 7) * 8; \
        *(uint4*)(sK + key * 72 + ds) = rk0; *(uint4*)(sK + (key + 32) * 72 + ds) = rk1; \
        const unsigned vw0[4] = {rv0.x, rv0.y, rv0.z, rv0.w}; const unsigned vw1[4] = {rv1.x, rv1.y, rv1.z, rv1.w}; \
        const int vk = tid & 63, vd = (tid >> 6) * 16; \
        _Pragma("unroll") for (int e2 = 0; e2 < 4; ++e2) { sVT[(vd + 2 * e2) * 72 + vk] = (bf16_t)(vw0[e2] & 0xffffu); sVT[(vd + 2 * e2 + 1) * 72 + vk] = (bf16_t)(vw0[e2] >> 16); \
            sVT[(vd + 8 + 2 * e2) * 72 + vk] = (bf16_t)(vw1[e2] & 0xffffu); sVT[(vd + 8 + 2 * e2 + 1) * 72 + vk] = (bf16_t)(vw1[e2] >> 16); } }
    __syncthreads();
    AT_LOAD(0); AT_STAGE(0); AT_LOAD(1);
    __syncthreads();
    for (int tile = 0; tile < ntile; ++tile) {
        const bool masked = tile >= 4; const int kpos0 = (nb - 1) * 128 + (bt_lo + tile - 4) * 64;
        if (tile + 1 < ntile) AT_STAGE((tile + 1) & 1);
        AT_LOAD(tile + 2);
        const bf16_t* sK = sKb + (tile & 1) * 64 * 72; const bf16_t* sVT = sVb + (tile & 1) * 64 * 72;
        f32x4 s[2][4];
#pragma unroll
        for (int kt = 0; kt < 4; ++kt) { const bf16x8 K0 = as8(*(const uint4*)(sK + (kt * 16 + fr) * 72 + fq * 8)), K1 = as8(*(const uint4*)(sK + (kt * 16 + fr) * 72 + 32 + fq * 8));
#pragma unroll
            for (int rt = 0; rt < 2; ++rt) { f32x4 a = (f32x4){0.f, 0.f, 0.f, 0.f}; a = MFMA(K0, qf[rt][0], a); a = MFMA(K1, qf[rt][1], a); s[rt][kt] = a; } }
        const int q0w = nb * 128 + w * 32;
        if (masked && (kpos0 < q0w + 31 - 128 || kpos0 + 63 > q0w + 128)) {
#pragma unroll
            for (int rt = 0; rt < 2; ++rt)
#pragma unroll
                for (int kt = 0; kt < 4; ++kt)
#pragma unroll
                    for (int r = 0; r < 4; ++r) { const int qpos = nb * 128 + w * 32 + rt * 16 + fr, kpos = kpos0 + kt * 16 + fq * 4 + r; const int d = qpos - kpos; if (d > 128 || d < -128) s[rt][kt][r] = -1e30f; }
        }
        bf16x8 PB[2][2];
#pragma unroll
        for (int rt = 0; rt < 2; ++rt) {
            float mx = -1e30f;
#pragma unroll
            for (int kt = 0; kt < 4; ++kt) mx = fmaxf(mx, fmaxf(fmaxf(s[rt][kt][0], s[rt][kt][1]), fmaxf(s[rt][kt][2], s[rt][kt][3])));
            mx = fmaxf(mx, __shfl_xor(mx, 16)); mx = fmaxf(mx, __shfl_xor(mx, 32));
            const float mn = fmaxf(mrow[rt], mx), alpha = __builtin_amdgcn_exp2f(mrow[rt] - mn); mrow[rt] = mn; float ps = 0.f;
            float pv[4][4];
#pragma unroll
            for (int kt = 0; kt < 4; ++kt)
#pragma unroll
                for (int r = 0; r < 4; ++r) { pv[kt][r] = __builtin_amdgcn_exp2f(s[rt][kt][r] - mn); ps += pv[kt][r]; }
            lrow[rt] = lrow[rt] * alpha + ps;
#pragma unroll
            for (int kp = 0; kp < 2; ++kp) PB[rt][kp] = as8(make_uint4(pk(pv[2 * kp][0], pv[2 * kp][1]), pk(pv[2 * kp][2], pv[2 * kp][3]), pk(pv[2 * kp + 1][0], pv[2 * kp + 1][1]), pk(pv[2 * kp + 1][2], pv[2 * kp + 1][3])));
#pragma unroll
            for (int dt = 0; dt < 4; ++dt) o[rt][dt] = o[rt][dt] * alpha;
        }
#pragma unroll
        for (int dt = 0; dt < 4; ++dt)
#pragma unroll
            for (int kp = 0; kp < 2; ++kp) { const bf16_t* vp = sVT + (dt * 16 + fr) * 72 + kp * 32 + fq * 4; const uint2 v0 = *(const uint2*)vp, v1 = *(const uint2*)(vp + 16);
                const bf16x8 VA = as8(make_uint4(v0.x, v0.y, v1.x, v1.y));
#pragma unroll
                for (int rt = 0; rt < 2; ++rt) o[rt][dt] = MFMA(VA, PB[rt][kp], o[rt][dt]); }
        __syncthreads();
    }
#undef AT_LOAD
#undef AT_STAGE
#pragma unroll
    for (int rt = 0; rt < 2; ++rt) { float l = lrow[rt]; l += __shfl_xor(l, 16); l += __shfl_xor(l, 32); const float inv = 1.f / l;
        bf16_t* rp = FL + (qrow0 + rt * 16 + fr) * F2LD;
#pragma unroll
        for (int dt = 0; dt < 4; ++dt) { const int d = hq * 64 + dt * 16 + fq * 4; const uint2 gg = *(const uint2*)(rp + GATT + d);
            uint2 ov; ov.x = pk(o[rt][dt][0] * inv * siluf_(bflo(gg.x)), o[rt][dt][1] * inv * siluf_(bfhi(gg.x))); ov.y = pk(o[rt][dt][2] * inv * siluf_(bflo(gg.y)), o[rt][dt][3] * inv * siluf_(bfhi(gg.y)));
            *(uint2*)(rp + QOFF + d) = ov; } }
}

__device__ __forceinline__ void s5tab_phase(const P& p) {
    unsigned char* ws = p.ws; const int gt = blockIdx.x * NTHR + tid_l(), gs = gridDim.x * NTHR;
    const float2* PW = (const float2*)(ws + WS_PW); const float2* BB = (const float2*)(ws + WS_BB);
    for (int idx = gt; idx < 128 * 64; idx += gs) ((float2*)(ws + WS_A32))[idx] = PW[((idx >> 6) * 33 + 32) * 64 + (idx & 63)];
    bf16_t* WX = (bf16_t*)(ws + WS_WX);
    for (int i8 = gt; i8 < 128 * 128 * 512 / 8; i8 += gs) { const int idx = i8 * 8;
        const int k = idx & 511, pc = (idx >> 9) & 127, gd = idx >> 16, pp = pc >> 1, ci = pc & 1, i = k >> 4, h0 = k & 15, dir = gd & 1;
        const int m = dir ? i : 31 - i; const float2 a = PW[(gd * 33 + m) * 64 + pp]; const float4* bp = (const float4*)(BB + (gd * 64 + pp) * 16 + h0);
        const float4 b0 = bp[0], b1 = bp[1], b2 = bp[2], b3 = bp[3];
#define WXV(BX, BY) (ci ? a.x * (BY) + a.y * (BX) : a.x * (BX) - a.y * (BY))
        *(uint4*)(WX + idx) = make_uint4(pk(WXV(b0.x, b0.y), WXV(b0.z, b0.w)), pk(WXV(b1.x, b1.y), WXV(b1.z, b1.w)), pk(WXV(b2.x, b2.y), WXV(b2.z, b2.w)), pk(WXV(b3.x, b3.y), WXV(b3.z, b3.w)));
#undef WXV
    }
    bf16_t* VT = (bf16_t*)(ws + WS_VT);
    for (int i8 = gt; i8 < 64 * 512 * 256 / 8; i8 += gs) { const int idx = i8 * 8;
        const int kk = idx & 255, col = (idx >> 8) & 511, g = idx >> 17, dir = kk >> 7, pp = (kk >> 1) & 63, t = col >> 4, h = col & 15;
        const int m = dir ? 32 - t : t + 1; const float4* ap = (const float4*)(PW + ((g * 2 + dir) * 33 + m) * 64 + pp); const float4 a0 = ap[0], a1 = ap[1];
        const float4 cr = *(const float4*)(p.c_re + (g * 16 + h) * 64 + pp), cm = *(const float4*)(p.c_im + (g * 16 + h) * 64 + pp);
        *(uint4*)(VT + idx) = make_uint4(pk(cr.x * a0.x - cm.x * a0.y, -(cr.x * a0.y + cm.x * a0.x)), pk(cr.y * a0.z - cm.y * a0.w, -(cr.y * a0.w + cm.y * a0.z)),
                                         pk(cr.z * a1.x - cm.z * a1.y, -(cr.z * a1.y + cm.z * a1.x)), pk(cr.w * a1.z - cm.w * a1.w, -(cr.w * a1.w + cm.w * a1.z)));
    }
    bf16_t* KT2 = (bf16_t*)(ws + WS_KT2);
    for (int i4 = gt; i4 < 64 * 63 * 256 / 4; i4 += gs) { const int idx = i4 * 4;
        const int hp = idx & 15, h = (idx >> 4) & 15, mm = (idx >> 8) % 63, g = idx / (63 * 256); float acc0 = 0.f, acc1 = 0.f, acc2 = 0.f, acc3 = 0.f;
        for (int dir = 0; dir < 2; ++dir) { const int m = dir ? 31 - mm : mm - 31; if (m < 0) continue; const int gd = g * 2 + dir;
            for (int pp = 0; pp < 64; ++pp) { const float2 a = PW[(gd * 33 + m) * 64 + pp]; const float4* bp = (const float4*)(BB + (gd * 64 + pp) * 16 + hp); const float4 b0 = bp[0], b1 = bp[1];
                const float cr = p.c_re[(g * 16 + h) * 64 + pp], cim = p.c_im[(g * 16 + h) * 64 + pp];
                const float er = cr * a.x - cim * a.y, ei = cr * a.y + cim * a.x;
                acc0 += er * b0.x - ei * b0.y; acc1 += er * b0.z - ei * b0.w; acc2 += er * b1.x - ei * b1.y; acc3 += er * b1.z - ei * b1.w; } }
        *(uint2*)(KT2 + idx) = make_uint2(pk(acc0, acc1), pk(acc2, acc3)); }
}

__device__ __forceinline__ void s5scan_phase(const P& p) {
    unsigned* S32 = (unsigned*)(p.ws + WS_S); const float2* A32 = (const float2*)(p.ws + WS_A32);
    for (int idx = blockIdx.x * NTHR + tid_l(); idx < 16 * 64 * 2 * 64; idx += gridDim.x * NTHR) {
        const int pp = idx & 63, dir = (idx >> 6) & 1, g = (idx >> 7) & 63, b = idx >> 13; const float2 a = A32[(g * 2 + dir) * 64 + pp];
        float sr = 0.f, si = 0.f;
        unsigned* base = S32 + ((size_t)(b * 72) * 64 + g) * 128 + dir * 64 + pp;
        for (int i0 = 0; i0 < 72; i0 += 8) {
            unsigned wv[8];
#pragma unroll
            for (int j = 0; j < 8; ++j) { const int i = i0 + j, c = dir ? (i < 8 ? 7 - i : 79 - i) : i; wv[j] = base[(size_t)c * 8192]; }
#pragma unroll
            for (int j = 0; j < 8; ++j) { const int i = i0 + j, c = dir ? (i < 8 ? 7 - i : 79 - i) : i; base[(size_t)c * 8192] = pk(sr, si);
                const float nr = a.x * sr - a.y * si + bflo(wv[j]), ni = a.x * si + a.y * sr + bfhi(wv[j]); sr = nr; si = ni; }
        }
    }
}

__device__ __forceinline__ void final_phase(const P& p) {
    const int tid = tid_l(); const int lane = tid & 63, w = tid >> 6;
    for (int tok = blockIdx.x * 8 + w; tok < 32768; tok += gridDim.x * 8) {
        float* row = p.out + (size_t)tok * 1024; float4 v[4]; float ss = 0.f;
#pragma unroll
        for (int m = 0; m < 4; ++m) { v[m] = *(const float4*)(row + m * 256 + lane * 4); ss += v[m].x * v[m].x + v[m].y * v[m].y + v[m].z * v[m].z + v[m].w * v[m].w; }
#pragma unroll
        for (int o = 32; o >= 1; o >>= 1) ss += __shfl_xor(ss, o);
        const float rs = rsqrtf(ss * (1.f / 1024.f) + EPSN);
#pragma unroll
        for (int m = 0; m < 4; ++m) { const int col = m * 256 + lane * 4; const float4 g = *(const float4*)(p.final_g + col);
            float4 o; o.x = v[m].x * rs * g.x; o.y = v[m].y * rs * g.y; o.z = v[m].z * rs * g.z; o.w = v[m].w * rs * g.w; *(float4*)(row + col) = o; }
    }
}

#define LAS __attribute__((address_space(3)))
#define XB_TMO      128
#define XB_XCNT(j)  (256  + 64 * (j))
#define XB_XSUB(j)  (1280 + 64 * (j))
#define XB_XGEN(j)  (2304 + 64 * (j))
#define XB_TOP      3328
#define XB_TOPGEN   3392
#define XCD_BAR_WORDS 3456
#define XB_SPIN_CAP (1u << 18)

__device__ __forceinline__ unsigned xb_ld(unsigned* p)              { return __hip_atomic_load(p, __ATOMIC_RELAXED, __HIP_MEMORY_SCOPE_AGENT); }
__device__ __forceinline__ unsigned xb_add(unsigned* p, unsigned v) { return __hip_atomic_fetch_add(p, v, __ATOMIC_RELAXED, __HIP_MEMORY_SCOPE_AGENT); }
__device__ __forceinline__ unsigned xb_xcc_id() { return (unsigned)__builtin_amdgcn_s_getreg((3 << 11) | 20) & 0xFu; }
#define XB_SPIN(cond, bar) do { unsigned _sp = 0; while (cond) { __builtin_amdgcn_s_sleep(1); \
    if ((++_sp & 255u) == 0u) { if (xb_ld(&(bar)[XB_TMO])) break; if (_sp > XB_SPIN_CAP) { atomicAdd(&(bar)[XB_TMO], 1u); break; } } } } while (0)

struct XcdBarrier {
    unsigned* bar; unsigned x;
    volatile LAS unsigned* st;
};

__device__ __forceinline__ XcdBarrier xcd_barrier_post(unsigned* bar, volatile LAS unsigned* st) {
    XcdBarrier b; b.bar = bar; b.x = xb_xcc_id(); b.st = st;
    if (threadIdx.x == 0) (void)xb_add(&bar[XB_XCNT(b.x)], 1u);
    return b;
}
__device__ __forceinline__ void xcd_barrier_complete(unsigned* bar, unsigned x, unsigned& nloc, unsigned& nx) {
    const unsigned G = gridDim.x * gridDim.y * gridDim.z;
    unsigned sum, cnt, mine, sp = 0u;
    for (;;) {
        sum = 0u; cnt = 0u; mine = 0u;
#pragma unroll
        for (unsigned j = 0; j < 16; ++j) { const unsigned c = xb_ld(&bar[XB_XCNT(j)]); sum += c; cnt += (c > 0u) ? 1u : 0u; mine = (j == x) ? c : mine; }
        if (sum == G) break;
        __builtin_amdgcn_s_sleep(1);
        if ((++sp & 255u) == 0u) { if (xb_ld(&bar[XB_TMO])) break; if (sp > XB_SPIN_CAP) { atomicAdd(&bar[XB_TMO], 1u); break; } }
    }
    nloc = mine > 0u ? mine : 1u; nx = cnt > 0u ? cnt : 1u;
}

__device__ __forceinline__ void xcd_barrier(const XcdBarrier& b) {
    asm volatile("s_waitcnt vmcnt(0)" ::: "memory");
    __syncthreads();
    if (threadIdx.x == 0) {
        unsigned* bar = b.bar;
        __builtin_amdgcn_s_waitcnt(0);
        unsigned nloc = b.st[0], nx = b.st[1];
        if (nloc == 0u) { xcd_barrier_complete(bar, b.x, nloc, nx); b.st[0] = nloc; b.st[1] = nx; }
        const unsigned old = xb_add(&bar[XB_XSUB(b.x)], 1u);
        const unsigned gen = old / nloc;
        if (old + 1u == (gen + 1u) * nloc) {
            __builtin_amdgcn_fence(__ATOMIC_RELEASE, "agent");
            asm volatile("s_waitcnt vmcnt(0)" ::: "memory");
            const unsigned og = xb_add(&bar[XB_TOP], 1u);
            const unsigned tg = og / nx;
            if (og + 1u == (tg + 1u) * nx) xb_add(&bar[XB_TOPGEN], 1u);
            else XB_SPIN(xb_ld(&bar[XB_TOPGEN]) == tg, bar);
            __builtin_amdgcn_fence(__ATOMIC_ACQUIRE, "agent");
            xb_add(&bar[XB_XGEN(b.x)], 1u);
            asm volatile("s_waitcnt vmcnt(0)" ::: "memory");
        } else {
            XB_SPIN(xb_ld(&bar[XB_XGEN(b.x)]) == gen, bar);
            __builtin_amdgcn_fence(__ATOMIC_ACQUIRE, "agent");
            asm volatile("s_waitcnt vmcnt(0)" ::: "memory");
        }
    }
    __syncthreads();
}

struct ListOrder {
    int nM, nN, nwg, base, step, cnt;
    __device__ void init(int M, int N, int base_, int step_, int cnt_) { nM = M / 256; nN = N / 256; nwg = nM * nN; base = base_; step = step_; cnt = cnt_; }
    __device__ bool next(int i, pg8::Unit& u) const {
        if (i >= cnt) return false; const int L = base + i * step; if (L >= nwg) return false;
        int wgid = L; { const int q = nwg / 8, r = nwg % 8, xcd = wgid % 8, off = wgid / 8; wgid = (xcd < r ? xcd * (q + 1) : r * (q + 1) + (xcd - r) * q) + off; }
        const int nig = 8 * nN, gid = wgid / nig, fm = gid * 8, gsz = (nM - fm) < 8 ? (nM - fm) : 8;
        u.pm = fm + ((wgid % nig) % gsz); u.pn = (wgid % nig) / gsz; return true;
    }
    __device__ __forceinline__ void a_ready(const pg8::Unit&) const {}
    __device__ __forceinline__ void done(const pg8::Unit&) const {}
};
template <class Epi>
__device__ __forceinline__ void run_gemm_list(unsigned char* lds, const bf16_t* A, int lda, const bf16_t* Bt, int M, int N, int K, int base, int step, int cnt, const Epi& ep) {
    pg8::Gemm g{A, Bt, M, N, K, lda}; ListOrder S; S.init(M, N, base, step, cnt);
    pg8::gemm_phase<Epi, ListOrder, true, true>((PG8_LAS unsigned char*)lds, g, S, ep);
}
template <class Epi>
__device__ __forceinline__ void run_gemm(unsigned char* lds, const bf16_t* A, int lda, const bf16_t* Bt, int M, int N, int K, int c, const Epi& ep) {
    pg8::Gemm g{A, Bt, M, N, K, lda}; pg8::StaticOrder S; S.init(M, N, gridDim.x, c);
    pg8::gemm_phase<Epi, pg8::StaticOrder, true, true>((PG8_LAS unsigned char*)lds, g, S, ep);
}

__global__ void __launch_bounds__(NTHR) fwd_megakernel(P p) {
    extern __shared__ __attribute__((aligned(16))) unsigned char lds[];
    cg::grid_group grid = cg::this_grid();
    unsigned char* ws = p.ws;
    const int bid = blockIdx.x, nb = gridDim.x;
#define half (tid_l() >> 8)
#define hl (lds + (tid_l() >> 8) * HALF_LDS)

    volatile LAS unsigned* xst = (volatile LAS unsigned*)((LAS unsigned char*)lds + 2 * HALF_LDS);
    if (threadIdx.x == 0) { xst[0] = 0u; xst[1] = 0u; }
    __syncthreads();
    XcdBarrier xb = xcd_barrier_post((unsigned*)(ws + WS_BAR), xst);
    prep_phase(p, lds);
    grid.sync();
    normmod_phase(p, 0, 0, NTOK, 0, nb);
    xcd_barrier(xb);
    const bf16_t* H0 = (const bf16_t*)(ws + WS_H); const bf16_t* W0 = (const bf16_t*)(ws + WS_WIN0);
    PgA epa{ws, p.gk_b, 0};
    run_gemm(lds, H0, 1024, W0, GROWS, 9216, 1024, bid, epa);
    xcd_barrier(xb);
    pre_phase(p, 0, half, hl);
    xcd_barrier(xb);
    for (int grp = 0; grp < 8; ++grp) {
        const int par = grp & 1;
        if (bid < 64) {
            const int blk = bid < 32 ? 2 * (((bid >> 4) << 3) + (bid & 7)) + ((bid >> 3) & 1) : bid;
            seq_block(p, par, blk, lds); }
        if (grp >= 1) {
            PgC epc{p.x, p.ctx, p.out, (float*)(ws + WS_XC), (const float*)(ws + WS_MOD), grp - 1};
            run_gemm_list(lds, (const bf16_t*)(ws + WS_OF + (size_t)(par ^ 1) * OBUF), 2048, (const bf16_t*)(ws + WS_WOUT0), GROWS, 1024, 2048, bid - 64, 72, (bid >= 64 && bid < 136) ? 1 : 0, epc);
        }
        if (grp < 7) {
            int base, step, cnt;
            if (bid >= 136) { base = bid - 136; step = 120; cnt = 4; } else if (bid >= 64) { base = 480 + bid - 64; step = 72; cnt = 2; } else { base = 624 + bid; step = 64; cnt = bid < 24 ? 1 : 0; }
            epa.par = par ^ 1;
            run_gemm_list(lds, H0 + (size_t)(grp + 1) * GROWS * 1024, 1024, W0, GROWS, 9216, 1024, base, step, cnt, epa);
        }
        xcd_barrier(xb);
        if (grp < 7) pre_phase(p, par ^ 1, half, hl);
        gatenorm_phase(p, par);
        xcd_barrier(xb);
    }
    {
        PgC epc{p.x, p.ctx, p.out, (float*)(ws + WS_XC), (const float*)(ws + WS_MOD), 7};
        run_gemm(lds, (const bf16_t*)(ws + WS_OF + OBUF), 2048, (const bf16_t*)(ws + WS_WOUT0), GROWS, 1024, 2048, bid, epc);
        if (bid >= 72) normmod_phase(p, 1, 0, 7 * GROWS, 72, nb - 72);
    }
    xcd_barrier(xb);
    normmod_phase(p, 1, 7 * GROWS, NTOK, 0, nb);
    s5tab_phase(p);
    xcd_barrier(xb);
    {
        PgB epl{(bf16_t*)(ws + WS_F2L), F2LD, (const float2*)(ws + WS_ROPE), 1}; PgB epc{(bf16_t*)(ws + WS_F2C), F2CLD, (const float2*)(ws + WS_ROPE), 0};
        run_gemm(lds, (const bf16_t*)(ws + WS_H), 1024, (const bf16_t*)(ws + WS_WIN1), 32768, 4608, 1024, bid, epl);
        run_gemm(lds, (const bf16_t*)(ws + WS_H) + (size_t)32768 * 1024, 1024, (const bf16_t*)(ws + WS_WIN1), 4096, 1536, 1024, bid, epc);
    }
    xcd_barrier(xb);
    {
        constexpr int NX = 128 * 9;
        for (int it = bid * 2 + half; it < NX + 4096; it += nb * 2) {
            if (it < NX) {
                int gd = it / 9, tm = it % 9;
                if (nb == 256) { const int li = (it >> 9) * 64 + (((it >> 1) & 255) >> 3) * 2 + (it & 1), gg = ((it >> 1) & 7) * 8 + li / 18, rem = li % 18; gd = gg * 2 + rem / 9; tm = rem % 9; }
                LdS5X al{(const bf16_t*)(ws + WS_F2L), gd >> 1}; LdPlain bl{(const bf16_t*)(ws + WS_WX) + (size_t)gd * 128 * 512, 512};
                EpiS5X ep{(bf16_t*)(ws + WS_S), gd >> 1, gd & 1}; gemm_tile(al, bl, ep, tm * 128, 0, 512, hl); }
            else { int a = it - NX;
                if (nb == 256) {
                    const int t = a + 128, li = (t >> 9) * 64 + (((t >> 1) & 255) >> 3) * 2 + (t & 1) - 16; a = ((((t >> 1) & 7) * 2 + (li >> 8)) << 8) + (li & 255); }
                attn_item(p, a, hl); }
        }
    }
    xcd_barrier(xb);
    s5scan_phase(p);
    xcd_barrier(xb);
    {
        for (int it = bid * 2 + half; it < 64 * 32; it += nb * 2) {
            const int local = ((it >> 4) & 31) * 2 + (it & 1); const int g = (nb == 256) ? (it >> 9) * 16 + ((it >> 1) & 7) * 2 + (local >> 5) : it >> 5;
            const int tile = (nb == 256) ? (local & 31) : (it & 31); const int tm = tile >> 2, tn = tile & 3;
            LdS5YA al{(const bf16_t*)(ws + WS_F2L), (const bf16_t*)(ws + WS_S), g}; LdS5YB bl{(const bf16_t*)(ws + WS_KT2), (const bf16_t*)(ws + WS_VT), g};
            EpiS5Y ep{(const bf16_t*)(ws + WS_F2L), (bf16_t*)(ws + WS_H), p.s5_d, g}; gemm_tile(al, bl, ep, tm * 128, tn * 128, 768, hl); }
    }
    xcd_barrier(xb);
    {
        PgGLU ep{(bf16_t*)(ws + WS_F2L)};
        run_gemm(lds, (const bf16_t*)(ws + WS_H), 1024, (const bf16_t*)(ws + WS_WGLU), 32768, 2048, 1024, bid, ep);
    }
    xcd_barrier(xb);
    {
        PgD ep{p.out, (const float*)(ws + WS_MOD) + 17 * 3072};
        run_gemm(lds, (const bf16_t*)(ws + WS_F2L) + QOFF, F2LD, (const bf16_t*)(ws + WS_WOUT1), 32768, 1024, 2048, bid, ep);
    }
    xcd_barrier(xb);
    final_phase(p);
#undef half
#undef hl
}

extern "C" void kernel_launch(void* const* d_in, const int* in_sizes, int n_in, void* d_out, int out_size, void* d_ws, size_t ws_size, hipStream_t stream) {
    static int grid_blocks = 0;
    if (grid_blocks == 0) {
        if (ws_size < WS_TOTAL) { fprintf(stderr, "kernel_launch: workspace too small: %zu < %zu\n", ws_size, (size_t)WS_TOTAL); grid_blocks = -1; return; }
        int dev = 0, cus = 0, per_cu = 0;
        (void)hipGetDevice(&dev);
        (void)hipDeviceGetAttribute(&cus, hipDeviceAttributeMultiprocessorCount, dev);
        (void)hipFuncSetAttribute((const void*)fwd_megakernel, hipFuncAttributeMaxDynamicSharedMemorySize, LDS_BYTES);
        (void)hipOccupancyMaxActiveBlocksPerMultiprocessor(&per_cu, (const void*)fwd_megakernel, NTHR, LDS_BYTES);
        if (per_cu < 1) { fprintf(stderr, "kernel_launch: occupancy query reports %d blocks/CU\n", per_cu); per_cu = 1; }
        grid_blocks = cus;
    }
    if (grid_blocks < 0) return;
    P p{};
    const float** pp = (const float**)&p;
    for (int i = 0; i < 27; ++i) pp[i] = (const float*)d_in[i];
    p.out = (float*)d_out; p.ws = (unsigned char*)d_ws;
    (void)hipMemsetAsync((unsigned char*)d_ws + WS_BAR, 0, 16384, stream);
    void* args[] = {&p};
    hipError_t e = hipLaunchCooperativeKernel((void*)fwd_megakernel, dim3(grid_blocks), dim3(NTHR), args, LDS_BYTES, stream);
    if (e != hipSuccess) fprintf(stderr, "cooperative launch failed: %s (grid %d)\n", hipGetErrorString(e), grid_blocks);
}
```

```cpp
#include <hip/hip_runtime.h>
#include <hip/hip_cooperative_groups.h>
#include <cstdio>
#include <cstdint>
namespace cg = cooperative_groups;

typedef unsigned short bf16_t;
typedef short bf16x8 __attribute__((ext_vector_type(8)));
typedef float f32x4 __attribute__((ext_vector_type(4)));

#define MFMA(a, b, c) __builtin_amdgcn_mfma_f32_16x16x32_bf16(a, b, c, 0, 0, 0)
#define DEV __device__ __forceinline__

constexpr int NTOK = 36864;
constexpr int GROWS = 4608;
constexpr int HALF_LDS = 73728;
constexpr int LDS_BYTES = 2 * HALF_LDS + 64;
constexpr int NTHR = 512;
constexpr float EPSN = 1e-6f;
constexpr int KOFF = 0, VOFF = 256, UOFF = 512, GATT = 1536, QOFF = 2560, GS5 = 3584, F2LD = 4608, F2CLD = 1536;

constexpr size_t WS_WIN1 = 0;
constexpr size_t WS_WGLU = WS_WIN1 + 9437184;
constexpr size_t WS_WOUT1 = WS_WGLU + 4194304;
constexpr size_t WS_XC = WS_WOUT1 + 4194304;
constexpr size_t WS_MOD = WS_XC + 16777216;
constexpr size_t WS_LB = WS_MOD + 417792;
constexpr size_t WS_ROPE = WS_LB + 8192;
constexpr size_t WS_A32 = WS_ROPE + 8192;
constexpr size_t WS_PW = WS_A32 + 65536;
constexpr size_t WS_BB = WS_PW + 2162688;
constexpr size_t WS_R1 = WS_BB + 1048576;
constexpr size_t WS_WIN0 = WS_R1;
constexpr size_t WS_WOUT0 = WS_WIN0 + 18874368;
constexpr size_t WS_WX = WS_R1;
constexpr size_t WS_KT2 = WS_WX + 16777216;
constexpr size_t WS_VT = WS_KT2 + 2064384;
constexpr size_t WS_H = WS_R1 + 35618816;
constexpr size_t WS_S = WS_H + 75497472;
constexpr size_t WS_R3 = WS_S + 37748736;
constexpr size_t WS_FEATB = WS_R3;
constexpr size_t WS_FEATF = WS_FEATB + 56623104;
constexpr size_t WS_QD = WS_FEATF + 56623104;
constexpr size_t WS_KTT = WS_QD + 28311552;
constexpr size_t WS_ATT = WS_KTT + 28311552;
constexpr size_t WS_DEC = WS_ATT + 7077888;
constexpr size_t WS_VTT = WS_DEC + 1769472;
constexpr size_t WS_GATES = WS_VTT + 18874368;
constexpr size_t WS_OF = WS_GATES + 37748736;
constexpr size_t WS_OB = WS_OF + 37748736;
constexpr size_t WS_VTT1 = WS_FEATF + 28311552;
constexpr size_t OBUF = 18874368;
static_assert(WS_OB + 37748736 <= WS_R3 + 314572800, "layer-0 buffers overflow region 3");
constexpr size_t WS_F2L = WS_R3;
constexpr size_t WS_F2C = WS_F2L + 301989888;
constexpr size_t WS_END = WS_F2C + 12582912;
constexpr size_t WS_BAR = WS_END;
constexpr size_t WS_TOTAL = WS_BAR + 16384;
constexpr size_t F2C_DELTA = (WS_F2C - WS_F2L) / 2;

struct P {
    const float *x, *c, *ctx, *c_ctx, *ada_w, *ada_b, *norm_g, *final_g, *ev_w_in, *ev_w_out, *gk_w, *gk_b, *gla_g, *lb_raw, *hg_g,
        *od_w_in, *od_w_out, *sink, *lam_re, *lam_im, *log_dt, *b_re, *b_im, *c_re, *c_im, *s5_d, *glu_w;
    float* out;
    unsigned char* ws;
};

DEV int tid_l() { int t = threadIdx.x; asm volatile("" : "+v"(t)); return t; }
typedef __bf16 bf16v2_t __attribute__((ext_vector_type(2)));
typedef float f32v2_t __attribute__((ext_vector_type(2)));
DEV unsigned pk(float a, float b) { const f32v2_t v = {a, b}; return __builtin_bit_cast(unsigned, __builtin_convertvector(v, bf16v2_t)); }
DEV bf16_t f2bf(float f) { return __builtin_bit_cast(bf16_t, (__bf16)f); }
typedef _Float16 h16v2_t __attribute__((ext_vector_type(2)));
typedef _Float16 h16v8_t __attribute__((ext_vector_type(8)));
DEV unsigned pkh(float a, float b) { const h16v2_t v = {(_Float16)a, (_Float16)b}; return __builtin_bit_cast(unsigned, v); }
DEV void unpackh8(uint4 v, float* f) { const h16v8_t h = __builtin_bit_cast(h16v8_t, v); _Pragma("unroll") for (int e = 0; e < 8; ++e) f[e] = (float)h[e]; }
DEV float bflo(unsigned w) { return __uint_as_float(w << 16); }
DEV float bfhi(unsigned w) { return __uint_as_float(w & 0xffff0000u); }
DEV float bf2f(bf16_t b) { return __uint_as_float((unsigned)b << 16); }
DEV bf16x8 as8(uint4 v) { return __builtin_bit_cast(bf16x8, v); }
DEV float rcpf_(float x) { return __builtin_amdgcn_rcpf(x); }
DEV float sigmoidf_(float x) { return rcpf_(1.f + __expf(-x)); }
DEV float siluf_(float x) { return x * rcpf_(1.f + __expf(-x)); }
DEV float geluf_(float x) { float u = 0.7978845608028654f * (x + 0.044715f * x * x * x); float t = 1.f - 2.f * rcpf_(1.f + __expf(2.f * u)); return 0.5f * x * (1.f + t); }
DEV void unpack8(uint4 v, float* f) { f[0] = bflo(v.x); f[1] = bfhi(v.x); f[2] = bflo(v.y); f[3] = bfhi(v.y); f[4] = bflo(v.z); f[5] = bfhi(v.z); f[6] = bflo(v.w); f[7] = bfhi(v.w); }

namespace pg8 {
#define PG8_LAS __attribute__((address_space(3)))
typedef unsigned short bf16_t;
typedef short bf16x8 __attribute__((ext_vector_type(8)));
typedef float f32x4 __attribute__((ext_vector_type(4)));
typedef unsigned u32x4 __attribute__((ext_vector_type(4)));
constexpr int BM = 256, BK = 64, HALF = 128, HTB = HALF * BK * 2  , STAGE_BYTES = 8 * HTB, NXCD = 8, WGM = 8;

__host__ __device__ __forceinline__ int lds_byte(int r, int c) { const int st = (r >> 4) * 2 + (c >> 5), rr = r & 15, cc = c & 31, ob = rr * 64 + cc * 2; return st * 1024 + (ob ^ (((ob >> 9) & 1) << 5)); }
__host__ __device__ __forceinline__ void stage_rc(int b, int& R, int& C) { const int st = b / 1024, sb = b % 1024, swz = sb ^ (((sb >> 9) & 1) << 5); R = (st >> 1) * 16 + swz / 64; C = (st & 1) * 32 + (swz % 64) / 2; }
__host__ __device__ __forceinline__ int perm32(int rho) { const int n = rho >> 4, i = rho & 15; return 8 * (i >> 2) + 4 * n + (i & 3); }

struct Unit { int pm, pn; };
struct Gemm { const bf16_t* A; const bf16_t* Bt; int M, N, K, lda; };

struct StaticOrder {
    int nM, nN, nwg, G, c;
    __host__ __device__ void init(int M, int N, int G_, int c_) { nM = M / BM; nN = N / BM; nwg = nM * nN; G = G_; c = c_; }
    __host__ __device__ bool next(int i, Unit& u) const {
        const long L = (long)i * G + c; if (L >= nwg) return false;
        int wgid = (int)L; { const int q = nwg / NXCD, r = nwg % NXCD, xcd = wgid % NXCD, off = wgid / NXCD; wgid = (xcd < r ? xcd * (q + 1) : r * (q + 1) + (xcd - r) * q) + off; }
        const int nig = WGM * nN, gid = wgid / nig, fm = gid * WGM, gsz = (nM - fm) < WGM ? (nM - fm) : WGM;
        u.pm = fm + ((wgid % nig) % gsz); u.pn = (wgid % nig) / gsz; return true;
    }
    __device__ __forceinline__ void a_ready(const Unit&) const {}
    __device__ __forceinline__ void done(const Unit&) const {}
};
template <class Epi, class Sched, bool ALIGN_EPI = false, bool SP2 = false>
__device__ __forceinline__ void gemm_phase(PG8_LAS unsigned char* lds, const Gemm g, const Sched& S, const Epi& E) {
    const int tid = tid_l(), wid = __builtin_amdgcn_readfirstlane(tid >> 6), lane = tid & 63, wr = wid >> 2, wc = wid & 3, fr = lane & 15, fq = lane >> 4;
    const int K = g.K, nt = K / BK;
    unsigned voffA[2], voffB[2];
#pragma unroll
    for (int i = 0; i < 2; ++i) { int R, C; stage_rc(tid * 16 + i * 8192, R, C); const int Rb = Epi::PERM ? ((R & ~31) + perm32(R & 31)) : R;
        voffA[i] = (unsigned)(R * g.lda + C) * 2u; voffB[i] = (unsigned)(Rb * K + C) * 2u; }
    const size_t kstep = (size_t)(BK * 2);
    const size_t hstep = (size_t)HALF * K * 2, hstepA = (size_t)HALF * g.lda * 2, tstepA = 2 * hstepA;
    const size_t tstep = 2 * hstep;
    const unsigned ldsw = (unsigned)wid * 1024u;
    const int aoff = lds_byte(wr * 64 + fr, fq * 8), boff = lds_byte(wc * 32 + fr, fq * 8);
#define PG8_SA(b, h) (((b) * 2 + (h)) * HTB)
#define PG8_SB(b, h) ((4 + (b) * 2 + (h)) * HTB)
#define PG8_STAGE(bufoff, gbase, voff) do { _Pragma("unroll") for (int _i = 0; _i < 2; ++_i) \
        __builtin_amdgcn_global_load_lds((const unsigned*)((const char*)(gbase) + (voff)[_i]), (PG8_LAS unsigned*)(lds + (bufoff) + ldsw + _i * 8192), 16, 0, 0); } while (0)
#define PG8_LDA(dst, b, h) do { _Pragma("unroll") for (int m = 0; m < 4; ++m) _Pragma("unroll") for (int k = 0; k < 2; ++k) dst[m][k] = *(const PG8_LAS bf16x8*)(lds + PG8_SA(b, h) + aoff + m * 2048 + k * 1024); } while (0)
#define PG8_LDB(dst, b, h) do { _Pragma("unroll") for (int n = 0; n < 2; ++n) _Pragma("unroll") for (int k = 0; k < 2; ++k) dst[n][k] = *(const PG8_LAS bf16x8*)(lds + PG8_SB(b, h) + boff + n * 2048 + k * 1024); } while (0)
#define PG8_MMA(ai, bj, At, Bt) do { __builtin_amdgcn_s_setprio(1); _Pragma("unroll") for (int m = 0; m < 4; ++m) _Pragma("unroll") for (int n = 0; n < 2; ++n) _Pragma("unroll") for (int k = 0; k < 2; ++k) \
        acc[ai][bj][m][n] = __builtin_amdgcn_mfma_f32_16x16x32_bf16(Bt[n][k], At[m][k], acc[ai][bj][m][n], 0, 0, 0); __builtin_amdgcn_s_setprio(0); } while (0)
#define PG8_WAIT_V(n) asm volatile("s_waitcnt vmcnt(" #n ")" ::: "memory")
#define PG8_WAIT_L(n) asm volatile("s_waitcnt lgkmcnt(" #n ")" ::: "memory")
#define PG8_BAR __builtin_amdgcn_s_barrier()
#define PG8_SCHED __builtin_amdgcn_sched_barrier(0)
    Unit cur, nxt; int ui = 0;
    if (!S.next(0, cur)) return;
    f32x4 acc[2][2][4][2];
#pragma unroll
    for (int a = 0; a < 2; ++a)
#pragma unroll
        for (int b = 0; b < 2; ++b)
#pragma unroll
            for (int m = 0; m < 4; ++m)
#pragma unroll
                for (int n = 0; n < 2; ++n) acc[a][b][m][n] = (f32x4){0.f, 0.f, 0.f, 0.f};
    bf16x8 At[4][2], B0[2][2], B1[2][2];
    const char* cA = (const char*)g.A + (size_t)cur.pm * tstepA; const char* cB = (const char*)g.Bt + (size_t)cur.pn * tstep;
    S.a_ready(cur);
    if constexpr (SP2) {
        PG8_STAGE(PG8_SB(0, 0), cB, voffB); PG8_STAGE(PG8_SB(0, 1), cB + hstep, voffB); PG8_STAGE(PG8_SA(0, 0), cA, voffA); PG8_STAGE(PG8_SA(0, 1), cA + hstepA, voffA);
        if (wr == 1) PG8_BAR;
        PG8_WAIT_V(2); PG8_BAR;
        PG8_STAGE(PG8_SB(1, 0), cB + kstep, voffB); PG8_STAGE(PG8_SA(1, 0), cA + kstep, voffA); PG8_STAGE(PG8_SB(1, 1), cB + hstep + kstep, voffB);
        PG8_WAIT_V(6); PG8_BAR;
    } else {
        PG8_STAGE(PG8_SB(0, 0), cB, voffB); PG8_STAGE(PG8_SA(0, 0), cA, voffA); PG8_STAGE(PG8_SB(0, 1), cB + hstep, voffB); PG8_STAGE(PG8_SA(0, 1), cA + hstepA, voffA);
        if (wr == 1) PG8_BAR;
        PG8_WAIT_V(4); PG8_BAR;
        PG8_STAGE(PG8_SB(1, 0), cB + kstep, voffB); PG8_STAGE(PG8_SA(1, 0), cA + kstep, voffA); PG8_STAGE(PG8_SB(1, 1), cB + hstep + kstep, voffB);
        PG8_WAIT_V(6); PG8_BAR;
    }
    for (;;) {
        const bool has_next = S.next(ui + 1, nxt);
        const char* nA = has_next ? (const char*)g.A + (size_t)nxt.pm * tstepA : cA; const char* nB = has_next ? (const char*)g.Bt + (size_t)nxt.pn * tstep : cB;
        for (int t = 0; t < nt; t += 2) {
            const bool last = (t == nt - 2);
            const char* a1 = cA + (size_t)(t + 1) * kstep;
            const char* a2 = last ? nA : cA + (size_t)(t + 2) * kstep; const char* b2 = last ? nB : cB + (size_t)(t + 2) * kstep;
            const char* a3 = a2 + kstep; const char* b3 = b2 + kstep;
            if (last && has_next) S.a_ready(nxt);
            if constexpr (SP2) {
            PG8_LDB(B0, 0, 0); PG8_LDB(B1, 0, 1); PG8_SCHED; PG8_LDA(At, 0, 0); PG8_STAGE(PG8_SA(1, 1), a1 + hstepA, voffA);
            PG8_WAIT_V(8); PG8_WAIT_L(0); PG8_BAR; PG8_MMA(0, 0, At, B0); PG8_MMA(0, 1, At, B1); PG8_BAR; PG8_SCHED;
            PG8_LDA(At, 0, 1); PG8_STAGE(PG8_SB(0, 0), b2, voffB); PG8_STAGE(PG8_SB(0, 1), b2 + hstep, voffB); PG8_STAGE(PG8_SA(0, 0), a2, voffA);
            PG8_WAIT_V(8); PG8_WAIT_L(0); PG8_BAR; PG8_MMA(1, 0, At, B0); PG8_MMA(1, 1, At, B1); PG8_BAR; PG8_SCHED;
            PG8_LDB(B0, 1, 0); PG8_LDB(B1, 1, 1); PG8_SCHED; PG8_LDA(At, 1, 0); PG8_STAGE(PG8_SA(0, 1), a2 + hstepA, voffA);
            PG8_WAIT_V(8); PG8_WAIT_L(0); PG8_BAR; PG8_MMA(0, 0, At, B0); PG8_MMA(0, 1, At, B1); PG8_BAR; PG8_SCHED;
            PG8_LDA(At, 1, 1); PG8_STAGE(PG8_SB(1, 0), b3, voffB); PG8_STAGE(PG8_SB(1, 1), b3 + hstep, voffB); PG8_STAGE(PG8_SA(1, 0), a3, voffA);
            PG8_WAIT_V(8); PG8_WAIT_L(0); PG8_BAR; PG8_MMA(1, 0, At, B0); PG8_MMA(1, 1, At, B1); PG8_BAR; PG8_SCHED;
            } else {
            PG8_LDB(B0, 0, 0); PG8_SCHED; PG8_LDA(At, 0, 0); PG8_STAGE(PG8_SA(1, 1), a1 + hstepA, voffA);
            PG8_WAIT_L(8); PG8_BAR; PG8_WAIT_L(0); PG8_MMA(0, 0, At, B0); PG8_BAR; PG8_SCHED;
            PG8_LDB(B1, 0, 1); PG8_STAGE(PG8_SB(0, 0), b2, voffB);
            PG8_BAR; PG8_WAIT_L(0); PG8_MMA(0, 1, At, B1); PG8_BAR;
            PG8_LDA(At, 0, 1); PG8_STAGE(PG8_SA(0, 0), a2, voffA);
            PG8_BAR; PG8_WAIT_L(0); PG8_MMA(1, 0, At, B0); PG8_BAR; PG8_SCHED;
            PG8_STAGE(PG8_SB(0, 1), b2 + hstep, voffB);
            PG8_WAIT_V(6); PG8_BAR; PG8_MMA(1, 1, At, B1); PG8_BAR;
            PG8_LDB(B0, 1, 0); PG8_SCHED; PG8_LDA(At, 1, 0); PG8_STAGE(PG8_SA(0, 1), a2 + hstepA, voffA);
            PG8_WAIT_L(8); PG8_BAR; PG8_WAIT_L(0); PG8_MMA(0, 0, At, B0); PG8_BAR; PG8_SCHED;
            PG8_LDB(B1, 1, 1); PG8_STAGE(PG8_SB(1, 0), b3, voffB);
            PG8_BAR; PG8_WAIT_L(0); PG8_MMA(0, 1, At, B1); PG8_BAR;
            PG8_LDA(At, 1, 1); PG8_STAGE(PG8_SA(1, 0), a3, voffA);
            PG8_BAR; PG8_WAIT_L(0); PG8_MMA(1, 0, At, B0); PG8_BAR; PG8_SCHED;
            PG8_STAGE(PG8_SB(1, 1), b3 + hstep, voffB);
            PG8_WAIT_V(6); PG8_BAR; PG8_MMA(1, 1, At, B1); PG8_BAR;
            }
        }
        if constexpr (ALIGN_EPI) { if (wr == 0) PG8_BAR; }
        if constexpr (!Epi::AFTER_DRAIN) { E(acc, cur, wr, wc, fr, fq); S.done(cur); }
        if (!has_next) break;
#pragma unroll
        for (int a = 0; a < 2; ++a)
#pragma unroll
            for (int b = 0; b < 2; ++b)
#pragma unroll
                for (int m = 0; m < 4; ++m)
#pragma unroll
                    for (int n = 0; n < 2; ++n) acc[a][b][m][n] = (f32x4){0.f, 0.f, 0.f, 0.f};
        cur = nxt; cA = nA; cB = nB; ++ui;
        if constexpr (ALIGN_EPI) { if (wr == 1) PG8_BAR; }
    }
    PG8_WAIT_V(0);
    if constexpr (!ALIGN_EPI) { if (wr == 0) PG8_BAR; }
    PG8_BAR;
    if constexpr (Epi::AFTER_DRAIN) { E.fused(acc, cur, wr, wc, fr, fq, lds, wid, lane); S.done(cur); }
#undef PG8_SA
#undef PG8_SB
#undef PG8_STAGE
#undef PG8_LDA
#undef PG8_LDB
#undef PG8_MMA
#undef PG8_WAIT_V
#undef PG8_WAIT_L
#undef PG8_BAR
#undef PG8_SCHED
}
}

template <class AL, class BL, class EP>
__device__ __forceinline__ void gemm_tile(const AL& al, const BL& bl, const EP& ep, int m0, int n0, int K, unsigned char* lds) {
    const int tid = tid_l() & 255, lane = tid & 63, w = tid >> 6, wm = w >> 1, wn = w & 1;
    bf16_t* sA = (bf16_t*)lds;
    bf16_t* sB = sA + 2 * 128 * 72;
    const int lr = tid >> 3, lk = (tid & 7) * 8;
    f32x4 acc[4][4];
#pragma unroll
    for (int i = 0; i < 4; ++i)
#pragma unroll
        for (int j = 0; j < 4; ++j) acc[i][j] = (f32x4){0.f, 0.f, 0.f, 0.f};
    uint4 ra0[4], rb0[4], ra1[4], rb1[4];
#define GLOAD(RA, RB, KT) { const int k_ = (KT) * 64 + lk; _Pragma("unroll") for (int x = 0; x < 4; ++x) { RA[x] = al.load(m0 + lr + 32 * x, k_); RB[x] = bl.load(n0 + lr + 32 * x, k_); } }
#define LSTORE(RA, RB, BUF) { bf16_t* a_ = sA + (BUF) * 128 * 72; bf16_t* b_ = sB + (BUF) * 128 * 72; _Pragma("unroll") for (int x = 0; x < 4; ++x) { *(uint4*)(a_ + (lr + 32 * x) * 72 + lk) = RA[x]; *(uint4*)(b_ + (lr + 32 * x) * 72 + lk) = RB[x]; } }
#define COMPUTE(BUF) { const bf16_t* a_ = sA + (BUF) * 128 * 72; const bf16_t* b_ = sB + (BUF) * 128 * 72; \
        _Pragma("unroll") for (int kh = 0; kh < 2; ++kh) { bf16x8 fw[4], ft[4]; \
            _Pragma("unroll") for (int i = 0; i < 4; ++i) fw[i] = as8(*(const uint4*)(b_ + (wn * 64 + i * 16 + (lane & 15)) * 72 + kh * 32 + (lane >> 4) * 8)); \
            _Pragma("unroll") for (int j = 0; j < 4; ++j) ft[j] = as8(*(const uint4*)(a_ + (wm * 64 + j * 16 + (lane & 15)) * 72 + kh * 32 + (lane >> 4) * 8)); \
            _Pragma("unroll") for (int i = 0; i < 4; ++i) _Pragma("unroll") for (int j = 0; j < 4; ++j) acc[i][j] = MFMA(fw[i], ft[j], acc[i][j]); } }
    const int nk = K >> 6;
    __syncthreads();
    GLOAD(ra0, rb0, 0); GLOAD(ra1, rb1, 1);
    LSTORE(ra0, rb0, 0);
    __syncthreads();
    for (int kt = 0; kt < nk; kt += 2) {
        GLOAD(ra0, rb0, (kt + 2 < nk ? kt + 2 : nk - 1));
        COMPUTE(0);
        LSTORE(ra1, rb1, 1);
        __syncthreads();
        GLOAD(ra1, rb1, (kt + 3 < nk ? kt + 3 : nk - 1));
        COMPUTE(1);
        if (kt + 2 < nk) LSTORE(ra0, rb0, 0);
        __syncthreads();
    }
#undef GLOAD
#undef LSTORE
#undef COMPUTE
    ep(acc, m0 + wm * 64, n0 + wn * 64, lane);
}
DEV void tile_map8(int it, int NT, int& tm, int& tn) { const int x = it & 7, q = it >> 3, c = NT >> 3; tn = x + 8 * (q % c); tm = q / c; }

struct LdPlain { const bf16_t* base; int ld; DEV uint4 load(int row, int k) const { return *(const uint4*)(base + (size_t)row * ld + k); } };
struct LdH1L { const bf16_t* H; DEV uint4 load(int m, int k) const { const int b = m >> 11, t = m & 2047; return *(const uint4*)(H + (size_t)(b * 2304 + 256 + t) * 1024 + k); } };
struct LdH1C { const bf16_t* H; DEV uint4 load(int m, int k) const { const int b = m >> 8, j = m & 255; return *(const uint4*)(H + (size_t)(b * 2304 + j) * 1024 + k); } };
struct LdD { const bf16_t* F; DEV uint4 load(int m, int k) const { const int kk = k < 1024 ? QOFF + k : GS5 + k - 1024; return *(const uint4*)(F + (size_t)m * F2LD + kk); } };
struct LdS5X { const bf16_t* FL; int g;
    DEV uint4 load(int n, int k) const { const int b = n / 72, c = n - b * 72, i = k >> 4, h = k & 15;
        const size_t off = c < 8 ? F2C_DELTA + (size_t)(b * 256 + c * 32 + i) * F2CLD : (size_t)(b * 2048 + (c - 8) * 32 + i) * F2LD;
        return *(const uint4*)(FL + off + UOFF + g * 16 + h); } };
struct LdS5YA { const bf16_t* FL; const bf16_t* S; int g;
    DEV uint4 load(int n, int k) const { const int b = n >> 6, cl = n & 63;
        const bf16_t* p = k < 512 ? FL + (size_t)(b * 2048 + cl * 32 + (k >> 4)) * F2LD + UOFF + g * 16 + (k & 15) : S + ((size_t)(b * 72 + cl + 8) * 64 + g) * 256 + (k - 512);
        return *(const uint4*)p; } };
struct LdS5YB { const bf16_t* KT2; const bf16_t* VT; int g;
    DEV uint4 load(int col, int k) const { const int t = col >> 4, h = col & 15;
        const bf16_t* p = k < 512 ? KT2 + ((size_t)(g * 63 + (t - (k >> 4) + 31)) * 16 + h) * 16 + (k & 15) : VT + ((size_t)g * 512 + col) * 256 + (k - 512);
        return *(const uint4*)p; } };

#define PG_ROWS_COLS(...) \
    _Pragma("unroll") for (int ai = 0; ai < 2; ++ai) _Pragma("unroll") for (int m = 0; m < 4; ++m) { const int row = u.pm * 256 + ai * 128 + wr * 64 + m * 16 + fr; \
        _Pragma("unroll") for (int bj = 0; bj < 2; ++bj) _Pragma("unroll") for (int n = 0; n < 2; ++n) { const int col = u.pn * 256 + bj * 128 + wc * 32 + n * 16 + fq * 4; const f32x4 v = acc[ai][bj][m][n]; __VA_ARGS__ } }
struct PgA {
    static constexpr bool PERM = false, AFTER_DRAIN = false;
    unsigned char* ws; const float* gkb; int par;
    DEV void operator()(const f32x4 (&acc)[2][2][4][2], const pg8::Unit& u, int wr, int wc, int fr, int fq) const {
        bf16_t* featb = (bf16_t*)(ws + WS_FEATB); unsigned short* featf = (unsigned short*)(ws + WS_FEATF);   bf16_t* gates = (bf16_t*)(ws + WS_GATES + (size_t)par * OBUF);
        PG_ROWS_COLS(
            if ((col >= 2048 && col < 3072) || (col >= 7168 && col < 8192)) {
                const int oc = col < 3072 ? col - 2048 : col - 6144;
                uint2 o; o.x = pk(v[0], v[1]); o.y = pk(v[2], v[3]); *(uint2*)(gates + (size_t)row * 2048 + oc) = o;
            } else if ((col >= 1024 && col < 2048) || (col >= 6144 && col < 7168)) {
                const int vc = col < 2048 ? col - 1024 : col - 5120; const int bl_ = row / 2304, j_ = row - bl_ * 2304;
                bf16_t* vt = (bf16_t*)(ws + (par ? WS_VTT1 : WS_VTT)) + (((size_t)(bl_ * 72 + (j_ >> 5)) * 2048 + vc) * 32 + (j_ & 31));
                const unsigned p01 = pk(v[0], v[1]), p23 = pk(v[2], v[3]);
                vt[0] = (bf16_t)(p01 & 0xffffu); vt[32] = (bf16_t)(p01 >> 16); vt[64] = (bf16_t)(p23 & 0xffffu); vt[96] = (bf16_t)(p23 >> 16);
            } else if (col < 4096 || (col >= 6144 && col < 8192)) {
                const float s = col < 512 ? 0.08838834764831845f : 1.f; const int oc = col < 4096 ? col : col - 2048;
                uint2 o; o.x = pk(v[0] * s, v[1] * s); o.y = pk(v[2] * s, v[3] * s); *(uint2*)(featb + (size_t)row * 6144 + oc) = o;
            } else if (col < 6144) {
                const int cc = col - 4096;
                *(uint2*)(featf + (size_t)row * 3072 + cc) = make_uint2(pkh(v[0], v[1]), pkh(v[2], v[3]));
            } else {
                const int cc = col - 8192; const f32x4 bb = *(const f32x4*)(gkb + cc);
                *(uint2*)(featf + (size_t)row * 3072 + 2048 + cc) = make_uint2(pkh(v[0] + bb[0], v[1] + bb[1]), pkh(v[2] + bb[2], v[3] + bb[3]));
            })
    }
};
struct PgC {
    static constexpr bool PERM = false, AFTER_DRAIN = false;
    const float* x; const float* ctx; float* out; float* xc; const float* mod; int grp;
    DEV void operator()(const f32x4 (&acc)[2][2][4][2], const pg8::Unit& u, int wr, int wc, int fr, int fq) const {
        PG_ROWS_COLS(
            const int R = grp * GROWS + row; const int b = R / 2304, jj = R - b * 2304; const bool isc = jj < 256;
            const size_t ro = isc ? (size_t)(b * 256 + jj) * 1024 : (size_t)(b * 2048 + jj - 256) * 1024;
            const f32x4 s = *(const f32x4*)((isc ? ctx : x) + ro + col); const f32x4 gt = *(const f32x4*)(mod + (size_t)(isc ? 16 : b) * 3072 + 2048 + col);
            *(f32x4*)((isc ? xc : out) + ro + col) = s + gt * v; )
    }
};
struct PgB {
    static constexpr bool PERM = false, AFTER_DRAIN = false;
    bf16_t* F; int ld; const float2* rope; int latent;
    DEV void operator()(const f32x4 (&acc)[2][2][4][2], const pg8::Unit& u, int wr, int wc, int fr, int fq) const {
#pragma unroll
        for (int ai = 0; ai < 2; ++ai)
#pragma unroll
            for (int m = 0; m < 4; ++m) { const int row = u.pm * 256 + ai * 128 + wr * 64 + m * 16 + fr; const int t = row & 2047;
#pragma unroll
                for (int bj = 0; bj < 2; ++bj) { const int cb = u.pn * 256 + bj * 128 + wc * 32; f32x4 v0 = acc[ai][bj][m][0], v1 = acc[ai][bj][m][1];
                    const bool isq = cb >= QOFF && cb < QOFF + 1024;
                    if (latent && (cb < VOFF || isq)) { const float sc = isq ? 0.18033688011112042f : 1.f; const int pos = (cb & 32) ? (t & 63) : (t >> 6); f32x4 o0, o1;
#pragma unroll
                        for (int r = 0; r < 4; ++r) { const float2 cs = rope[pos * 16 + fq * 4 + r]; o0[r] = (v0[r] * cs.x - v1[r] * cs.y) * sc; o1[r] = (v1[r] * cs.x + v0[r] * cs.y) * sc; }
                        v0 = o0; v1 = o1; }
                    uint2 o; o.x = pk(v0[0], v0[1]); o.y = pk(v0[2], v0[3]); *(uint2*)(F + (size_t)row * ld + cb + fq * 4) = o;
                    o.x = pk(v1[0], v1[1]); o.y = pk(v1[2], v1[3]); *(uint2*)(F + (size_t)row * ld + cb + 16 + fq * 4) = o; } }
    }
};
struct PgGLU {
    static constexpr bool PERM = false, AFTER_DRAIN = false;
    bf16_t* F;
    DEV void operator()(const f32x4 (&acc)[2][2][4][2], const pg8::Unit& u, int wr, int wc, int fr, int fq) const {
#pragma unroll
        for (int ai = 0; ai < 2; ++ai)
#pragma unroll
            for (int m = 0; m < 4; ++m) { const int row = u.pm * 256 + ai * 128 + wr * 64 + m * 16 + fr;
#pragma unroll
                for (int n = 0; n < 2; ++n) { const int oc = u.pn * 128 + wc * 32 + n * 16 + fq * 4; const f32x4 a = acc[ai][0][m][n], b = acc[ai][1][m][n];
                    bf16_t* pp = F + (size_t)row * F2LD + GS5 + oc; const uint2 gg = *(const uint2*)pp;
                    const float g0 = bflo(gg.x), g1 = bfhi(gg.x), g2 = bflo(gg.y), g3 = bfhi(gg.y);
                    uint2 o; o.x = pk(a[0] * sigmoidf_(b[0]) * siluf_(g0), a[1] * sigmoidf_(b[1]) * siluf_(g1)); o.y = pk(a[2] * sigmoidf_(b[2]) * siluf_(g2), a[3] * sigmoidf_(b[3]) * siluf_(g3));
                    *(uint2*)pp = o; } }
    }
};
struct PgD {
    static constexpr bool PERM = false, AFTER_DRAIN = false;
    float* out; const float* mod;
    DEV void operator()(const f32x4 (&acc)[2][2][4][2], const pg8::Unit& u, int wr, int wc, int fr, int fq) const {
        PG_ROWS_COLS(
            float* dst = out + (size_t)row * 1024 + col; const f32x4 gt = *(const f32x4*)(mod + (size_t)(row >> 11) * 3072 + 2048 + col);
            *(f32x4*)dst = *(const f32x4*)dst + gt * v; )
    }
};
struct EpiS5X { bf16_t* S; int g, dir;
    DEV void operator()(f32x4 (&acc)[4][4], int mrow0, int ncol0, int lane) const {
#pragma unroll
        for (int j = 0; j < 4; ++j) { const int n = mrow0 + j * 16 + (lane & 15);
#pragma unroll
            for (int i = 0; i < 4; ++i) { const int col = ncol0 + i * 16 + (lane >> 4) * 4; const f32x4 v = acc[i][j];
                uint2 o; o.x = pk(v[0], v[1]); o.y = pk(v[2], v[3]); *(uint2*)(S + (((size_t)n * 64 + g) * 2 + dir) * 128 + col) = o; } }
    }
};
struct EpiS5Y { const bf16_t* FL; bf16_t* Z; const float* dsk; int g;
    DEV void operator()(f32x4 (&acc)[4][4], int mrow0, int ncol0, int lane) const {
#pragma unroll
        for (int j = 0; j < 4; ++j) { const int n = mrow0 + j * 16 + (lane & 15); const int b = n >> 6, cl = n & 63;
#pragma unroll
            for (int i = 0; i < 4; ++i) { const int t = (ncol0 >> 4) + i, h = (lane >> 4) * 4; const f32x4 v = acc[i][j];
                const size_t m = (size_t)b * 2048 + cl * 32 + t; const uint2 uu = *(const uint2*)(FL + m * F2LD + UOFF + g * 16 + h);
                const float4 dd = *(const float4*)(dsk + g * 16 + h);
                uint2 o; o.x = pk(geluf_(v[0] + dd.x * bflo(uu.x)), geluf_(v[1] + dd.y * bfhi(uu.x))); o.y = pk(geluf_(v[2] + dd.z * bflo(uu.y)), geluf_(v[3] + dd.w * bfhi(uu.y)));
                *(uint2*)(Z + m * 1024 + g * 16 + h) = o; } }
    }
};

template <class MAP>
__device__ __forceinline__ void transpose_tile(const float* src, int ldsrc, bf16_t* dst, int K, int n0, int k0, const MAP& map, unsigned char* lds) {
    float* tile = (float*)lds;
    const int tid = tid_l() & 255;
    __syncthreads();
#pragma unroll
    for (int e = 0; e < 16; ++e) { const int idx = tid + e * 256; const int kk = idx >> 6, nn = idx & 63; tile[kk * 65 + nn] = src[(size_t)(k0 + kk) * ldsrc + map(n0 + nn)]; }
    __syncthreads();
    const int nn = tid >> 2, kq = (tid & 3) * 16;
    unsigned o[8];
#pragma unroll
    for (int e = 0; e < 8; ++e) o[e] = pk(tile[(kq + 2 * e) * 65 + nn], tile[(kq + 2 * e + 1) * 65 + nn]);
    uint4* d = (uint4*)(dst + (size_t)(n0 + nn) * K + k0 + kq);
    d[0] = make_uint4(o[0], o[1], o[2], o[3]); d[1] = make_uint4(o[4], o[5], o[6], o[7]);
}
struct MapIn0 { DEV int operator()(int n) const { return n < 2048 ? n : n + 32; } };
struct MapId { DEV int operator()(int n) const { return n; } };
struct MapIn1 { DEV int operator()(int n) const { return n < 512 ? n + 1024 : n < 1536 ? n + 2048 : n < 2560 ? n : n < 3584 ? n - 2560 : n; } };
struct MapGlu { DEV int operator()(int n) const { return ((n >> 7) & 1) * 1024 + (n >> 8) * 128 + (n & 127); } };

__device__ __forceinline__ void prep_phase(const P& p, unsigned char* lds) {
    unsigned char* ws = p.ws;
    const int tid5 = tid_l(), half = tid5 >> 8, tid = tid5 & 255, nb = gridDim.x, bid = blockIdx.x;
    lds += half * HALF_LDS;
    constexpr int N_IN0 = 128 * 16, N_G = 16 * 16, N_OUT0 = 16 * 32, N_IN1 = 72 * 16, N_GLU = 32 * 16, N_OUT1 = 16 * 32, N_ADA = 96;
    constexpr int E0 = N_IN0, E1 = E0 + N_G, E2 = E1 + N_OUT0, E3 = E2 + N_IN1, E4 = E3 + N_GLU, E5 = E4 + N_OUT1, E6 = E5 + N_ADA;
    for (int it = bid * 2 + half; it < E6; it += nb * 2) {
        if (it < E0) { transpose_tile(p.ev_w_in, 8224, (bf16_t*)(ws + WS_WIN0), 1024, (it >> 4) * 64, (it & 15) * 64, MapIn0(), lds); }
        else if (it < E1) {
            const int i2 = it - E0; const int n0 = (i2 >> 4) * 64, k0 = (i2 & 15) * 64; const int nn = tid >> 2, kq = (tid & 3) * 16;
            const int n = n0 + nn, dd = n >> 9, cc = n & 511; float gw[16];
#pragma unroll
            for (int r = 0; r < 16; ++r) gw[r] = p.gk_w[(size_t)(dd * 16 + r) * 512 + cc];
            unsigned o[8];
#pragma unroll
            for (int e = 0; e < 8; ++e) { float v2[2];
#pragma unroll
                for (int q = 0; q < 2; ++q) { const float* wr = p.ev_w_in + (size_t)(k0 + kq + 2 * e + q) * 8224 + 2048 + dd * 16; float a = 0.f;
#pragma unroll
                    for (int r = 0; r < 16; ++r) a += wr[r] * gw[r];
                    v2[q] = a; }
                o[e] = pk(v2[0], v2[1]); }
            uint4* d = (uint4*)((bf16_t*)(ws + WS_WIN0) + (size_t)(8192 + n) * 1024 + k0 + kq);
            d[0] = make_uint4(o[0], o[1], o[2], o[3]); d[1] = make_uint4(o[4], o[5], o[6], o[7]);
        }
        else if (it < E2) { const int i2 = it - E1; transpose_tile(p.ev_w_out, 1024, (bf16_t*)(ws + WS_WOUT0), 2048, (i2 >> 5) * 64, (i2 & 31) * 64, MapId(), lds); }
        else if (it < E3) { const int i2 = it - E2; transpose_tile(p.od_w_in, 4608, (bf16_t*)(ws + WS_WIN1), 1024, (i2 >> 4) * 64, (i2 & 15) * 64, MapIn1(), lds); }
        else if (it < E4) { const int i2 = it - E3; transpose_tile(p.glu_w, 2048, (bf16_t*)(ws + WS_WGLU), 1024, (i2 >> 4) * 64, (i2 & 15) * 64, MapGlu(), lds); }
        else if (it < E5) { const int i2 = it - E4; transpose_tile(p.od_w_out, 1024, (bf16_t*)(ws + WS_WOUT1), 2048, (i2 >> 5) * 64, (i2 & 31) * 64, MapId(), lds); }
        else {
            const int i2 = it - E5; const int layer = i2 / 48, col0 = (i2 % 48) * 64;
            float* sc = (float*)lds;
            __syncthreads();
            for (int idx = tid; idx < 17 * 1024; idx += 256) { const int r = idx >> 10, k = idx & 1023; const float v = r < 16 ? p.c[r * 1024 + k] : p.c_ctx[k]; sc[idx] = v / (1.f + expf(-v)); }
            __syncthreads();
            const int cl = tid & 63, kq = tid >> 6; float a[17];
#pragma unroll
            for (int r = 0; r < 17; ++r) a[r] = 0.f;
            const float* wp = p.ada_w + (size_t)layer * 1024 * 3072 + col0 + cl;
            for (int k = kq * 256; k < kq * 256 + 256; k += 8) { float wv[8];
#pragma unroll
                for (int j = 0; j < 8; ++j) wv[j] = wp[(size_t)(k + j) * 3072];
#pragma unroll
                for (int j = 0; j < 8; ++j)
#pragma unroll
                    for (int r = 0; r < 17; ++r) a[r] += sc[r * 1024 + k + j] * wv[j]; }
            __syncthreads();
#pragma unroll
            for (int r = 0; r < 17; ++r) sc[(kq * 17 + r) * 64 + cl] = a[r];
            __syncthreads();
            for (int idx = tid; idx < 17 * 64; idx += 256) { const int r = idx >> 6, c2 = idx & 63;
                const float v = sc[(0 * 17 + r) * 64 + c2] + sc[(1 * 17 + r) * 64 + c2] + sc[(2 * 17 + r) * 64 + c2] + sc[(3 * 17 + r) * 64 + c2];
                ((float*)(ws + WS_MOD))[((size_t)layer * 17 + r) * 3072 + col0 + c2] = v + p.ada_b[layer * 3072 + col0 + c2]; }
        }
    }
    const int gt = bid * NTHR + tid5, gs = nb * NTHR;
    for (int idx = gt; idx < 2048; idx += gs) { const int d = idx >> 10, col = idx & 1023; const float r0 = p.lb_raw[d * 2048 + col], r1 = p.lb_raw[d * 2048 + 1024 + col]; ((float*)(ws + WS_LB))[idx] = 1.f / (1.f + expf(r1 - r0)); }
    for (int idx = gt; idx < 1024; idx += gs) { const int pos = idx >> 4, i = idx & 15; const float fr = powf(10000.f, -(float)i / 16.f); float s, c; sincosf((float)pos * fr, &s, &c); ((float2*)(ws + WS_ROPE))[idx] = make_float2(c, s); }
    for (int idx = gt; idx < 128 * 33 * 64; idx += gs) { const int pp = idx & 63, m = (idx >> 6) % 33, gd = idx / (64 * 33), g = gd >> 1, dir = gd & 1;
        const float lre = p.lam_re[dir * 4096 + g * 64 + pp], lim = p.lam_im[dir * 4096 + g * 64 + pp], dt = expf(p.log_dt[dir * 64 + g]);
        const float mag = expf(lre * dt * (float)m); float s, c; sincosf(lim * dt * (float)m, &s, &c); ((float2*)(ws + WS_PW))[idx] = make_float2(mag * c, mag * s); }
    for (int idx = gt; idx < 128 * 64 * 16; idx += gs) { const int h = idx & 15, pp = (idx >> 4) & 63, gd = idx >> 10, g = gd >> 1, dir = gd & 1;
        const float lre = p.lam_re[dir * 4096 + g * 64 + pp], lim = p.lam_im[dir * 4096 + g * 64 + pp], dt = expf(p.log_dt[dir * 64 + g]);
        const float mag = expf(lre * dt); float s, c; sincosf(lim * dt, &s, &c); const float xr = mag * c - 1.f, xi = mag * s, den = lre * lre + lim * lim;
        const float qr = (xr * lre + xi * lim) / den, qi = (xi * lre - xr * lim) / den; const float br = p.b_re[(g * 64 + pp) * 16 + h], bi = p.b_im[(g * 64 + pp) * 16 + h];
        ((float2*)(ws + WS_BB))[idx] = make_float2(qr * br - qi * bi, qr * bi + qi * br); }
}

__device__ __forceinline__ void normmod_phase(const P& p, int layer, int tok_lo, int tok_hi, int blk0, int nblk) {
    const int tid = tid_l(); const int lane = tid & 63, w = tid >> 6;
    const float* xc = (const float*)(p.ws + WS_XC); const float* mod = (const float*)(p.ws + WS_MOD) + (size_t)layer * 17 * 3072;
    bf16_t* H = (bf16_t*)(p.ws + WS_H); const float* ng = p.norm_g + layer * 1024;
    for (int tok = tok_lo + (blockIdx.x - blk0) * 8 + w; tok < tok_hi; tok += nblk * 8) {
        const int b = tok / 2304, j = tok - b * 2304; const bool isc = j < 256;
        const float* src = isc ? (layer == 0 ? p.ctx : xc) + (size_t)(b * 256 + j) * 1024 : (layer == 0 ? p.x : p.out) + (size_t)(b * 2048 + j - 256) * 1024;
        const float* md = mod + (size_t)(isc ? 16 : b) * 3072;
        const int hrow = layer == 0 ? tok : (isc ? 32768 + b * 256 + j : b * 2048 + j - 256);
        float4 v[4]; float ss = 0.f;
#pragma unroll
        for (int m = 0; m < 4; ++m) { v[m] = *(const float4*)(src + m * 256 + lane * 4); ss += v[m].x * v[m].x + v[m].y * v[m].y + v[m].z * v[m].z + v[m].w * v[m].w; }
#pragma unroll
        for (int o = 32; o >= 1; o >>= 1) ss += __shfl_xor(ss, o);
        const float rs = rsqrtf(ss * (1.f / 1024.f) + EPSN);
#pragma unroll
        for (int m = 0; m < 4; ++m) { const int col = m * 256 + lane * 4; const float4 g = *(const float4*)(ng + col), sh = *(const float4*)(md + col), sc = *(const float4*)(md + 1024 + col);
            uint2 o; o.x = pk(v[m].x * rs * g.x * (1.f + sc.x) + sh.x, v[m].y * rs * g.y * (1.f + sc.y) + sh.y); o.y = pk(v[m].z * rs * g.z * (1.f + sc.z) + sh.z, v[m].w * rs * g.w * (1.f + sc.w) + sh.w);
            *(uint2*)(H + (size_t)hrow * 1024 + col) = o; }
    }
}

__device__ __forceinline__ void pre_phase(const P& p, int par, int half, unsigned char* lds) {
    const int tid = tid_l() & 255, lane = tid & 63, w = tid >> 6;
    float* sG = (float*)lds;
    bf16_t* sQ = (bf16_t*)(lds + 33792);
    bf16_t* sK = sQ + 32 * 136;
    bf16_t* sT = sK + 32 * 136;
    bf16_t* sAtt = sT + 128 * 40;
    const bf16_t* FB = (const bf16_t*)(p.ws + WS_FEATB); const unsigned short* FF = (const unsigned short*)(p.ws + WS_FEATF);
    const int li = tid >> 3, seg = tid & 7, stride = gridDim.x * 2;
    uint4 nq0, nq1, nk0, nk1, ng00, ng01, ng10, ng11;
#define PRE_DEC(IT) const int chunk = (IT) % 72, t2 = (IT) / 72, head12 = t2 % 12, bl = t2 / 12; const int hgrn = head12 >= 4, head = hgrn ? head12 - 4 : head12; \
        const size_t row = (size_t)bl * 2304 + chunk * 32 + li;
#define PRE_LOAD(IT) { PRE_DEC(IT) const bf16_t* fb_ = FB + row * 6144; const int qo_ = hgrn ? 3072 + head * 128 : head * 128, ko_ = hgrn ? qo_ : 512 + head * 128; \
        nq0 = *(const uint4*)(fb_ + qo_ + seg * 16); nq1 = *(const uint4*)(fb_ + qo_ + seg * 16 + 8); nk0 = *(const uint4*)(fb_ + ko_ + seg * 16); nk1 = *(const uint4*)(fb_ + ko_ + seg * 16 + 8); \
        const unsigned short* f0_ = FF + row * 3072 + (hgrn ? head * 128 : 2048 + head * 128) + seg * 16; const unsigned short* f1_ = f0_ + (hgrn ? 1024 : 512); \
        ng00 = *(const uint4*)(f0_); ng01 = *(const uint4*)(f0_ + 8); ng10 = *(const uint4*)(f1_); ng11 = *(const uint4*)(f1_ + 8); }
    int it = blockIdx.x * 2 + half;
    if (it < 1728) PRE_LOAD(it)
    for (; it < 1728; it += stride) {
        PRE_DEC(it)
        const bf16_t* fb = FB + row * 6144;
        float q[16], kk_[16], g0[16], g1[16];
        unpack8(nq0, q); unpack8(nq1, q + 8); unpack8(nk0, kk_); unpack8(nk1, kk_ + 8);
        unpackh8(ng00, g0); unpackh8(ng01, g0 + 8); unpackh8(ng10, g1); unpackh8(ng11, g1 + 8);
        float kh0[16], kh1[16];
#pragma unroll
        for (int e = 0; e < 16; ++e) { kh0[e] = 0.f; kh1[e] = 0.f; }
        if (hgrn) {
            const float* lbp = (const float*)(p.ws + WS_LB) + head * 128 + seg * 16;
#pragma unroll
            for (int e4 = 0; e4 < 4; ++e4) { const float4 l0 = *(const float4*)(lbp + e4 * 4), l1 = *(const float4*)(lbp + 1024 + e4 * 4); const float la[4] = {l0.x, l0.y, l0.z, l0.w}, lc[4] = {l1.x, l1.y, l1.z, l1.w};
#pragma unroll
                for (int r = 0; r < 4; ++r) { const int e = e4 * 4 + r; const float f0 = la[r] + (1.f - la[r]) * rcpf_(1.f + __expf(-g0[e])), f1 = lc[r] + (1.f - lc[r]) * rcpf_(1.f + __expf(-g1[e]));
                    kh0[e] = 1.f - f0; kh1[e] = 1.f - f1; g0[e] = __logf(f0); g1[e] = __logf(f1); } }
        } else {
#pragma unroll
            for (int e = 0; e < 16; ++e) { g0[e] = (fminf(g0[e], 0.f) - __logf(1.f + __expf(-fabsf(g0[e])))) * 0.0625f; g1[e] = (fminf(g1[e], 0.f) - __logf(1.f + __expf(-fabsf(g1[e])))) * 0.0625f; }
        }
        { const int nx = it + stride < 1728 ? it + stride : it; PRE_LOAD(nx) }
#pragma unroll
        for (int e = 0; e < 4; ++e) { *(float4*)(sG + li * 132 + seg * 16 + e * 4) = make_float4(g0[4 * e], g0[4 * e + 1], g0[4 * e + 2], g0[4 * e + 3]);
            *(float4*)(sG + 32 * 132 + li * 132 + seg * 16 + e * 4) = make_float4(g1[4 * e], g1[4 * e + 1], g1[4 * e + 2], g1[4 * e + 3]); }
        __syncthreads();
        { float* pl = sG + (tid >> 7) * 32 * 132 + (tid & 127); float a = 0.f;
#pragma unroll
            for (int i = 0; i < 32; ++i) { a += pl[i * 132]; pl[i * 132] = a; } }
        __syncthreads();
#pragma unroll
        for (int dir = 0; dir < 2; ++dir) {
            const int hd = hgrn ? 8 + head * 2 + dir : head * 2 + dir;
            const size_t hb = ((size_t)(bl * 24 + hd) * 72 + chunk);
            float g[16];
#pragma unroll
            for (int e = 0; e < 16; ++e) g[e] = dir ? g1[e] : g0[e];
            {
                unsigned oq[8], ok[8];
                float Pv[16], PLv[16];
                const float* sGd = sG + dir * 32 * 132;
#pragma unroll
                for (int e4 = 0; e4 < 4; ++e4) { const float4 a4 = *(const float4*)(sGd + li * 132 + seg * 16 + e4 * 4), b4 = *(const float4*)(sGd + 31 * 132 + seg * 16 + e4 * 4);
                    Pv[4 * e4] = a4.x; Pv[4 * e4 + 1] = a4.y; Pv[4 * e4 + 2] = a4.z; Pv[4 * e4 + 3] = a4.w; PLv[4 * e4] = b4.x; PLv[4 * e4 + 1] = b4.y; PLv[4 * e4 + 2] = b4.z; PLv[4 * e4 + 3] = b4.w; }
                bf16_t* qd_g = (bf16_t*)(p.ws + WS_QD) + hb * 4096 + li * 128 + (seg >> 1) * 32 + (seg & 1) * 4;
#pragma unroll
                for (int e = 0; e < 16; e += 2) {
                    float qd[2], ki[2];
#pragma unroll
                    for (int u = 0; u < 2; ++u) { const float Pi = Pv[e + u], PL = PLv[e + u];
                        const float bc = dir ? PL - Pi + g[e + u] : Pi; const float kv = hgrn ? (dir ? kh1[e + u] : kh0[e + u]) : kk_[e + u];
                        qd[u] = q[e + u] * __expf(bc); ki[u] = kv * __expf(fminf(-bc, 87.f)); const float ktl = kv * __expf(PL - bc);
                        sT[((e + u) * 8 + seg) * 40 + li] = f2bf(ktl);
                        if (li == 31) ((float*)(p.ws + WS_DEC))[hb * 128 + seg * 16 + e + u] = __expf(PL); }
                    oq[e >> 1] = pk(qd[0], qd[1]); ok[e >> 1] = pk(ki[0], ki[1]);
                }
                *(uint4*)(sQ + li * 136 + seg * 16) = make_uint4(oq[0], oq[1], oq[2], oq[3]); *(uint4*)(sQ + li * 136 + seg * 16 + 8) = make_uint4(oq[4], oq[5], oq[6], oq[7]);
                *(uint4*)(sK + li * 136 + seg * 16) = make_uint4(ok[0], ok[1], ok[2], ok[3]); *(uint4*)(sK + li * 136 + seg * 16 + 8) = make_uint4(ok[4], ok[5], ok[6], ok[7]);
#pragma unroll
                for (int qg = 0; qg < 4; ++qg) *(uint2*)(qd_g + qg * 8) = make_uint2(oq[qg * 2], oq[qg * 2 + 1]);
            }
            __syncthreads();
            {
                const int ti = w >> 1, tj = w & 1; f32x4 a = (f32x4){0.f, 0.f, 0.f, 0.f};
                if (dir ? !(ti == 1 && tj == 0) : !(ti == 0 && tj == 1)) {
#pragma unroll
                    for (int kk = 0; kk < 4; ++kk) { const bf16x8 A = as8(*(const uint4*)(sQ + (ti * 16 + (lane & 15)) * 136 + kk * 32 + (lane >> 4) * 8)); const bf16x8 B = as8(*(const uint4*)(sK + (tj * 16 + (lane & 15)) * 136 + kk * 32 + (lane >> 4) * 8)); a = MFMA(A, B, a); }
                }
#pragma unroll
                for (int r = 0; r < 4; ++r) { const int c = ti * 16 + (lane >> 4) * 4 + r, s2 = tj * 16 + (lane & 15); const bool keep = dir ? (s2 >= c) : (s2 <= c); sAtt[c * 40 + s2] = f2bf(keep ? a[r] : 0.f); }
            }
            __syncthreads();
            {
                const int d = tid >> 1, part = tid & 1; bf16_t* kt_g = (bf16_t*)(p.ws + WS_KTT) + hb * 4096 + d * 32 + part * 16;
                const int dr = (d & 15) * 8 + (d >> 4);
                *(uint4*)kt_g = *(const uint4*)(sT + dr * 40 + part * 16); *(uint4*)(kt_g + 8) = *(const uint4*)(sT + dr * 40 + part * 16 + 8);
                if (tid < 128) { const int r = tid >> 2, pt = tid & 3; *(uint4*)((bf16_t*)(p.ws + WS_ATT) + hb * 1024 + r * 32 + pt * 8) = *(const uint4*)(sAtt + r * 40 + pt * 8); }
            }
            if (dir == 0) __syncthreads();
        }
    }
#undef PRE_DEC
#undef PRE_LOAD
}

__device__ __forceinline__ void seq_block(const P& p, int par, int blk, unsigned char* lds) {
    const int tid = tid_l(), lane = tid & 63, w = tid >> 6, fr = lane & 15, fq = lane >> 4;
    int bl, hd, vcol0;
    if (blk < 32) { bl = blk >> 4; hd = (blk >> 1) & 7; vcol0 = (hd >> 1) * 256 + (blk & 1) * 128; } else { const int b2 = blk - 32; bl = b2 >> 4; hd = 8 + (b2 & 15); vcol0 = 1024 + ((hd - 8) >> 1) * 128; }
    const int dir = hd & 1, vcol = vcol0 + w * 16;
    bf16_t* O = (bf16_t*)(p.ws + (dir ? WS_OB : WS_OF) + (size_t)par * OBUF);
    const size_t hb = (size_t)(bl * 24 + hd) * 72;
    const size_t QDo = WS_QD + hb * 8192, KTo = WS_KTT + hb * 8192, ATo = WS_ATT + hb * 2048, DCo = WS_DEC + hb * 512, VTo = (par ? WS_VTT1 : WS_VTT) + (size_t)bl * 72 * 131072;
    const char* wsb = (const char*)p.ws;
    const size_t o0 = QDo + ((((w >> 2) * 16 + fr) * 128 + (w & 3) * 32 + fq * 8) * 2);
    const size_t o1 = w < 2 ? ATo + (((w * 16 + fr) * 32 + fq * 8) * 2) : KTo + ((((w - 2) * 16 + fr) * 32 + fq * 8) * 2);
    const size_t o2 = w < 2 ? KTo + ((((w + 6) * 16 + fr) * 32 + fq * 8) * 2) : DCo + (lane & 31) * 16;
    const size_t o3 = VTo + (((vcol + fr) * 32 + fq * 8) * 2);
    const char* b0 = wsb + o0; const char* b1 = wsb + o1; const char* b2 = wsb + o2; const char* b3 = wsb + o3;
    const unsigned s0 = 8192, s1 = w < 2 ? 2048u : 8192u, s2 = w < 2 ? 8192u : 512u, s3 = 131072;
    const int id0 = w, id1 = w + 8, id2 = w < 3 ? w + 16 : 18, id3 = 19 + w;
    f32x4 S[8];
#pragma unroll
    for (int d = 0; d < 8; ++d) S[d] = (f32x4){0.f, 0.f, 0.f, 0.f};
    uint4 stA0, stA1, stA2, stA3, stB0, stB1, stB2, stB3, stC0, stC1, stC2, stC3, stD0, stD1, stD2, stD3;
#define SQ_CH(CC) (dir ? ((CC) < 8 ? 7 - (CC) : 79 - (CC)) : (CC))
#define SQ_LOAD(ST, CC) { const size_t c_ = (size_t)SQ_CH((CC) < 72 ? (CC) : 71); ST##0 = *(const uint4*)(b0 + c_ * s0); ST##1 = *(const uint4*)(b1 + c_ * s1); ST##2 = *(const uint4*)(b2 + c_ * s2); ST##3 = *(const uint4*)(b3 + c_ * s3); }
#define SQ_STEP(ST, CC) { unsigned char* sl = lds + ((CC) & 1) * 27648; \
        *(uint4*)(sl + id0 * 1024 + lane * 16) = ST##0; *(uint4*)(sl + id1 * 1024 + lane * 16) = ST##1; if (w < 3) *(uint4*)(sl + id2 * 1024 + lane * 16) = ST##2; *(uint4*)(sl + id3 * 1024 + lane * 16) = ST##3; \
        SQ_LOAD(ST, (CC) + 4); \
        __syncthreads(); \
        const int c = SQ_CH(CC); \
        const bf16x8 Bv = as8(*(const uint4*)(sl + id3 * 1024 + lane * 16)); \
        bf16x8 SB[4]; \
        _Pragma("unroll") for (int kk = 0; kk < 4; ++kk) SB[kk] = as8(make_uint4(pk(S[2 * kk][0], S[2 * kk][1]), pk(S[2 * kk][2], S[2 * kk][3]), pk(S[2 * kk + 1][0], S[2 * kk + 1][1]), pk(S[2 * kk + 1][2], S[2 * kk + 1][3]))); \
        _Pragma("unroll") for (int ci = 0; ci < 2; ++ci) { f32x4 o = (f32x4){0.f, 0.f, 0.f, 0.f}; \
            o = MFMA(Bv, as8(*(const uint4*)(sl + (8 + ci) * 1024 + lane * 16)), o); \
            _Pragma("unroll") for (int kk = 0; kk < 4; ++kk) o = MFMA(SB[kk], as8(*(const uint4*)(sl + (ci * 4 + kk) * 1024 + lane * 16)), o); \
            uint2 ov; ov.x = pk(o[0], o[1]); ov.y = pk(o[2], o[3]); \
            *(uint2*)(O + ((size_t)bl * 2304 + c * 32 + ci * 16 + fr) * 2048 + vcol + fq * 4) = ov; } \
        _Pragma("unroll") for (int dt = 0; dt < 8; ++dt) { const f32x4 dcv = *(const f32x4*)(sl + 18 * 1024 + (dt * 4 + fq) * 16); \
            S[dt] = S[dt] * dcv; S[dt] = MFMA(as8(*(const uint4*)(sl + (10 + dt) * 1024 + lane * 16)), Bv, S[dt]); } }
    SQ_LOAD(stA, 0); SQ_LOAD(stB, 1); SQ_LOAD(stC, 2); SQ_LOAD(stD, 3);
    __syncthreads();
    for (int cc = 0; cc < 72; cc += 4) { SQ_STEP(stA, cc); SQ_STEP(stB, cc + 1); SQ_STEP(stC, cc + 2); SQ_STEP(stD, cc + 3); }
    __syncthreads();
#undef SQ_CH
#undef SQ_LOAD
#undef SQ_STEP
}

__device__ __forceinline__ void gatenorm_phase(const P& p, int par) {
    const int tid = tid_l(); const int lane = tid & 63, w = tid >> 6;
    bf16_t* OF = (bf16_t*)(p.ws + WS_OF + (size_t)par * OBUF); const bf16_t* OB = (const bf16_t*)(p.ws + WS_OB + (size_t)par * OBUF); const bf16_t* GT = (const bf16_t*)(p.ws + WS_GATES + (size_t)par * OBUF);
    for (int r = blockIdx.x * 8 + w; r < GROWS; r += gridDim.x * 8) {
#pragma unroll
        for (int m = 0; m < 4; ++m) { const int col = m * 512 + lane * 8;
            float a[8], b[8], gt[8]; unpack8(*(const uint4*)(OF + (size_t)r * 2048 + col), a); unpack8(*(const uint4*)(OB + (size_t)r * 2048 + col), b);
            unpack8(*(const uint4*)(GT + (size_t)r * 2048 + col), gt);
            float ss = 0.f;
#pragma unroll
            for (int e = 0; e < 8; ++e) { a[e] += b[e]; ss += a[e] * a[e]; }
            ss += __shfl_xor(ss, 1); ss += __shfl_xor(ss, 2); ss += __shfl_xor(ss, 4); ss += __shfl_xor(ss, 8);
            float rs; const float* gw;
            if (m < 2) { ss += __shfl_xor(ss, 16); rs = rsqrtf(ss * (1.f / 256.f) + EPSN); gw = p.gla_g + (col & 255); } else { rs = rsqrtf(ss * (1.f / 128.f) + EPSN); gw = p.hg_g + (col & 127); }
            unsigned o[4];
#pragma unroll
            for (int e = 0; e < 8; e += 2) o[e >> 1] = pk(a[e] * rs * gw[e] * siluf_(gt[e]), a[e + 1] * rs * gw[e + 1] * siluf_(gt[e + 1]));
            *(uint4*)(OF + (size_t)r * 2048 + col) = make_uint4(o[0], o[1], o[2], o[3]); }
    }
}

#define DPPF(V, CTRL) __builtin_bit_cast(float, __builtin_amdgcn_update_dpp(0, __builtin_bit_cast(int, (V)), (CTRL), 0xF, 0xF, false))
DEV float rowmax16(float v) { v = fmaxf(v, DPPF(v, 0xB1)); v = fmaxf(v, DPPF(v, 0x4E)); v = fmaxf(v, DPPF(v, 0x124)); v = fmaxf(v, DPPF(v, 0x128)); return v; }
DEV float rowsum16(float v) { v += DPPF(v, 0xB1); v += DPPF(v, 0x4E); v += DPPF(v, 0x124); v += DPPF(v, 0x128); return v; }
__device__ __forceinline__ void attn_item(const P& p, int item, unsigned char* lds) {
    const int tid = tid_l() & 255, lane = tid & 63, w = tid >> 6, fr = lane & 15, fq = lane >> 4;
    bf16_t* sKb = (bf16_t*)lds;
    bf16_t* sVb = sKb + 2 * 64 * 72;
    bf16_t* FL = (bf16_t*)(p.ws + WS_F2L);
    const int nb = (item >> 1) & 15, hq = ((item >> 5) & 7) * 2 + (item & 1), b = item >> 8, kv = hq >> 2;
    const float sinkv = p.sink[hq] * 1.4426950408889634f;
    const size_t qrow0 = (size_t)b * 2048 + nb * 128 + w * 32;
    bf16x8 qf[2][2];
#pragma unroll
    for (int rt = 0; rt < 2; ++rt)
#pragma unroll
        for (int kk = 0; kk < 2; ++kk) qf[rt][kk] = as8(*(const uint4*)(FL + (qrow0 + rt * 16 + fr) * F2LD + QOFF + hq * 64 + kk * 32 + fq * 8));
    float mrow[2], lrow[2]; f32x4 o[2][4];
#pragma unroll
    for (int rt = 0; rt < 2; ++rt) { mrow[rt] = sinkv; lrow[rt] = fq == 0 ? 1.f : 0.f;
#pragma unroll
        for (int dt = 0; dt < 4; ++dt) o[rt][dt] = (f32x4){0.f, 0.f, 0.f, 0.f}; }
    const int bt_lo = nb == 0 ? 2 : 0, ntile = 4 + ((nb == 15 ? 3 : 5) - bt_lo + 1);
    uint4 rk0, rk1, rv0, rv1;
#define AT_LOAD(T) { const int t_ = (T) < ntile ? (T) : ntile - 1; const bool cx_ = t_ < 4; const int kp_ = (nb - 1) * 128 + (bt_lo + t_ - 4) * 64; \
        const size_t ro_ = cx_ ? F2C_DELTA + (size_t)(b * 256 + t_ * 64) * F2CLD : (size_t)(b * 2048 + kp_) * F2LD; const int ld_ = cx_ ? F2CLD : F2LD; \
        const bf16_t* kp0_ = FL + ro_ + kv * 64 + (size_t)(tid >> 3) * ld_ + (tid & 7) * 8; \
        rk0 = *(const uint4*)(kp0_ + KOFF); rk1 = *(const uint4*)(kp0_ + (size_t)32 * ld_ + KOFF); \
        const bf16_t* vp0_ = FL + ro_ + kv * 64 + VOFF + (size_t)(tid & 63) * ld_ + (tid >> 6) * 16;     \
        rv0 = *(const uint4*)vp0_; rv1 = *(const uint4*)(vp0_ + 8); }
#define AT_STAGE(BUF) { bf16_t* sK = sKb + (BUF) * 64 * 72; bf16_t* sVT = sVb + (BUF) * 64 * 72; const int key = tid >> 3, ds = (tid & 7) * 8; \
        *(uint4*)(sK + key * 72 + ds) = rk0; *(uint4*)(sK + (key + 32) * 72 + ds) = rk1; \
        const unsigned vw0[4] = {rv0.x, rv0.y, rv0.z, rv0.w}; const unsigned vw1[4] = {rv1.x, rv1.y, rv1.z, rv1.w}; \
        const int vk = tid & 63, vd = (tid >> 6) * 16; \
        _Pragma("unroll") for (int e2 = 0; e2 < 4; ++e2) { sVT[(vd + 2 * e2) * 72 + vk] = (bf16_t)(vw0[e2] & 0xffffu); sVT[(vd + 2 * e2 + 1) * 72 + vk] = (bf16_t)(vw0[e2] >> 16); \
            sVT[(vd + 8 + 2 * e2) * 72 + vk] = (bf16_t)(vw1[e2] & 0xffffu); sVT[(vd + 8 + 2 * e2 + 1) * 72 + vk] = (bf16_t)(vw1[e2] >> 16); } }
    __syncthreads();
    AT_LOAD(0); AT_STAGE(0); AT_LOAD(1);
    __syncthreads();
    for (int tile = 0; tile < ntile; ++tile) {
        const bool masked = tile >= 4; const int kpos0 = (nb - 1) * 128 + (bt_lo + tile - 4) * 64;
        if (tile + 1 < ntile) AT_STAGE((tile + 1) & 1);
        AT_LOAD(tile + 2);
        const bf16_t* sK = sKb + (tile & 1) * 64 * 72; const bf16_t* sVT = sVb + (tile & 1) * 64 * 72;
        f32x4 s[2][4];
#pragma unroll
        for (int kt = 0; kt < 4; ++kt) { const bf16x8 K0 = as8(*(const uint4*)(sK + (kt * 16 + fr) * 72 + fq * 8)), K1 = as8(*(const uint4*)(sK + (kt * 16 + fr) * 72 + 32 + fq * 8));
#pragma unroll
            for (int rt = 0; rt < 2; ++rt) { f32x4 a = (f32x4){0.f, 0.f, 0.f, 0.f}; a = MFMA(K0, qf[rt][0], a); a = MFMA(K1, qf[rt][1], a); s[rt][kt] = a; } }
        const int q0w = nb * 128 + w * 32;
        if (masked && (kpos0 < q0w + 31 - 128 || kpos0 + 63 > q0w + 128)) {
#pragma unroll
            for (int rt = 0; rt < 2; ++rt)
#pragma unroll
                for (int kt = 0; kt < 4; ++kt)
#pragma unroll
                    for (int r = 0; r < 4; ++r) { const int qpos = nb * 128 + w * 32 + rt * 16 + fr, kpos = kpos0 + kt * 16 + fq * 4 + r; const int d = qpos - kpos; if (d > 128 || d < -128) s[rt][kt][r] = -1e30f; }
        }
        bf16x8 PB[2][2];
#pragma unroll
        for (int rt = 0; rt < 2; ++rt) {
            float mx = -1e30f;
#pragma unroll
            for (int kt = 0; kt < 4; ++kt) mx = fmaxf(mx, fmaxf(fmaxf(s[rt][kt][0], s[rt][kt][1]), fmaxf(s[rt][kt][2], s[rt][kt][3])));
            mx = fmaxf(mx, __shfl_xor(mx, 16)); mx = fmaxf(mx, __shfl_xor(mx, 32));
            const float mn = fmaxf(mrow[rt], mx), alpha = __builtin_amdgcn_exp2f(mrow[rt] - mn); mrow[rt] = mn; float ps = 0.f;
            float pv[4][4];
#pragma unroll
            for (int kt = 0; kt < 4; ++kt)
#pragma unroll
                for (int r = 0; r < 4; ++r) { pv[kt][r] = __builtin_amdgcn_exp2f(s[rt][kt][r] - mn); ps += pv[kt][r]; }
            lrow[rt] = lrow[rt] * alpha + ps;
#pragma unroll
            for (int kp = 0; kp < 2; ++kp) PB[rt][kp] = as8(make_uint4(pk(pv[2 * kp][0], pv[2 * kp][1]), pk(pv[2 * kp][2], pv[2 * kp][3]), pk(pv[2 * kp + 1][0], pv[2 * kp + 1][1]), pk(pv[2 * kp + 1][2], pv[2 * kp + 1][3])));
#pragma unroll
            for (int dt = 0; dt < 4; ++dt) o[rt][dt] = o[rt][dt] * alpha;
        }
#pragma unroll
        for (int dt = 0; dt < 4; ++dt)
#pragma unroll
            for (int kp = 0; kp < 2; ++kp) { const bf16_t* vp = sVT + (dt * 16 + fr) * 72 + kp * 32 + fq * 4; const uint2 v0 = *(const uint2*)vp, v1 = *(const uint2*)(vp + 16);
                const bf16x8 VA = as8(make_uint4(v0.x, v0.y, v1.x, v1.y));
#pragma unroll
                for (int rt = 0; rt < 2; ++rt) o[rt][dt] = MFMA(VA, PB[rt][kp], o[rt][dt]); }
        __syncthreads();
    }
#undef AT_LOAD
#undef AT_STAGE
#pragma unroll
    for (int rt = 0; rt < 2; ++rt) { float l = lrow[rt]; l += __shfl_xor(l, 16); l += __shfl_xor(l, 32); const float inv = 1.f / l;
        bf16_t* rp = FL + (qrow0 + rt * 16 + fr) * F2LD;
#pragma unroll
        for (int dt = 0; dt < 4; ++dt) { const int d = hq * 64 + dt * 16 + fq * 4; const uint2 gg = *(const uint2*)(rp + GATT + d);
            uint2 ov; ov.x = pk(o[rt][dt][0] * inv * siluf_(bflo(gg.x)), o[rt][dt][1] * inv * siluf_(bfhi(gg.x))); ov.y = pk(o[rt][dt][2] * inv * siluf_(bflo(gg.y)), o[rt][dt][3] * inv * siluf_(bfhi(gg.y)));
            *(uint2*)(rp + QOFF + d) = ov; } }
}

__device__ __forceinline__ void s5tab_phase(const P& p) {
    unsigned char* ws = p.ws; const int gt = blockIdx.x * NTHR + tid_l(), gs = gridDim.x * NTHR;
    const float2* PW = (const float2*)(ws + WS_PW); const float2* BB = (const float2*)(ws + WS_BB);
    for (int idx = gt; idx < 128 * 64; idx += gs) ((float2*)(ws + WS_A32))[idx] = PW[((idx >> 6) * 33 + 32) * 64 + (idx & 63)];
    bf16_t* WX = (bf16_t*)(ws + WS_WX);
    for (int i8 = gt; i8 < 128 * 128 * 512 / 8; i8 += gs) { const int idx = i8 * 8;
        const int k = idx & 511, pc = (idx >> 9) & 127, gd = idx >> 16, pp = pc >> 1, ci = pc & 1, i = k >> 4, h0 = k & 15, dir = gd & 1;
        const int m = dir ? i : 31 - i; const float2 a = PW[(gd * 33 + m) * 64 + pp]; const float4* bp = (const float4*)(BB + (gd * 64 + pp) * 16 + h0);
        const float4 b0 = bp[0], b1 = bp[1], b2 = bp[2], b3 = bp[3];
#define WXV(BX, BY) (ci ? a.x * (BY) + a.y * (BX) : a.x * (BX) - a.y * (BY))
        *(uint4*)(WX + idx) = make_uint4(pk(WXV(b0.x, b0.y), WXV(b0.z, b0.w)), pk(WXV(b1.x, b1.y), WXV(b1.z, b1.w)), pk(WXV(b2.x, b2.y), WXV(b2.z, b2.w)), pk(WXV(b3.x, b3.y), WXV(b3.z, b3.w)));
#undef WXV
    }
    bf16_t* VT = (bf16_t*)(ws + WS_VT);
    for (int i8 = gt; i8 < 64 * 512 * 256 / 8; i8 += gs) { const int idx = i8 * 8;
        const int kk = idx & 255, col = (idx >> 8) & 511, g = idx >> 17, dir = kk >> 7, pp = (kk >> 1) & 63, t = col >> 4, h = col & 15;
        const int m = dir ? 32 - t : t + 1; const float4* ap = (const float4*)(PW + ((g * 2 + dir) * 33 + m) * 64 + pp); const float4 a0 = ap[0], a1 = ap[1];
        const float4 cr = *(const float4*)(p.c_re + (g * 16 + h) * 64 + pp), cm = *(const float4*)(p.c_im + (g * 16 + h) * 64 + pp);
        *(uint4*)(VT + idx) = make_uint4(pk(cr.x * a0.x - cm.x * a0.y, -(cr.x * a0.y + cm.x * a0.x)), pk(cr.y * a0.z - cm.y * a0.w, -(cr.y * a0.w + cm.y * a0.z)),
                                         pk(cr.z * a1.x - cm.z * a1.y, -(cr.z * a1.y + cm.z * a1.x)), pk(cr.w * a1.z - cm.w * a1.w, -(cr.w * a1.w + cm.w * a1.z)));
    }
    bf16_t* KT2 = (bf16_t*)(ws + WS_KT2);
    for (int i4 = gt; i4 < 64 * 63 * 256 / 4; i4 += gs) { const int idx = i4 * 4;
        const int hp = idx & 15, h = (idx >> 4) & 15, mm = (idx >> 8) % 63, g = idx / (63 * 256); float acc0 = 0.f, acc1 = 0.f, acc2 = 0.f, acc3 = 0.f;
        for (int dir = 0; dir < 2; ++dir) { const int m = dir ? 31 - mm : mm - 31; if (m < 0) continue; const int gd = g * 2 + dir;
            for (int pp = 0; pp < 64; ++pp) { const float2 a = PW[(gd * 33 + m) * 64 + pp]; const float4* bp = (const float4*)(BB + (gd * 64 + pp) * 16 + hp); const float4 b0 = bp[0], b1 = bp[1];
                const float cr = p.c_re[(g * 16 + h) * 64 + pp], cim = p.c_im[(g * 16 + h) * 64 + pp];
                const float er = cr * a.x - cim * a.y, ei = cr * a.y + cim * a.x;
                acc0 += er * b0.x - ei * b0.y; acc1 += er * b0.z - ei * b0.w; acc2 += er * b1.x - ei * b1.y; acc3 += er * b1.z - ei * b1.w; } }
        *(uint2*)(KT2 + idx) = make_uint2(pk(acc0, acc1), pk(acc2, acc3)); }
}

__device__ __forceinline__ void s5scan_phase(const P& p) {
    unsigned* S32 = (unsigned*)(p.ws + WS_S); const float2* A32 = (const float2*)(p.ws + WS_A32);
    for (int idx = blockIdx.x * NTHR + tid_l(); idx < 16 * 64 * 2 * 64; idx += gridDim.x * NTHR) {
        const int pp = idx & 63, dir = (idx >> 6) & 1, g = (idx >> 7) & 63, b = idx >> 13; const float2 a = A32[(g * 2 + dir) * 64 + pp];
        float sr = 0.f, si = 0.f;
        unsigned* base = S32 + ((size_t)(b * 72) * 64 + g) * 128 + dir * 64 + pp;
        for (int i0 = 0; i0 < 72; i0 += 8) {
            unsigned wv[8];
#pragma unroll
            for (int j = 0; j < 8; ++j) { const int i = i0 + j, c = dir ? (i < 8 ? 7 - i : 79 - i) : i; wv[j] = base[(size_t)c * 8192]; }
#pragma unroll
            for (int j = 0; j < 8; ++j) { const int i = i0 + j, c = dir ? (i < 8 ? 7 - i : 79 - i) : i; base[(size_t)c * 8192] = pk(sr, si);
                const float nr = a.x * sr - a.y * si + bflo(wv[j]), ni = a.x * si + a.y * sr + bfhi(wv[j]); sr = nr; si = ni; }
        }
    }
}

__device__ __forceinline__ void final_phase(const P& p) {
    const int tid = tid_l(); const int lane = tid & 63, w = tid >> 6;
    for (int tok = blockIdx.x * 8 + w; tok < 32768; tok += gridDim.x * 8) {
        float* row = p.out + (size_t)tok * 1024; float4 v[4]; float ss = 0.f;
#pragma unroll
        for (int m = 0; m < 4; ++m) { v[m] = *(const float4*)(row + m * 256 + lane * 4); ss += v[m].x * v[m].x + v[m].y * v[m].y + v[m].z * v[m].z + v[m].w * v[m].w; }
#pragma unroll
        for (int o = 32; o >= 1; o >>= 1) ss += __shfl_xor(ss, o);
        const float rs = rsqrtf(ss * (1.f / 1024.f) + EPSN);
#pragma unroll
        for (int m = 0; m < 4; ++m) { const int col = m * 256 + lane * 4; const float4 g = *(const float4*)(p.final_g + col);
            float4 o; o.x = v[m].x * rs * g.x; o.y = v[m].y * rs * g.y; o.z = v[m].z * rs * g.z; o.w = v[m].w * rs * g.w; *(float4*)(row + col) = o; }
    }
}

#define LAS __attribute__((address_space(3)))
#define XB_TMO      128
#define XB_XCNT(j)  (256  + 64 * (j))
#define XB_XSUB(j)  (1280 + 64 * (j))
#define XB_XGEN(j)  (2304 + 64 * (j))
#define XB_TOP      3328
#define XB_TOPGEN   3392
#define XCD_BAR_WORDS 3456
#define XB_SPIN_CAP (1u << 18)

__device__ __forceinline__ unsigned xb_ld(unsigned* p)              { return __hip_atomic_load(p, __ATOMIC_RELAXED, __HIP_MEMORY_SCOPE_AGENT); }
__device__ __forceinline__ unsigned xb_add(unsigned* p, unsigned v) { return __hip_atomic_fetch_add(p, v, __ATOMIC_RELAXED, __HIP_MEMORY_SCOPE_AGENT); }
__device__ __forceinline__ unsigned xb_xcc_id() { return (unsigned)__builtin_amdgcn_s_getreg((3 << 11) | 20) & 0xFu; }
#define XB_SPIN(cond, bar) do { unsigned _sp = 0; while (cond) { __builtin_amdgcn_s_sleep(1); \
    if ((++_sp & 255u) == 0u) { if (xb_ld(&(bar)[XB_TMO])) break; if (_sp > XB_SPIN_CAP) { atomicAdd(&(bar)[XB_TMO], 1u); break; } } } } while (0)

struct XcdBarrier {
    unsigned* bar; unsigned x;
    volatile LAS unsigned* st;
};

__device__ __forceinline__ XcdBarrier xcd_barrier_post(unsigned* bar, volatile LAS unsigned* st) {
    XcdBarrier b; b.bar = bar; b.x = xb_xcc_id(); b.st = st;
    if (threadIdx.x == 0) (void)xb_add(&bar[XB_XCNT(b.x)], 1u);
    return b;
}
__device__ __forceinline__ void xcd_barrier_complete(unsigned* bar, unsigned x, unsigned& nloc, unsigned& nx) {
    const unsigned G = gridDim.x * gridDim.y * gridDim.z;
    unsigned sum, cnt, mine, sp = 0u;
    for (;;) {
        sum = 0u; cnt = 0u; mine = 0u;
#pragma unroll
        for (unsigned j = 0; j < 16; ++j) { const unsigned c = xb_ld(&bar[XB_XCNT(j)]); sum += c; cnt += (c > 0u) ? 1u : 0u; mine = (j == x) ? c : mine; }
        if (sum == G) break;
        __builtin_amdgcn_s_sleep(1);
        if ((++sp & 255u) == 0u) { if (xb_ld(&bar[XB_TMO])) break; if (sp > XB_SPIN_CAP) { atomicAdd(&bar[XB_TMO], 1u); break; } }
    }
    nloc = mine > 0u ? mine : 1u; nx = cnt > 0u ? cnt : 1u;
}

__device__ __forceinline__ void xcd_barrier(const XcdBarrier& b) {
    asm volatile("s_waitcnt vmcnt(0)" ::: "memory");
    __syncthreads();
    if (threadIdx.x == 0) {
        unsigned* bar = b.bar;
        __builtin_amdgcn_s_waitcnt(0);
        unsigned nloc = b.st[0], nx = b.st[1];
        if (nloc == 0u) { xcd_barrier_complete(bar, b.x, nloc, nx); b.st[0] = nloc; b.st[1] = nx; }
        const unsigned old = xb_add(&bar[XB_XSUB(b.x)], 1u);
        const unsigned gen = old / nloc;
        if (old + 1u == (gen + 1u) * nloc) {
            __builtin_amdgcn_fence(__ATOMIC_RELEASE, "agent");
            asm volatile("s_waitcnt vmcnt(0)" ::: "memory");
            const unsigned og = xb_add(&bar[XB_TOP], 1u);
            const unsigned tg = og / nx;
            if (og + 1u == (tg + 1u) * nx) xb_add(&bar[XB_TOPGEN], 1u);
            else XB_SPIN(xb_ld(&bar[XB_TOPGEN]) == tg, bar);
            __builtin_amdgcn_fence(__ATOMIC_ACQUIRE, "agent");
            xb_add(&bar[XB_XGEN(b.x)], 1u);
            asm volatile("s_waitcnt vmcnt(0)" ::: "memory");
        } else {
            XB_SPIN(xb_ld(&bar[XB_XGEN(b.x)]) == gen, bar);
            __builtin_amdgcn_fence(__ATOMIC_ACQUIRE, "agent");
            asm volatile("s_waitcnt vmcnt(0)" ::: "memory");
        }
    }
    __syncthreads();
}

struct ListOrder {
    int nM, nN, nwg, base, step, cnt;
    __device__ void init(int M, int N, int base_, int step_, int cnt_) { nM = M / 256; nN = N / 256; nwg = nM * nN; base = base_; step = step_; cnt = cnt_; }
    __device__ bool next(int i, pg8::Unit& u) const {
        if (i >= cnt) return false; const int L = base + i * step; if (L >= nwg) return false;
        int wgid = L; { const int q = nwg / 8, r = nwg % 8, xcd = wgid % 8, off = wgid / 8; wgid = (xcd < r ? xcd * (q + 1) : r * (q + 1) + (xcd - r) * q) + off; }
        const int nig = 8 * nN, gid = wgid / nig, fm = gid * 8, gsz = (nM - fm) < 8 ? (nM - fm) : 8;
        u.pm = fm + ((wgid % nig) % gsz); u.pn = (wgid % nig) / gsz; return true;
    }
    __device__ __forceinline__ void a_ready(const pg8::Unit&) const {}
    __device__ __forceinline__ void done(const pg8::Unit&) const {}
};
template <class Epi>
__device__ __forceinline__ void run_gemm_list(unsigned char* lds, const bf16_t* A, int lda, const bf16_t* Bt, int M, int N, int K, int base, int step, int cnt, const Epi& ep) {
    pg8::Gemm g{A, Bt, M, N, K, lda}; ListOrder S; S.init(M, N, base, step, cnt);
    pg8::gemm_phase<Epi, ListOrder, true, true>((PG8_LAS unsigned char*)lds, g, S, ep);
}
template <class Epi>
__device__ __forceinline__ void run_gemm(unsigned char* lds, const bf16_t* A, int lda, const bf16_t* Bt, int M, int N, int K, int c, const Epi& ep) {
    pg8::Gemm g{A, Bt, M, N, K, lda}; pg8::StaticOrder S; S.init(M, N, gridDim.x, c);
    pg8::gemm_phase<Epi, pg8::StaticOrder, true, true>((PG8_LAS unsigned char*)lds, g, S, ep);
}

__global__ void __launch_bounds__(NTHR) fwd_megakernel(P p) {
    extern __shared__ __attribute__((aligned(16))) unsigned char lds[];
    cg::grid_group grid = cg::this_grid();
    unsigned char* ws = p.ws;
    const int bid = blockIdx.x, nb = gridDim.x;
#define half (tid_l() >> 8)
#define hl (lds + (tid_l() >> 8) * HALF_LDS)

    volatile LAS unsigned* xst = (volatile LAS unsigned*)((LAS unsigned char*)lds + 2 * HALF_LDS);
    if (threadIdx.x == 0) { xst[0] = 0u; xst[1] = 0u; }
    __syncthreads();
    XcdBarrier xb = xcd_barrier_post((unsigned*)(ws + WS_BAR), xst);
    prep_phase(p, lds);
    grid.sync();
    normmod_phase(p, 0, 0, NTOK, 0, nb);
    xcd_barrier(xb);
    const bf16_t* H0 = (const bf16_t*)(ws + WS_H); const bf16_t* W0 = (const bf16_t*)(ws + WS_WIN0);
    PgA epa{ws, p.gk_b, 0};
    run_gemm(lds, H0, 1024, W0, GROWS, 9216, 1024, bid, epa);
    xcd_barrier(xb);
    pre_phase(p, 0, half, hl);
    xcd_barrier(xb);
    for (int grp = 0; grp < 8; ++grp) {
        const int par = grp & 1;
        if (bid < 64) {
            const int blk = bid < 32 ? 2 * (((bid >> 4) << 3) + (bid & 7)) + ((bid >> 3) & 1) : bid;
            seq_block(p, par, blk, lds); }
        if (grp >= 1) {
            PgC epc{p.x, p.ctx, p.out, (float*)(ws + WS_XC), (const float*)(ws + WS_MOD), grp - 1};
            run_gemm_list(lds, (const bf16_t*)(ws + WS_OF + (size_t)(par ^ 1) * OBUF), 2048, (const bf16_t*)(ws + WS_WOUT0), GROWS, 1024, 2048, bid - 64, 72, (bid >= 64 && bid < 136) ? 1 : 0, epc);
        }
        if (grp < 7) {
            int base, step, cnt;
            if (bid >= 136) { base = bid - 136; step = 120; cnt = 4; } else if (bid >= 64) { base = 480 + bid - 64; step = 72; cnt = 2; } else { base = 624 + bid; step = 64; cnt = bid < 24 ? 1 : 0; }
            epa.par = par ^ 1;
            run_gemm_list(lds, H0 + (size_t)(grp + 1) * GROWS * 1024, 1024, W0, GROWS, 9216, 1024, base, step, cnt, epa);
        }
        xcd_barrier(xb);
        if (grp < 7) pre_phase(p, par ^ 1, half, hl);
        gatenorm_phase(p, par);
        xcd_barrier(xb);
    }
    {
        PgC epc{p.x, p.ctx, p.out, (float*)(ws + WS_XC), (const float*)(ws + WS_MOD), 7};
        run_gemm(lds, (const bf16_t*)(ws + WS_OF + OBUF), 2048, (const bf16_t*)(ws + WS_WOUT0), GROWS, 1024, 2048, bid, epc);
        if (bid >= 72) normmod_phase(p, 1, 0, 7 * GROWS, 72, nb - 72);
    }
    xcd_barrier(xb);
    normmod_phase(p, 1, 7 * GROWS, NTOK, 0, nb);
    s5tab_phase(p);
    xcd_barrier(xb);
    {
        PgB epl{(bf16_t*)(ws + WS_F2L), F2LD, (const float2*)(ws + WS_ROPE), 1}; PgB epc{(bf16_t*)(ws + WS_F2C), F2CLD, (const float2*)(ws + WS_ROPE), 0};
        run_gemm(lds, (const bf16_t*)(ws + WS_H), 1024, (const bf16_t*)(ws + WS_WIN1), 32768, 4608, 1024, bid, epl);
        run_gemm(lds, (const bf16_t*)(ws + WS_H) + (size_t)32768 * 1024, 1024, (const bf16_t*)(ws + WS_WIN1), 4096, 1536, 1024, bid, epc);
    }
    xcd_barrier(xb);
    {
        constexpr int NX = 128 * 9, LIM = NX + 3072;
        int it = bid * 2 + half;
        for (; it < LIM; it += nb * 2) {
            if (it < NX) {
                int gd = it / 9, tm = it % 9;
                if (nb == 256) { const int li = (it >> 9) * 64 + (((it >> 1) & 255) >> 3) * 2 + (it & 1), gg = ((it >> 1) & 7) * 8 + li / 18, rem = li % 18; gd = gg * 2 + rem / 9; tm = rem % 9; }
                LdS5X al{(const bf16_t*)(ws + WS_F2L), gd >> 1}; LdPlain bl{(const bf16_t*)(ws + WS_WX) + (size_t)gd * 128 * 512, 512};
                EpiS5X ep{(bf16_t*)(ws + WS_S), gd >> 1, gd & 1}; gemm_tile(al, bl, ep, tm * 128, 0, 512, hl); }
            else { int a = it - NX;
                if (nb == 256) {
                    const int t = a + 128, li = (t >> 9) * 64 + (((t >> 1) & 255) >> 3) * 2 + (t & 1) - 16; a = ((((t >> 1) & 7) * 2 + (li >> 8)) << 8) + (li & 255); }
                attn_item(p, a, hl); }
        }
        xcd_barrier(xb);
        s5scan_phase(p);
        for (; it < NX + 4096; it += nb * 2) { int a = it - NX;
            if (nb == 256) { const int t = a + 128, li = (t >> 9) * 64 + (((t >> 1) & 255) >> 3) * 2 + (t & 1) - 16; a = ((((t >> 1) & 7) * 2 + (li >> 8)) << 8) + (li & 255); }
            attn_item(p, a, hl); }
    }
    xcd_barrier(xb);
    {
        for (int it = bid * 2 + half; it < 64 * 32; it += nb * 2) {
            const int local = ((it >> 4) & 31) * 2 + (it & 1); const int g = (nb == 256) ? (it >> 9) * 16 + ((it >> 1) & 7) * 2 + (local >> 5) : it >> 5;
            const int tile = (nb == 256) ? (local & 31) : (it & 31); const int tm = tile >> 2, tn = tile & 3;
            LdS5YA al{(const bf16_t*)(ws + WS_F2L), (const bf16_t*)(ws + WS_S), g}; LdS5YB bl{(const bf16_t*)(ws + WS_KT2), (const bf16_t*)(ws + WS_VT), g};
            EpiS5Y ep{(const bf16_t*)(ws + WS_F2L), (bf16_t*)(ws + WS_H), p.s5_d, g}; gemm_tile(al, bl, ep, tm * 128, tn * 128, 768, hl); }
    }
    xcd_barrier(xb);
    {
        PgGLU ep{(bf16_t*)(ws + WS_F2L)};
        run_gemm(lds, (const bf16_t*)(ws + WS_H), 1024, (const bf16_t*)(ws + WS_WGLU), 32768, 2048, 1024, bid, ep);
    }
    xcd_barrier(xb);
    {
        PgD ep{p.out, (const float*)(ws + WS_MOD) + 17 * 3072};
        run_gemm(lds, (const bf16_t*)(ws + WS_F2L) + QOFF, F2LD, (const bf16_t*)(ws + WS_WOUT1), 32768, 1024, 2048, bid, ep);
    }
    xcd_barrier(xb);
    final_phase(p);
#undef half
#undef hl
}

extern "C" void kernel_launch(void* const* d_in, const int* in_sizes, int n_in, void* d_out, int out_size, void* d_ws, size_t ws_size, hipStream_t stream) {
    static int grid_blocks = 0;
    if (grid_blocks == 0) {
        if (ws_size < WS_TOTAL) { fprintf(stderr, "kernel_launch: workspace too small: %zu < %zu\n", ws_size, (size_t)WS_TOTAL); grid_blocks = -1; return; }
        int dev = 0, cus = 0, per_cu = 0;
        (void)hipGetDevice(&dev);
        (void)hipDeviceGetAttribute(&cus, hipDeviceAttributeMultiprocessorCount, dev);
        (void)hipFuncSetAttribute((const void*)fwd_megakernel, hipFuncAttributeMaxDynamicSharedMemorySize, LDS_BYTES);
        (void)hipOccupancyMaxActiveBlocksPerMultiprocessor(&per_cu, (const void*)fwd_megakernel, NTHR, LDS_BYTES);
        if (per_cu < 1) { fprintf(stderr, "kernel_launch: occupancy query reports %d blocks/CU\n", per_cu); per_cu = 1; }
        grid_blocks = cus;
    }
    if (grid_blocks < 0) return;
    P p{};
    const float** pp = (const float**)&p;
    for (int i = 0; i < 27; ++i) pp[i] = (const float*)d_in[i];
    p.out = (float*)d_out; p.ws = (unsigned char*)d_ws;
    (void)hipMemsetAsync((unsigned char*)d_ws + WS_BAR, 0, 16384, stream);
    void* args[] = {&p};
    hipError_t e = hipLaunchCooperativeKernel((void*)fwd_megakernel, dim3(grid_blocks), dim3(NTHR), args, LDS_BYTES, stream);
    if (e != hipSuccess) fprintf(stderr, "cooperative launch failed: %s (grid %d)\n", hipGetErrorString(e), grid_blocks);
}
```
